# Optimizing an MI355X kernel written in HIP

```python
import math
import jax
import jax.numpy as jnp
from jax import lax
import numpy as np

D_MODEL = 1024
BATCH = 8
SEQ = 4096
DEPTH = 2

F32 = jnp.float32
GRID_W = 64
GROUP_WIDTH = D_MODEL // 2
CHUNK = 64
Q_BLOCK = 128
EPS = 1e-6

HG_HEADS = 4
HG_DIM = GROUP_WIDTH // HG_HEADS
N_HGRN_LAYERS = (DEPTH + 1) // 2

DA_HEADS = 4
DA_DIM = GROUP_WIDTH // (2 * DA_HEADS)
ROPE_DIM = DA_DIM // 4
ROPE_THETA = 500000.0

ML_HEADS = 4
ML_DIM = GROUP_WIDTH // ML_HEADS
ML_CONV = 5

NA_HEADS = 8
NA_DIM = GROUP_WIDTH // NA_HEADS
NA_ROWS = 8
NA_COLS = 16

N_EXPERTS = 128
TOP_K = 8
N_GROUPS = 8
TOPK_GROUPS = 4
EXPERT_FF = D_MODEL // 4
SHARED_FF = D_MODEL // 4
ROUTED_SCALE = 2.5
MOE_BLOCK = 128

EVEN_IN = 8 * GROUP_WIDTH
ODD_IN = 7 * GROUP_WIDTH + 4 * ML_HEADS

kernel_name = 'hybrid_hgrn2_diffattn_mlstm_natten_moe'


def rms_norm(x, gain):
    xf = x.astype(F32)
    y = xf * lax.rsqrt(jnp.mean(xf * xf, axis=-1, keepdims=True) + EPS)
    return (y * gain.astype(F32)).astype(x.dtype)


def ada_modulation(c, w_mod, b_mod):
    m = (jnp.dot(jax.nn.silu(c), w_mod) + b_mod)[:, None, :]
    return jnp.split(m, 6, axis=-1)


def modulate(h, shift, scale):
    return h * (1 + scale) + shift


def to_chunks(t):
    b, h, T = t.shape[:3]
    return jnp.moveaxis(t.reshape(b, h, T // CHUNK, CHUNK, *t.shape[3:]), 2, 0)


def from_chunks(t):
    t = jnp.moveaxis(t, 0, 2)
    return t.reshape(t.shape[0], t.shape[1], -1, *t.shape[4:])


def flip_t(t):
    return jnp.flip(t, axis=2)


def hgrn2_scan(q, k, v, logf):
    b_, h_, _, dk = q.shape
    dv = v.shape[-1]
    mask = jnp.tril(jnp.ones((CHUNK, CHUNK), bool))

    def step(S, inp):
        qc, kc, vc, lfc = inp
        cum = jnp.cumsum(lfc, axis=2)
        diff = cum[:, :, :, None, :] - cum[:, :, None, :, :]
        w = jnp.exp(jnp.where(mask[:, :, None], diff, -jnp.inf))
        attn = jnp.einsum('bhtsd,bhsd->bhts', qc[:, :, :, None, :] * w, kc)
        o = jnp.einsum('bhts,bhse->bhte', attn, vc) + jnp.einsum('bhtd,bhde->bhte', qc * jnp.exp(cum), S)
        last = cum[:, :, -1:, :]
        S = jnp.exp(last[:, :, 0, :])[..., None] * S + jnp.einsum('bhsd,bhse->bhde', kc * jnp.exp(last - cum), vc)
        return S, o

    S0 = jnp.zeros((b_, h_, dk, dv), F32)
    _, o = lax.scan(step, S0, (to_chunks(q), to_chunks(k), to_chunks(v), to_chunks(logf)))
    return from_chunks(o)


def hgrn2_mixer(q, i, f_fwd, f_bwd, g, lb, norm_gain):
    B, T, _ = q.shape

    def heads(t):
        return t.reshape(B, T, HG_HEADS, HG_DIM).transpose(0, 2, 1, 3).astype(F32)

    qh = heads(jax.nn.silu(q))
    vh = heads(i)
    lb_h = lb.astype(F32).reshape(2, 1, HG_HEADS, 1, HG_DIM)

    def forget(fpre, lbd):
        fg = lbd + (1 - lbd) * jax.nn.sigmoid(heads(fpre))
        return 1 - fg, jnp.log(fg)

    kf, lff = forget(f_fwd, lb_h[0])
    kb, lfb = forget(f_bwd, lb_h[1])
    o_f = hgrn2_scan(qh, kf, vh, lff)
    o_b = flip_t(hgrn2_scan(flip_t(qh), flip_t(kb), flip_t(vh), flip_t(lfb)))
    o = rms_norm(o_f + o_b, norm_gain) * jax.nn.silu(heads(g))
    return o.transpose(0, 2, 1, 3).reshape(B, T, GROUP_WIDTH).astype(q.dtype)


def rope_partial(x, cos, sin):
    xr, xp = x[..., :ROPE_DIM], x[..., ROPE_DIM:]
    x1, x2 = xr[..., :ROPE_DIM // 2], xr[..., ROPE_DIM // 2:]
    rot = jnp.concatenate([x1 * cos - x2 * sin, x2 * cos + x1 * sin], axis=-1)
    return jnp.concatenate([rot.astype(x.dtype), xp], axis=-1)


def diff_attention(q, k, v, lq1, lk1, lq2, lk2, subln, layer_idx, cos, sin):
    B, T, _ = q.shape
    lambda_init = 0.8 - 0.6 * math.exp(-0.3 * layer_idx)
    lam = (jnp.exp(jnp.sum(lq1.astype(F32) * lk1.astype(F32)))
           - jnp.exp(jnp.sum(lq2.astype(F32) * lk2.astype(F32))) + lambda_init)
    qh = rope_partial(q.reshape(B, T, DA_HEADS, 2, DA_DIM).transpose(0, 2, 3, 1, 4), cos, sin)
    kh = rope_partial(k.reshape(B, T, DA_HEADS, 2, DA_DIM).transpose(0, 2, 3, 1, 4), cos, sin)
    vh = v.reshape(B, T, DA_HEADS, 2 * DA_DIM).transpose(0, 2, 1, 3)
    scale = DA_DIM ** -0.5
    nb = T // Q_BLOCK
    qb = jnp.moveaxis(qh.reshape(B, DA_HEADS, 2, nb, Q_BLOCK, DA_DIM), 3, 0)

    def block(qblk):
        s = jnp.einsum('bhmqd,bhmkd->bhmqk', qblk, kh).astype(F32) * scale
        p = jax.nn.softmax(s, axis=-1)
        a = p[:, :, 0] - lam * p[:, :, 1]
        return jnp.einsum('bhqk,bhkd->bhqd', a.astype(vh.dtype), vh)

    o = lax.map(block, qb)
    o = jnp.moveaxis(o, 0, 2).reshape(B, DA_HEADS, T, 2 * DA_DIM)
    o = rms_norm(o, subln) * (1 - lambda_init)
    return o.transpose(0, 2, 1, 3).reshape(B, T, GROUP_WIDTH).astype(q.dtype)


def mlstm_scan(q, k, v, ig, lf):
    b_, h_, _, dk = q.shape
    dv = v.shape[-1]
    mask = jnp.tril(jnp.ones((CHUNK, CHUNK), bool))

    def step(carry, inp):
        S, nvec, m = carry
        qc, kc, vc, ic, fc = inp
        cum = jnp.cumsum(fc, axis=-1)
        dmat = jnp.where(mask, cum[..., :, None] - cum[..., None, :] + ic[..., None, :], -jnp.inf)
        g = cum + m[..., None]
        mt = jnp.maximum(g, jnp.max(dmat, axis=-1))
        a = jnp.einsum('bhtd,bhsd->bhts', qc, kc) * jnp.exp(dmat - mt[..., None])
        inter = jnp.exp(g - mt)
        num = inter[..., None] * jnp.einsum('bhtd,bhde->bhte', qc, S) + jnp.einsum('bhts,bhse->bhte', a, vc)
        den = inter * jnp.einsum('bhtd,bhd->bht', qc, nvec) + jnp.sum(a, axis=-1)
        h = num / jnp.maximum(jnp.abs(den), jnp.exp(-mt))[..., None]
        last = cum[..., -1]
        ds = last[..., None] - cum + ic
        m_new = jnp.maximum(last + m, jnp.max(ds, axis=-1))
        decay = jnp.exp(last + m - m_new)
        ws = jnp.exp(ds - m_new[..., None])
        S = decay[..., None, None] * S + jnp.einsum('bhs,bhsd,bhse->bhde', ws, kc, vc)
        nvec = decay[..., None] * nvec + jnp.einsum('bhs,bhsd->bhd', ws, kc)
        return (S, nvec, m_new), h

    init = (jnp.zeros((b_, h_, dk, dv), F32), jnp.zeros((b_, h_, dk), F32), jnp.full((b_, h_), -1e30, F32))
    _, h = lax.scan(step, init, (to_chunks(q), to_chunks(k), to_chunks(v), to_chunks(ig), to_chunks(lf)))
    return from_chunks(h)


def short_conv_centred(x, w, b):
    C = x.shape[-1]
    y = lax.conv_general_dilated(x, w[:, None, :].astype(x.dtype), (1,), 'SAME',
                                 dimension_numbers=('NWC', 'WIO', 'NWC'), feature_group_count=C)
    return y + b.astype(x.dtype)


def mlstm_mixer(q, k, v, o, gates, i_bias, f_bias, conv_w, conv_b, norm_gain):
    B, T, _ = q.shape
    qk = jax.nn.silu(short_conv_centred(jnp.concatenate([q, k], axis=-1), conv_w, conv_b))
    q, k = jnp.split(qk, 2, axis=-1)

    def heads(t):
        return t.reshape(B, T, ML_HEADS, ML_DIM).transpose(0, 2, 1, 3).astype(F32)

    qh, kh, vh = heads(q), heads(k) * ML_DIM ** -0.5, heads(v)
    gt = gates.astype(F32).reshape(B, T, 2, 2, ML_HEADS).transpose(2, 3, 0, 4, 1)
    ig = gt[:, 0] + i_bias.astype(F32)[:, None, :, None]
    lf = jax.nn.log_sigmoid(gt[:, 1] + f_bias.astype(F32)[:, None, :, None])
    h_f = mlstm_scan(qh, kh, vh, ig[0], lf[0])
    h_b = flip_t(mlstm_scan(flip_t(qh), flip_t(kh), flip_t(vh), jnp.flip(ig[1], -1), jnp.flip(lf[1], -1)))
    h = rms_norm(h_f + h_b, norm_gain) * jax.nn.sigmoid(heads(o))
    return h.transpose(0, 2, 1, 3).reshape(B, T, GROUP_WIDTH).astype(v.dtype)


def neighbourhood_attention(q, k, v, rpb):
    B, T, _ = q.shape
    rows = T // GRID_W
    kr = min(NA_ROWS, rows)

    def grid(t):
        return t.reshape(B, rows, GRID_W, NA_HEADS, NA_DIM).transpose(0, 3, 1, 2, 4)

    qg, kg, vg = grid(q), grid(k), grid(v)
    col = np.arange(GRID_W)
    cstart = np.clip(col - NA_COLS // 2, 0, GRID_W - NA_COLS)
    cidx = cstart[:, None] + np.arange(NA_COLS)
    coff = cidx - col[:, None] + NA_COLS - 1
    rpb_c = rpb.astype(F32)[:, :, coff]
    scale = NA_DIM ** -0.5

    def row_block(r):
        rs = jnp.clip(r - kr // 2, 0, rows - kr)
        kw = lax.dynamic_slice_in_dim(kg, rs, kr, axis=2)[:, :, :, cidx]
        vw = lax.dynamic_slice_in_dim(vg, rs, kr, axis=2)[:, :, :, cidx]
        qr = lax.dynamic_index_in_dim(qg, r, axis=2, keepdims=False)
        s = jnp.einsum('bhcd,bhrcjd->bhcrj', qr, kw).astype(F32) * scale
        roff = rs + jnp.arange(kr) - r + NA_ROWS - 1
        s = s + jnp.take(rpb_c, roff, axis=1).transpose(0, 2, 1, 3)[None]
        p = jax.nn.softmax(s.reshape(B, NA_HEADS, GRID_W, kr * NA_COLS), axis=-1).reshape(s.shape)
        return jnp.einsum('bhcrj,bhrcjd->bhcd', p.astype(vw.dtype), vw)

    o = lax.map(row_block, jnp.arange(rows))
    return o.transpose(1, 0, 3, 2, 4).reshape(B, T, GROUP_WIDTH)


def moe_ffn(x, router, router_bias, exp_gate, exp_up, exp_down, sh_gate, sh_up, sh_down):
    B, T, D = x.shape
    n_tok = B * T
    xf = x.reshape(n_tok, D)
    scores = jax.nn.sigmoid(jnp.dot(xf, router).astype(F32))
    sel = scores + router_bias.astype(F32)
    grp_score = jnp.sum(lax.top_k(sel.reshape(n_tok, N_GROUPS, -1), 2)[0], axis=-1)
    grp_idx = lax.top_k(grp_score, TOPK_GROUPS)[1]
    grp_mask = jnp.any(grp_idx[:, :, None] == jnp.arange(N_GROUPS), axis=1)
    sel = jnp.where(jnp.repeat(grp_mask, N_EXPERTS // N_GROUPS, axis=1), sel, -jnp.inf)
    top_idx = lax.top_k(sel, TOP_K)[1]
    top_w = jnp.take_along_axis(scores, top_idx, axis=1)
    top_w = top_w / jnp.sum(top_w, axis=-1, keepdims=True) * ROUTED_SCALE
    n_asg = n_tok * TOP_K
    e_flat = top_idx.reshape(-1)
    order = jnp.argsort(e_flat)
    e_s = e_flat[order]
    tok_s = (order // TOP_K).astype(jnp.int32)
    w_s = top_w.reshape(-1)[order]
    counts = jnp.bincount(e_flat, length=N_EXPERTS)
    padded = (counts + MOE_BLOCK - 1) // MOE_BLOCK * MOE_BLOCK
    start = jnp.cumsum(counts) - counts
    pend = jnp.cumsum(padded)
    pstart = pend - padded
    pos = pstart[e_s] + jnp.arange(n_asg) - start[e_s]
    n_rows = n_asg + N_EXPERTS * MOE_BLOCK
    n_blk = n_rows // MOE_BLOCK
    row_tok = jnp.zeros((n_rows,), jnp.int32).at[pos].set(tok_s).reshape(n_blk, MOE_BLOCK)
    row_w = jnp.zeros((n_rows,), F32).at[pos].set(w_s).reshape(n_blk, MOE_BLOCK)
    blk_exp = jnp.minimum(jnp.searchsorted(pend, jnp.arange(n_blk) * MOE_BLOCK, side='right'), N_EXPERTS - 1)

    def expert_block(acc, inp):
        e, toks, wts = inp
        xb = xf[toks]
        hb = jax.nn.silu(xb @ exp_gate[e]) * (xb @ exp_up[e])
        yb = ((hb @ exp_down[e]).astype(F32) * wts[:, None]).astype(xf.dtype)
        return acc.at[toks].add(yb), None

    routed, _ = lax.scan(expert_block, jnp.zeros_like(xf), (blk_exp, row_tok, row_w))
    shared = (jax.nn.silu(xf @ sh_gate) * (xf @ sh_up)) @ sh_down
    return (routed + shared).reshape(B, T, D)


def even_layer(x, c, layer_idx, lb, cos, sin, norm1, norm2, w_mod, b_mod, w_in, w_out, hgrn_norm,
               lq1, lk1, lq2, lk2, subln, router, router_bias, exp_gate, exp_up, exp_down,
               sh_gate, sh_up, sh_down):
    sh1, sc1, g1, sh2, sc2, g2 = ada_modulation(c, w_mod, b_mod)
    h = modulate(rms_norm(x, norm1), sh1, sc1)
    aq, ai, af, ab, ag, bq, bk, bv = jnp.split(h @ w_in, 8, axis=-1)
    a_out = hgrn2_mixer(aq, ai, af, ab, ag, lb, hgrn_norm)
    b_out = diff_attention(bq, bk, bv, lq1, lk1, lq2, lk2, subln, layer_idx, cos, sin)
    x = x + g1 * (jnp.concatenate([a_out, b_out], axis=-1) @ w_out)
    h = modulate(rms_norm(x, norm2), sh2, sc2)
    return x + g2 * moe_ffn(h, router, router_bias, exp_gate, exp_up, exp_down, sh_gate, sh_up, sh_down)


def odd_layer(x, c, norm1, norm2, w_mod, b_mod, w_in, w_out, conv_w, conv_b, ml_i_bias, ml_f_bias,
              ml_norm, na_rpb, router, router_bias, exp_gate, exp_up, exp_down, sh_gate, sh_up, sh_down):
    sh1, sc1, g1, sh2, sc2, g2 = ada_modulation(c, w_mod, b_mod)
    h = modulate(rms_norm(x, norm1), sh1, sc1)
    G = GROUP_WIDTH
    splits = [G, 2 * G, 3 * G, 4 * G, 4 * G + 4 * ML_HEADS, 5 * G + 4 * ML_HEADS, 6 * G + 4 * ML_HEADS]
    cq, ck, cv, co, cg, dq, dk, dv = jnp.split(h @ w_in, splits, axis=-1)
    c_out = mlstm_mixer(cq, ck, cv, co, cg, ml_i_bias, ml_f_bias, conv_w, conv_b, ml_norm)
    d_out = neighbourhood_attention(dq, dk, dv, na_rpb)
    x = x + g1 * (jnp.concatenate([c_out, d_out], axis=-1) @ w_out)
    h = modulate(rms_norm(x, norm2), sh2, sc2)
    return x + g2 * moe_ffn(h, router, router_bias, exp_gate, exp_up, exp_down, sh_gate, sh_up, sh_down)


def setup_inputs(seed: int = 0) -> dict:
    key = jax.random.key(seed)
    keys = iter(jax.random.split(key, 64))

    def nrm(shape, scale):
        return jax.random.normal(next(keys), shape, jnp.float32) * scale

    def gain(n):
        return 1.0 + nrm((n,), 0.02)

    D = D_MODEL
    sd = D ** -0.5

    def moe(prefix):
        return {
            prefix + 'router': nrm((D, N_EXPERTS), sd),
            prefix + 'router_bias': nrm((N_EXPERTS,), 0.01),
            prefix + 'exp_gate': nrm((N_EXPERTS, D, EXPERT_FF), sd),
            prefix + 'exp_up': nrm((N_EXPERTS, D, EXPERT_FF), sd),
            prefix + 'exp_down': nrm((N_EXPERTS, EXPERT_FF, D), EXPERT_FF ** -0.5),
            prefix + 'sh_gate': nrm((D, SHARED_FF), sd),
            prefix + 'sh_up': nrm((D, SHARED_FF), sd),
            prefix + 'sh_down': nrm((SHARED_FF, D), SHARED_FF ** -0.5),
        }

    inp = {}
    inp['x'] = nrm((BATCH, SEQ, D), 1.0)
    inp['c'] = nrm((BATCH, D), 1.0)
    inp['hgrn_lb_logits'] = nrm((N_HGRN_LAYERS + 1, 2, GROUP_WIDTH), 0.5)
    inp['l0_norm1'] = gain(D)
    inp['l0_norm2'] = gain(D)
    inp['l0_w_mod'] = nrm((D, 6 * D), 0.5 * sd)
    inp['l0_b_mod'] = nrm((6 * D,), 0.02)
    inp['l0_w_in'] = nrm((D, EVEN_IN), sd)
    inp['l0_w_out'] = nrm((2 * GROUP_WIDTH, D), (2 * GROUP_WIDTH) ** -0.5)
    inp['l0_hgrn_norm'] = gain(HG_DIM)
    inp['l0_diff_lq1'] = nrm((DA_DIM,), 0.1)
    inp['l0_diff_lk1'] = nrm((DA_DIM,), 0.1)
    inp['l0_diff_lq2'] = nrm((DA_DIM,), 0.1)
    inp['l0_diff_lk2'] = nrm((DA_DIM,), 0.1)
    inp['l0_diff_subln'] = gain(2 * DA_DIM)
    inp.update(moe('l0_'))
    inp['l1_norm1'] = gain(D)
    inp['l1_norm2'] = gain(D)
    inp['l1_w_mod'] = nrm((D, 6 * D), 0.5 * sd)
    inp['l1_b_mod'] = nrm((6 * D,), 0.02)
    inp['l1_w_in'] = nrm((D, ODD_IN), sd)
    inp['l1_w_out'] = nrm((2 * GROUP_WIDTH, D), (2 * GROUP_WIDTH) ** -0.5)
    inp['l1_conv_w'] = nrm((ML_CONV, 2 * GROUP_WIDTH), ML_CONV ** -0.5)
    inp['l1_conv_b'] = nrm((2 * GROUP_WIDTH,), 0.02)
    inp['l1_ml_i_bias'] = nrm((2, ML_HEADS), 0.1)
    inp['l1_ml_f_bias'] = jnp.linspace(3.0, 6.0, ML_HEADS, dtype=jnp.float32)[None, :] + nrm((2, ML_HEADS), 0.1)
    inp['l1_ml_norm'] = gain(ML_DIM)
    inp['l1_na_rpb'] = nrm((NA_HEADS, 2 * NA_ROWS - 1, 2 * NA_COLS - 1), 0.02)
    inp.update(moe('l1_'))
    inp['final_norm'] = gain(D)
    return inp


def reference(x, c, hgrn_lb_logits,
              l0_norm1, l0_norm2, l0_w_mod, l0_b_mod, l0_w_in, l0_w_out, l0_hgrn_norm,
              l0_diff_lq1, l0_diff_lk1, l0_diff_lq2, l0_diff_lk2, l0_diff_subln,
              l0_router, l0_router_bias, l0_exp_gate, l0_exp_up, l0_exp_down,
              l0_sh_gate, l0_sh_up, l0_sh_down,
              l1_norm1, l1_norm2, l1_w_mod, l1_b_mod, l1_w_in, l1_w_out,
              l1_conv_w, l1_conv_b, l1_ml_i_bias, l1_ml_f_bias, l1_ml_norm, l1_na_rpb,
              l1_router, l1_router_bias, l1_exp_gate, l1_exp_up, l1_exp_down,
              l1_sh_gate, l1_sh_up, l1_sh_down,
              final_norm):
    T = x.shape[1]
    lb_all = jnp.cumsum(jax.nn.softmax(hgrn_lb_logits.astype(F32), axis=0), axis=0)
    pos = jnp.arange(T, dtype=F32)
    inv_freq = ROPE_THETA ** (-jnp.arange(0, ROPE_DIM, 2, dtype=F32) / ROPE_DIM)
    ang = pos[:, None] * inv_freq[None, :]
    cos, sin = jnp.cos(ang), jnp.sin(ang)
    layer_params = [
        (l0_norm1, l0_norm2, l0_w_mod, l0_b_mod, l0_w_in, l0_w_out, l0_hgrn_norm,
         l0_diff_lq1, l0_diff_lk1, l0_diff_lq2, l0_diff_lk2, l0_diff_subln,
         l0_router, l0_router_bias, l0_exp_gate, l0_exp_up, l0_exp_down, l0_sh_gate, l0_sh_up, l0_sh_down),
        (l1_norm1, l1_norm2, l1_w_mod, l1_b_mod, l1_w_in, l1_w_out,
         l1_conv_w, l1_conv_b, l1_ml_i_bias, l1_ml_f_bias, l1_ml_norm, l1_na_rpb,
         l1_router, l1_router_bias, l1_exp_gate, l1_exp_up, l1_exp_down, l1_sh_gate, l1_sh_up, l1_sh_down),
    ]
    for layer in range(DEPTH):
        if layer % 2 == 0:
            x = even_layer(x, c, layer, lb_all[layer // 2], cos, sin, *layer_params[layer])
        else:
            x = odd_layer(x, c, *layer_params[layer])
    return rms_norm(x, final_norm)
```

```cpp
#include <hip/hip_runtime.h>
#include <cstdio>
#include <cstdint>

namespace pg8 {
#define PG8_LAS __attribute__((address_space(3)))
typedef unsigned short bf16_t;
typedef short bf16x8 __attribute__((ext_vector_type(8)));
typedef float f32x4 __attribute__((ext_vector_type(4)));
typedef unsigned u32x4 __attribute__((ext_vector_type(4)));
constexpr int BM = 256, BK = 64, HALF = 128, HTB = HALF * BK * 2  , STAGE_BYTES = 8 * HTB, NXCD = 8, WGM = 8;

__host__ __device__ __forceinline__ int lds_byte(int r, int c) { const int st = (r >> 4) * 2 + (c >> 5), rr = r & 15, cc = c & 31, ob = rr * 64 + cc * 2; return st * 1024 + (ob ^ (((ob >> 9) & 1) << 5)); }
__host__ __device__ __forceinline__ void stage_rc(int b, int& R, int& C) { const int st = b / 1024, sb = b % 1024, swz = sb ^ (((sb >> 9) & 1) << 5); R = (st >> 1) * 16 + swz / 64; C = (st & 1) * 32 + (swz % 64) / 2; }
__host__ __device__ __forceinline__ int perm32(int rho) { const int n = rho >> 4, i = rho & 15; return 8 * (i >> 2) + 4 * n + (i & 3); }

__device__ __forceinline__ int fresh_lane() { int l; asm volatile("v_mbcnt_lo_u32_b32 %0, -1, 0\n\tv_mbcnt_hi_u32_b32 %0, -1, %0" : "=v"(l)); return l; }

struct Unit { int pn, arow0, nvalid, bt; };

struct DenseOrder {
    int nM, nN, nwg, G, c;
    __device__ __forceinline__ void init(int M, int N, int G_, int c_) { nM = M / BM; nN = N / BM; nwg = nM * nN; G = G_; c = c_; }
    __device__ __forceinline__ bool next(int i, Unit& u) const {
        const long L = (long)i * G + c; if (L >= nwg) return false;
        int wgid = (int)L; { const int q = nwg / NXCD, r = nwg % NXCD, xcd = wgid % NXCD, off = wgid / NXCD; wgid = (xcd < r ? xcd * (q + 1) : r * (q + 1) + (xcd - r) * q) + off; }
        const int nig = WGM * nN, gid = wgid / nig, fm = gid * WGM, gsz = (nM - fm) < WGM ? (nM - fm) : WGM;
        const int pm = fm + ((wgid % nig) % gsz); u.pn = (wgid % nig) / gsz; u.arow0 = pm * BM; u.nvalid = BM; u.bt = u.pn; return true;
    }
    __device__ __forceinline__ int arow(const Unit& u, int r) const { return u.arow0 + r; }
};

__device__ __forceinline__ unsigned cvt_pk_bf16(float lo, float hi) { unsigned r; asm volatile("v_cvt_pk_bf16_f32 %0, %1, %2" : "=v"(r) : "v"(lo), "v"(hi)); return r; }

template <class Epi, class Sched, bool ALIGN_EPI>
__device__ __forceinline__ void gemm_phase(PG8_LAS unsigned char* lds, const bf16_t* A, const bf16_t* Bt, const int K, const Sched& S, const Epi& E, const int wid  ) {
    int tid = wid * 64 + pg8::fresh_lane(); asm volatile("" : "+v"(tid));
    const int lane = tid & 63, wr = wid >> 2, wc = wid & 3, fr = lane & 15, fq = lane >> 4;
    const int nt = K / BK;
    unsigned voffB[2];
#pragma unroll
    for (int i = 0; i < 2; ++i) { int R, C; stage_rc(tid * 16 + i * 8192, R, C); const int Rb = Epi::PERM ? ((R & ~31) + perm32(R & 31)) : R;
        voffB[i] = (unsigned)(Rb * K + C) * 2u; }
#define PG8_AOFF(U, o00, o01, o10, o11) do { int _t = wid * 64 + pg8::fresh_lane(); asm volatile("" : "+v"(_t)); int _R0, _C0, _R1, _C1; stage_rc(_t * 16, _R0, _C0); stage_rc(_t * 16 + 8192, _R1, _C1); \
        o00 = (unsigned)S.arow(U, _R0) * K2 + (unsigned)_C0 * 2u; o01 = (unsigned)S.arow(U, _R1) * K2 + (unsigned)_C1 * 2u; \
        o10 = (unsigned)S.arow(U, HALF + _R0) * K2 + (unsigned)_C0 * 2u; o11 = (unsigned)S.arow(U, HALF + _R1) * K2 + (unsigned)_C1 * 2u; } while (0)
    const unsigned K2 = (unsigned)K * 2u;
    const unsigned kstep = (unsigned)(BK * 2);
    const size_t hstep = (size_t)HALF * K * 2;
    const size_t tstep = 2 * hstep;
    const unsigned ldsw = (unsigned)wid * 1024u;
    const int aoff = lds_byte(wr * 64 + fr, fq * 8), boff = lds_byte(wc * 32 + fr, fq * 8);
    const char* Ab = (const char*)A; const char* Bb = (const char*)Bt;
#define PG8_SA(b, h) (((b) * 2 + (h)) * HTB)
#define PG8_SB(b, h) ((4 + (b) * 2 + (h)) * HTB)
#define PG8_STAGE_B(bufoff, gbase) do { _Pragma("unroll") for (int _i = 0; _i < 2; ++_i) \
        __builtin_amdgcn_global_load_lds((const unsigned*)((const char*)(gbase) + voffB[_i]), (PG8_LAS unsigned*)(lds + (bufoff) + ldsw + _i * 8192), 16, 0, 0); } while (0)
#define PG8_STAGE_A(bufoff, kbyte, o0, o1) do { \
        __builtin_amdgcn_global_load_lds((const unsigned*)(Ab + (size_t)((kbyte) + (o0))), (PG8_LAS unsigned*)(lds + (bufoff) + ldsw), 16, 0, 0); \
        __builtin_amdgcn_global_load_lds((const unsigned*)(Ab + (size_t)((kbyte) + (o1))), (PG8_LAS unsigned*)(lds + (bufoff) + ldsw + 8192), 16, 0, 0); } while (0)
#define PG8_LDA(dst, b, h) do { _Pragma("unroll") for (int m = 0; m < 4; ++m) _Pragma("unroll") for (int k = 0; k < 2; ++k) dst[m][k] = *(const PG8_LAS bf16x8*)(lds + PG8_SA(b, h) + aoff + m * 2048 + k * 1024); } while (0)
#define PG8_LDB(dst, b, h) do { _Pragma("unroll") for (int n = 0; n < 2; ++n) _Pragma("unroll") for (int k = 0; k < 2; ++k) dst[n][k] = *(const PG8_LAS bf16x8*)(lds + PG8_SB(b, h) + boff + n * 2048 + k * 1024); } while (0)
#define PG8_MMA(ai, bj, At, Bt_) do { __builtin_amdgcn_s_setprio(1); _Pragma("unroll") for (int m = 0; m < 4; ++m) _Pragma("unroll") for (int n = 0; n < 2; ++n) _Pragma("unroll") for (int k = 0; k < 2; ++k) \
        acc[ai][bj][m][n] = __builtin_amdgcn_mfma_f32_16x16x32_bf16(Bt_[n][k], At[m][k], acc[ai][bj][m][n], 0, 0, 0); __builtin_amdgcn_s_setprio(0); } while (0)
#define PG8_WAIT_V(n) asm volatile("s_waitcnt vmcnt(" #n ")" ::: "memory")
#define PG8_WAIT_L(n) asm volatile("s_waitcnt lgkmcnt(" #n ")" ::: "memory")
#define PG8_BAR __builtin_amdgcn_s_barrier()
#define PG8_SCHED __builtin_amdgcn_sched_barrier(0)
    Unit cur, nxt; int ui = 0;
    if (!S.next(0, cur)) return;
    f32x4 acc[2][2][4][2];
#pragma unroll
    for (int a = 0; a < 2; ++a)
#pragma unroll
        for (int b = 0; b < 2; ++b)
#pragma unroll
            for (int m = 0; m < 4; ++m)
#pragma unroll
                for (int n = 0; n < 2; ++n) acc[a][b][m][n] = (f32x4){0.f, 0.f, 0.f, 0.f};
    bf16x8 At[4][2], B0[2][2], B1[2][2];
    unsigned c00, c01, c10, c11, n00, n01, n10, n11;
    PG8_AOFF(cur, c00, c01, c10, c11);
    const char* cB = Bb + (size_t)cur.bt * tstep;
    PG8_STAGE_B(PG8_SB(0, 0), cB); PG8_STAGE_B(PG8_SB(0, 1), cB + hstep); PG8_STAGE_A(PG8_SA(0, 0), 0u, c00, c01); PG8_STAGE_A(PG8_SA(0, 1), 0u, c10, c11);
    if (wr == 1) PG8_BAR;
    PG8_WAIT_V(2); PG8_BAR;
    PG8_STAGE_B(PG8_SB(1, 0), cB + kstep); PG8_STAGE_A(PG8_SA(1, 0), kstep, c00, c01); PG8_STAGE_B(PG8_SB(1, 1), cB + hstep + kstep);
    PG8_WAIT_V(6); PG8_BAR;
    for (;;) {
        const bool has_next = S.next(ui + 1, nxt);
        if (has_next) { PG8_AOFF(nxt, n00, n01, n10, n11); } else { n00 = c00; n01 = c01; n10 = c10; n11 = c11; }
        const char* nB = has_next ? Bb + (size_t)nxt.bt * tstep : cB;
        for (int t = 0; t < nt; t += 2) {
            const bool last = (t == nt - 2);
            const unsigned kb1 = (unsigned)(t + 1) * kstep;
            const unsigned kb2 = last ? 0u : (unsigned)(t + 2) * kstep, kb3 = kb2 + kstep;
            const unsigned a00 = last ? n00 : c00, a01 = last ? n01 : c01, a10 = last ? n10 : c10, a11 = last ? n11 : c11;
            const char* b2 = last ? nB : cB + (size_t)(t + 2) * kstep; const char* b3 = b2 + kstep;
            PG8_LDB(B0, 0, 0); PG8_LDB(B1, 0, 1); PG8_SCHED; PG8_LDA(At, 0, 0); PG8_STAGE_A(PG8_SA(1, 1), kb1, c10, c11);
            PG8_WAIT_V(8); PG8_WAIT_L(0); PG8_BAR; PG8_MMA(0, 0, At, B0); PG8_MMA(0, 1, At, B1); PG8_BAR; PG8_SCHED;
            PG8_LDA(At, 0, 1); PG8_STAGE_B(PG8_SB(0, 0), b2); PG8_STAGE_B(PG8_SB(0, 1), b2 + hstep); PG8_STAGE_A(PG8_SA(0, 0), kb2, a00, a01);
            PG8_WAIT_V(8); PG8_WAIT_L(0); PG8_BAR; PG8_MMA(1, 0, At, B0); PG8_MMA(1, 1, At, B1); PG8_BAR; PG8_SCHED;
            PG8_LDB(B0, 1, 0); PG8_LDB(B1, 1, 1); PG8_SCHED; PG8_LDA(At, 1, 0); PG8_STAGE_A(PG8_SA(0, 1), kb2, a10, a11);
            PG8_WAIT_V(8); PG8_WAIT_L(0); PG8_BAR; PG8_MMA(0, 0, At, B0); PG8_MMA(0, 1, At, B1); PG8_BAR; PG8_SCHED;
            PG8_LDA(At, 1, 1); PG8_STAGE_B(PG8_SB(1, 0), b3); PG8_STAGE_B(PG8_SB(1, 1), b3 + hstep); PG8_STAGE_A(PG8_SA(1, 0), kb3, a00, a01);
            PG8_WAIT_V(8); PG8_WAIT_L(0); PG8_BAR; PG8_MMA(1, 0, At, B0); PG8_MMA(1, 1, At, B1); PG8_BAR; PG8_SCHED;
        }
        if constexpr (ALIGN_EPI) { if (wr == 0) PG8_BAR; }
        E(acc, cur, wr, wc, fr, fq);
        if (!has_next) break;
#pragma unroll
        for (int a = 0; a < 2; ++a)
#pragma unroll
            for (int b = 0; b < 2; ++b)
#pragma unroll
                for (int m = 0; m < 4; ++m)
#pragma unroll
                    for (int n = 0; n < 2; ++n) acc[a][b][m][n] = (f32x4){0.f, 0.f, 0.f, 0.f};
        cur = nxt; cB = nB; c00 = n00; c01 = n01; c10 = n10; c11 = n11; ++ui;
        if constexpr (ALIGN_EPI) { if (wr == 1) PG8_BAR; }
    }
    PG8_WAIT_V(0);
    if constexpr (!ALIGN_EPI) { if (wr == 0) PG8_BAR; }
    PG8_BAR;
#undef PG8_AOFF
#undef PG8_SA
#undef PG8_SB
#undef PG8_STAGE_A
#undef PG8_STAGE_B
#undef PG8_LDA
#undef PG8_LDB
#undef PG8_MMA
#undef PG8_WAIT_V
#undef PG8_WAIT_L
#undef PG8_BAR
#undef PG8_SCHED
}
}
constexpr int NB = 8, NT_ = 4096, DM = 1024, NTOK = NB * NT_;
constexpr int GW = 512;
constexpr int P0W = 4096, P1W = 3840;
constexpr int NEXP = 128, EFF = 256, NSLOT = NTOK * 8, NSLOT_ALL = NSLOT + NTOK;
constexpr float EPS = 1e-6f;
constexpr int NWAVES = 8;

constexpr size_t MiB = 1u << 20;
constexpr size_t WS_CTL = 0, CTL_ZERO_BYTES = 1 * MiB;
constexpr size_t WS_TAB = 1 * MiB;
constexpr size_t WS_MOD = WS_TAB + 256 * 1024;
constexpr size_t WS_WIN0 = 2 * MiB, WS_WIN1 = 10 * MiB, WS_WOUT0 = 18 * MiB, WS_WOUT1 = 20 * MiB, WS_ROUT0 = 22 * MiB, WS_ROUT1 = 23 * MiB;
constexpr size_t WS_GU = 24 * MiB;
constexpr size_t WS_DN = 153 * MiB;
constexpr size_t WS_H2A = 218 * MiB;
constexpr size_t WS_PROJ = 282 * MiB;
constexpr size_t WS_CAT = 538 * MiB;
constexpr size_t WS_OF = 602 * MiB, WS_OB = 666 * MiB;
constexpr size_t WS_QKC = 730 * MiB;
constexpr size_t WS_Y = 218 * MiB;
constexpr size_t WS_HB = 794 * MiB;
constexpr size_t WS_H2B = 794 * MiB;
constexpr size_t WS_LOG = 938 * MiB;
constexpr size_t WS_TOPI = 970 * MiB, WS_TOPW = 971 * MiB, WS_RANK = 972 * MiB, WS_SLOT = 973 * MiB, WS_LIST = 974 * MiB;
constexpr size_t WS_END = 976 * MiB;
constexpr int CW_TMO = 0, CW_BAR = 4096, CW_Q0 = 8192, CW_Q1 = 8256, CW_CNT0 = 8448, CW_CNT1 = 8704;

constexpr int RING_BYTES = 131072;
constexpr int LDSCTL_OFF = RING_BYTES, MISC_OFF = LDSCTL_OFF + 320;
constexpr int LDS_BYTES = 147456;
constexpr int TBL_OFF = MISC_OFF + 128;

#define GAS __attribute__((address_space(1)))
#define LAS __attribute__((address_space(3)))
typedef unsigned short bf16;
typedef unsigned v4u __attribute__((ext_vector_type(4)));
typedef float f32x4 __attribute__((ext_vector_type(4)));
typedef short bf16x8 __attribute__((ext_vector_type(8)));
typedef GAS unsigned gu32;
typedef GAS unsigned long long gu64;
#define RLX_AGENT __ATOMIC_RELAXED, __HIP_MEMORY_SCOPE_AGENT
#define LDS_WAIT() asm volatile("s_waitcnt lgkmcnt(0)" ::: "memory")
#define VM_WAIT() asm volatile("s_waitcnt vmcnt(0)" ::: "memory")
__device__ __forceinline__ unsigned long long rt() { return __builtin_amdgcn_s_memrealtime(); }
__device__ __forceinline__ unsigned f2bf(float f) { unsigned u = __builtin_bit_cast(unsigned, f); return (u + 0x7fffu + ((u >> 16) & 1u)) >> 16; }
__device__ __forceinline__ unsigned pk2(float lo, float hi) { return f2bf(lo) | (f2bf(hi) << 16); }
#define XB_TMO      128
#define XB_XCNT(j)  (256  + 64 * (j))
#define XB_XSUB(j)  (1280 + 64 * (j))
#define XB_XGEN(j)  (2304 + 64 * (j))
#define XB_TOP      3328
#define XB_TOPGEN   3392
#define XCD_BAR_WORDS 3456
#define XB_SPIN_CAP (1u << 18)

__device__ __forceinline__ unsigned xb_ld(unsigned* p)              { return __hip_atomic_load(p, __ATOMIC_RELAXED, __HIP_MEMORY_SCOPE_AGENT); }
__device__ __forceinline__ unsigned xb_add(unsigned* p, unsigned v) { return __hip_atomic_fetch_add(p, v, __ATOMIC_RELAXED, __HIP_MEMORY_SCOPE_AGENT); }
__device__ __forceinline__ unsigned xb_xcc_id() { return (unsigned)__builtin_amdgcn_s_getreg((3 << 11) | 20) & 0xFu; }
#define XB_SPIN(cond, bar) do { unsigned _sp = 0; while (cond) { __builtin_amdgcn_s_sleep(1); \
    if ((++_sp & 255u) == 0u) { if (xb_ld(&(bar)[XB_TMO])) break; if (_sp > XB_SPIN_CAP) { atomicAdd(&(bar)[XB_TMO], 1u); break; } } } } while (0)

struct XcdBarrier {
    unsigned* bar; unsigned x;
    volatile LAS unsigned* st;
};

__device__ __forceinline__ XcdBarrier xcd_barrier_post(unsigned* bar, volatile LAS unsigned* st) {
    XcdBarrier b; b.bar = bar; b.x = xb_xcc_id(); b.st = st;
    if (threadIdx.x == 0) (void)xb_add(&bar[XB_XCNT(b.x)], 1u);
    return b;
}
__device__ __forceinline__ void xcd_barrier_complete(unsigned* bar, unsigned x, unsigned& nloc, unsigned& nx) {
    const unsigned G = gridDim.x * gridDim.y * gridDim.z;
    unsigned sum, cnt, mine, sp = 0u;
    for (;;) {
        sum = 0u; cnt = 0u; mine = 0u;
#pragma unroll
        for (unsigned j = 0; j < 16; ++j) { const unsigned c = xb_ld(&bar[XB_XCNT(j)]); sum += c; cnt += (c > 0u) ? 1u : 0u; mine = (j == x) ? c : mine; }
        if (sum == G) break;
        __builtin_amdgcn_s_sleep(1);
        if ((++sp & 255u) == 0u) { if (xb_ld(&bar[XB_TMO])) break; if (sp > XB_SPIN_CAP) { atomicAdd(&bar[XB_TMO], 1u); break; } }
    }
    nloc = mine > 0u ? mine : 1u; nx = cnt > 0u ? cnt : 1u;
}

__device__ __forceinline__ void xcd_barrier(const XcdBarrier& b) {
    asm volatile("s_waitcnt vmcnt(0)" ::: "memory");
    __syncthreads();
    if (threadIdx.x == 0) {
        unsigned* bar = b.bar;
        __builtin_amdgcn_s_waitcnt(0);
        unsigned nloc = b.st[0], nx = b.st[1];
        if (nloc == 0u) { xcd_barrier_complete(bar, b.x, nloc, nx); b.st[0] = nloc; b.st[1] = nx; }
        const unsigned old = xb_add(&bar[XB_XSUB(b.x)], 1u);
        const unsigned gen = old / nloc;
        if (old + 1u == (gen + 1u) * nloc) {
            __builtin_amdgcn_fence(__ATOMIC_RELEASE, "agent");
            asm volatile("s_waitcnt vmcnt(0)" ::: "memory");
            const unsigned og = xb_add(&bar[XB_TOP], 1u);
            const unsigned tg = og / nx;
            if (og + 1u == (tg + 1u) * nx) xb_add(&bar[XB_TOPGEN], 1u);
            else XB_SPIN(xb_ld(&bar[XB_TOPGEN]) == tg, bar);
            __builtin_amdgcn_fence(__ATOMIC_ACQUIRE, "agent");
            xb_add(&bar[XB_XGEN(b.x)], 1u);
            asm volatile("s_waitcnt vmcnt(0)" ::: "memory");
        } else {
            XB_SPIN(xb_ld(&bar[XB_XGEN(b.x)]) == gen, bar);
            __builtin_amdgcn_fence(__ATOMIC_ACQUIRE, "agent");
            asm volatile("s_waitcnt vmcnt(0)" ::: "memory");
        }
    }
    __syncthreads();
}
typedef float f32x2 __attribute__((ext_vector_type(2)));
typedef unsigned u32x2 __attribute__((ext_vector_type(2)));
__device__ __forceinline__ float bflo(unsigned w) { return __builtin_bit_cast(float, w << 16); }
__device__ __forceinline__ float bfhi(unsigned w) { return __builtin_bit_cast(float, w & 0xffff0000u); }
__device__ __forceinline__ float bf2f(bf16 b) { return __builtin_bit_cast(float, (unsigned)b << 16); }
__device__ __forceinline__ float wave_sum(float v) {
#pragma unroll
    for (int o = 1; o < 64; o <<= 1) v += __shfl_xor(v, o);
    return v;
}
__device__ __forceinline__ float sigm(float x) { return 1.f / (1.f + __expf(-x)); }
__device__ __forceinline__ float silu(float x) { return x / (1.f + __expf(-x)); }
__device__ __forceinline__ void unpack8(v4u w, float (&f)[8]) { f[0] = bflo(w.x); f[1] = bfhi(w.x); f[2] = bflo(w.y); f[3] = bfhi(w.y); f[4] = bflo(w.z); f[5] = bfhi(w.z); f[6] = bflo(w.w); f[7] = bfhi(w.w); }
__device__ __forceinline__ v4u pack8(const float (&f)[8]) { v4u w; w.x = pk2(f[0], f[1]); w.y = pk2(f[2], f[3]); w.z = pk2(f[4], f[5]); w.w = pk2(f[6], f[7]); return w; }

__device__ __forceinline__ void tr_item(const float* W, int ldw, int k0, int c0, int cvalid, bf16* WT, int ldt, int r0, LAS float* scr, int lane) {
#pragma unroll 8
    for (int i = 0; i < 32; ++i) { const int kk = 2 * i + (lane >> 5), n = lane & 31; scr[kk * 33 + n] = (n < cvalid) ? W[(size_t)(k0 + kk) * ldw + c0 + n] : 0.f; }
    LDS_WAIT(); asm volatile("" ::: "memory");
    const int c = lane & 7;
#pragma unroll
    for (int j = 0; j < 4; ++j) { const int n = (lane >> 3) + 8 * j; const LAS float* s = scr + (8 * c) * 33 + n;
        v4u o; o.x = pk2(s[0 * 33], s[1 * 33]); o.y = pk2(s[2 * 33], s[3 * 33]); o.z = pk2(s[4 * 33], s[5 * 33]); o.w = pk2(s[6 * 33], s[7 * 33]);
        *(v4u*)(WT + (size_t)(r0 + n) * ldt + k0 + 8 * c) = o; }
    LDS_WAIT(); asm volatile("" ::: "memory");
}
__device__ __forceinline__ void expert_item(const float* gate, const float* up, const float* down, const float* sgate, const float* sup, const float* sdown,
                                            bf16* GU, bf16* DN, int it, LAS float* scr, int lane) {
    const int e = it / 384, r = it - e * 384;
    const bool sh = (e == NEXP);
    if (r < 256) {
        const bool isup = r >= 128; const int rr = r & 127, sub = rr >> 6, q = rr & 63, kb = q >> 2, nb = q & 3;
        const float* W = sh ? (isup ? sup : sgate) : ((isup ? up : gate) + (size_t)e * (DM * EFF));
        tr_item(W, EFF, kb * 64, sub * 128 + nb * 32, 32, GU + (size_t)e * (512 * DM), DM, 256 * sub + (isup ? 128 : 0) + nb * 32, scr, lane);
    } else {
        const int rr = r - 256, kb = rr >> 5, nb = rr & 31;
        const float* W = sh ? sdown : down + (size_t)e * (EFF * DM);
        tr_item(W, DM, kb * 64, nb * 32, 32, DN + (size_t)e * (DM * EFF), EFF, nb * 32, scr, lane);
    }
}
#define TR_JOB(W_, ldw_, K_, c0_, ncols_, WT_, r0_) do { const int _nb = ((ncols_) + 31) / 32, _ni = ((K_) / 64) * _nb; \
        for (int _it = (gw + NGW - (jbase % NGW)) % NGW; _it < _ni; _it += NGW) { const int _kb = _it / _nb, _nk = _it % _nb; const int _cv = (ncols_) - _nk * 32; \
            tr_item(W_, ldw_, _kb * 64, (c0_) + _nk * 32, _cv < 32 ? _cv : 32, WT_, K_, (r0_) + _nk * 32, scr, lane); } jbase += _ni; } while (0)

__device__ __forceinline__ void mod_unit(int u, const float* c, const float* wm0, const float* bm0, const float* wm1, const float* bm1, float* MOD, LAS unsigned char* lds, int tid, int wave, int lane) {
    LAS float* sc = (LAS float*)(lds + 69632);
    LAS float* red = (LAS float*)(lds + 69632 + 32768);
    const int l = u / 96, cb = u % 96; const float* wm = l ? wm1 : wm0; const float* bm = l ? bm1 : bm0;
    for (int i = tid; i < NB * DM; i += 512) sc[i] = silu(c[i]);
    __syncthreads();
    float acc[8];
#pragma unroll
    for (int b = 0; b < 8; ++b) acc[b] = 0.f;
    const float* wp = wm + (size_t)(wave * 128) * 6144 + cb * 64 + lane;
    for (int k0 = 0; k0 < 128; k0 += 8) {
        float w[8];
#pragma unroll
        for (int j = 0; j < 8; ++j) w[j] = wp[(size_t)(k0 + j) * 6144];
#pragma unroll
        for (int j = 0; j < 8; ++j)
#pragma unroll
            for (int b = 0; b < 8; ++b) acc[b] += sc[b * DM + wave * 128 + k0 + j] * w[j];
    }
#pragma unroll
    for (int b = 0; b < 8; ++b) red[(wave * 8 + b) * 64 + lane] = acc[b];
    __syncthreads();
    { const int b = tid >> 6; float s = 0.f;
#pragma unroll
      for (int w = 0; w < 8; ++w) s += red[(w * 8 + b) * 64 + lane];
      MOD[(size_t)(l * 8 + b) * 6144 + cb * 64 + lane] = s + bm[cb * 64 + lane]; }
    __syncthreads();
}

__device__ __forceinline__ void normmod_row(const f32x4 (&v)[4], const float* gain, const float* shift, const float* scale, bf16* orow, int lane) {
    float ss = 0.f;
#pragma unroll
    for (int j = 0; j < 4; ++j) ss += (v[j].x * v[j].x + v[j].y * v[j].y) + (v[j].z * v[j].z + v[j].w * v[j].w);
    const float r = 1.f / sqrtf(wave_sum(ss) * (1.f / DM) + EPS);
    unsigned long long* o8 = (unsigned long long*)orow + lane;
#pragma unroll
    for (int j = 0; j < 4; ++j) { const f32x4 g = ((const f32x4*)gain)[lane + 64 * j], sh = ((const f32x4*)shift)[lane + 64 * j], sc = ((const f32x4*)scale)[lane + 64 * j];
        const f32x4 y = v[j] * r * g * (sc + 1.f) + sh;
        o8[64 * j] = (unsigned long long)pk2(y.x, y.y) | ((unsigned long long)pk2(y.z, y.w) << 32); }
}
__device__ __forceinline__ void normmod_phase(const float* X, const float* gain, const float* modl  , int sh_off, int sc_off, bf16* H, int gw, int NGW, int lane) {
    for (int m = gw; m < NTOK; m += NGW) {
        const f32x4* xr = (const f32x4*)(X + (size_t)m * DM) + lane; f32x4 v[4];
#pragma unroll
        for (int j = 0; j < 4; ++j) v[j] = xr[64 * j];
        const float* mb = modl + (size_t)(m >> 12) * 6144;
        normmod_row(v, gain, mb + sh_off, mb + sc_off, H + (size_t)m * DM, lane);
    }
}
__device__ __forceinline__ void finalnorm_row(const f32x4 (&v)[4], const float* gain, float* orow, int lane) {
    float ss = 0.f;
#pragma unroll
    for (int j = 0; j < 4; ++j) ss += (v[j].x * v[j].x + v[j].y * v[j].y) + (v[j].z * v[j].z + v[j].w * v[j].w);
    const float r = 1.f / sqrtf(wave_sum(ss) * (1.f / DM) + EPS);
#pragma unroll
    for (int j = 0; j < 4; ++j) ((f32x4*)orow)[lane + 64 * j] = v[j] * r * ((const f32x4*)gain)[lane + 64 * j];
}

__device__ __forceinline__ void rope_phase(bf16* P, const float* tab, int gtid, int NGT) {
    for (int idx = gtid; idx < NTOK * 16; idx += NGT) {
        const int tok = idx >> 4, grp = idx & 15, t = tok & (NT_ - 1);
        bf16* p = P + (size_t)tok * P0W + (grp < 8 ? 2560 : 3072) + (grp & 7) * 64;
        const v4u a = *(const v4u*)p, b = *(const v4u*)(p + 8);
        float x1[8], x2[8], cs[8], sn[8], y1[8], y2[8];
        unpack8(a, x1); unpack8(b, x2);
        const f32x4* tp = (const f32x4*)(tab + (size_t)t * 16);
        const f32x4 c0 = tp[0], c1 = tp[1], s0 = tp[2], s1 = tp[3];
        cs[0] = c0.x; cs[1] = c0.y; cs[2] = c0.z; cs[3] = c0.w; cs[4] = c1.x; cs[5] = c1.y; cs[6] = c1.z; cs[7] = c1.w;
        sn[0] = s0.x; sn[1] = s0.y; sn[2] = s0.z; sn[3] = s0.w; sn[4] = s1.x; sn[5] = s1.y; sn[6] = s1.z; sn[7] = s1.w;
#pragma unroll
        for (int i = 0; i < 8; ++i) { y1[i] = x1[i] * cs[i] - x2[i] * sn[i]; y2[i] = x2[i] * cs[i] + x1[i] * sn[i]; }
        *(v4u*)p = pack8(y1); *(v4u*)(p + 8) = pack8(y2);
    }
}

template <int ACT  >
__device__ __forceinline__ void gateout_phase(const float* OF, const float* OB, const float* gain, const bf16* P, int pitch, int gcol, bf16* CAT, int gw, int NGW, int lane) {
    const int hh = lane >> 4, e0 = (lane & 15) * 8;
    const f32x4 g0 = *(const f32x4*)(gain + e0), g1 = *(const f32x4*)(gain + e0 + 4);
    for (int m = gw; m < NTOK; m += NGW) {
        const float* pf = OF + (size_t)m * GW + hh * 128 + e0; const float* pb = OB + (size_t)m * GW + hh * 128 + e0;
        const f32x4 a0 = *(const f32x4*)pf + *(const f32x4*)pb, a1 = *(const f32x4*)(pf + 4) + *(const f32x4*)(pb + 4);
        float ss = (a0.x * a0.x + a0.y * a0.y) + (a0.z * a0.z + a0.w * a0.w) + (a1.x * a1.x + a1.y * a1.y) + (a1.z * a1.z + a1.w * a1.w);
        ss += __shfl_xor(ss, 1); ss += __shfl_xor(ss, 2); ss += __shfl_xor(ss, 4); ss += __shfl_xor(ss, 8);
        const float r = 1.f / sqrtf(ss * (1.f / 128.f) + EPS);
        float gv[8]; unpack8(*(const v4u*)(P + (size_t)m * pitch + gcol + hh * 128 + e0), gv);
        float y[8];
        const f32x4 n0 = a0 * r * g0, n1 = a1 * r * g1;
        y[0] = n0.x; y[1] = n0.y; y[2] = n0.z; y[3] = n0.w; y[4] = n1.x; y[5] = n1.y; y[6] = n1.z; y[7] = n1.w;
#pragma unroll
        for (int i = 0; i < 8; ++i) y[i] *= (ACT == 0) ? silu(gv[i]) : sigm(gv[i]);
        *(v4u*)(CAT + (size_t)m * DM + hh * 128 + e0) = pack8(y);
    }
}

struct EpiStoreBf16 {
    static constexpr bool PERM = true;
    bf16* O; int ldc;
    __device__ __forceinline__ void operator()(const pg8::f32x4 (&acc)[2][2][4][2], const pg8::Unit& u, int wr, int wc, int fr, int fq) const {
        const int row0 = u.arow0 + wr * 64 + fr, col0 = u.pn * 256 + wc * 32 + 8 * fq;
#pragma unroll
        for (int ai = 0; ai < 2; ++ai)
#pragma unroll
            for (int m = 0; m < 4; ++m) { bf16* rowp = O + (size_t)(row0 + ai * 128 + m * 16) * ldc + col0;
#pragma unroll
                for (int bj = 0; bj < 2; ++bj) { const pg8::f32x4 v0 = acc[ai][bj][m][0], v1 = acc[ai][bj][m][1];
                    v4u w; w.x = pg8::cvt_pk_bf16(v0[0], v0[1]); w.y = pg8::cvt_pk_bf16(v0[2], v0[3]); w.z = pg8::cvt_pk_bf16(v1[0], v1[1]); w.w = pg8::cvt_pk_bf16(v1[2], v1[3]);
                    *(v4u*)(rowp + bj * 128) = w; } }
    }
};
struct EpiResid {
    static constexpr bool PERM = false;
    const float* xin; float* out; const float* gm;
    __device__ __forceinline__ void operator()(const pg8::f32x4 (&acc)[2][2][4][2], const pg8::Unit& u, int wr, int wc, int fr, int fq) const {
        const int row0 = u.arow0 + wr * 64 + fr, col0 = u.pn * 256 + wc * 32 + 4 * fq;
#pragma unroll
        for (int ai = 0; ai < 2; ++ai)
#pragma unroll
            for (int m = 0; m < 4; ++m) { const int row = row0 + ai * 128 + m * 16; const float* gp = gm + (size_t)(row >> 12) * 6144 + col0; const size_t ro = (size_t)row * DM + col0;
#pragma unroll
                for (int bj = 0; bj < 2; ++bj)
#pragma unroll
                    for (int n = 0; n < 2; ++n) { const int c = bj * 128 + n * 16;
                        const pg8::f32x4 x4 = *(const pg8::f32x4*)(xin + ro + c), g4 = *(const pg8::f32x4*)(gp + c);
                        *(pg8::f32x4*)(out + ro + c) = x4 + g4 * acc[ai][bj][m][n]; } }
    }
};
struct EpiF32 {
    static constexpr bool PERM = false;
    float* C; int ldc;
    __device__ __forceinline__ void operator()(const pg8::f32x4 (&acc)[2][2][4][2], const pg8::Unit& u, int wr, int wc, int fr, int fq) const {
        const int row0 = u.arow0 + wr * 64 + fr, col0 = u.pn * 256 + wc * 32 + 4 * fq;
#pragma unroll
        for (int ai = 0; ai < 2; ++ai)
#pragma unroll
            for (int m = 0; m < 4; ++m) { float* rowp = C + (size_t)(row0 + ai * 128 + m * 16) * ldc + col0;
#pragma unroll
                for (int bj = 0; bj < 2; ++bj)
#pragma unroll
                    for (int n = 0; n < 2; ++n) *(pg8::f32x4*)(rowp + bj * 128 + n * 16) = acc[ai][bj][m][n]; }
    }
};
struct EpiGateUp {
    static constexpr bool PERM = true;
    bf16* HB;
    __device__ __forceinline__ void operator()(const pg8::f32x4 (&acc)[2][2][4][2], const pg8::Unit& u, int wr, int wc, int fr, int fq) const {
        const int col0 = u.pn * 128 + wc * 32 + 8 * fq;
#pragma unroll
        for (int ai = 0; ai < 2; ++ai)
#pragma unroll
            for (int m = 0; m < 4; ++m) { const int rl = ai * 128 + wr * 64 + m * 16 + fr;
                float y[8];
#pragma unroll
                for (int n = 0; n < 2; ++n)
#pragma unroll
                    for (int j = 0; j < 4; ++j) y[4 * n + j] = silu(acc[ai][0][m][n][j]) * acc[ai][1][m][n][j];
                if (rl < u.nvalid) *(v4u*)(HB + (size_t)(u.arow0 + rl) * EFF + col0) = pack8(y); }
    }
};
struct EpiDown {
    static constexpr bool PERM = true;
    bf16* Y;
    __device__ __forceinline__ void operator()(const pg8::f32x4 (&acc)[2][2][4][2], const pg8::Unit& u, int wr, int wc, int fr, int fq) const {
        const int col0 = u.pn * 256 + wc * 32 + 8 * fq;
#pragma unroll
        for (int ai = 0; ai < 2; ++ai)
#pragma unroll
            for (int m = 0; m < 4; ++m) { const int rl = ai * 128 + wr * 64 + m * 16 + fr; bf16* rowp = Y + (size_t)(u.arow0 + rl) * DM + col0;
#pragma unroll
                for (int bj = 0; bj < 2; ++bj) { const pg8::f32x4 v0 = acc[ai][bj][m][0], v1 = acc[ai][bj][m][1];
                    v4u w; w.x = pg8::cvt_pk_bf16(v0[0], v0[1]); w.y = pg8::cvt_pk_bf16(v0[2], v0[3]); w.z = pg8::cvt_pk_bf16(v1[0], v1[1]); w.w = pg8::cvt_pk_bf16(v1[2], v1[3]);
                    if (rl < u.nvalid) *(v4u*)(rowp + bj * 128) = w; } }
    }
};

__device__ __forceinline__ void moe_tables(const unsigned* cntg, LAS int* tb, int tid) {
    LAS int* cnt = tb; LAS int* start = tb + 130; LAS int* tpre = tb + 260;
    __syncthreads();
    if (tid < NEXP) cnt[tid] = (int)__hip_atomic_load(cntg + tid, __ATOMIC_RELAXED, __HIP_MEMORY_SCOPE_AGENT);
    if (tid == NEXP) cnt[NEXP] = NTOK;
    __syncthreads();
    if (tid == 0) { int s = 0, t = 0; for (int e = 0; e < NEXP; ++e) { start[e] = s; tpre[e] = t; s += cnt[e]; t += (cnt[e] + 255) >> 8; }
        start[NEXP] = NSLOT; tpre[NEXP] = t; t += NTOK / 256; start[NEXP + 1] = NSLOT_ALL; tpre[NEXP + 1] = t; }
    __syncthreads();
}
struct GroupOrder {
    const LAS int* cnt; const LAS int* start; const LAS int* tpre; const int* list; int ntc, total, G, c;
    __device__ __forceinline__ void init(const LAS int* tb, const int* list_, int ntc_, int G_, int c_) { cnt = tb; start = tb + 130; tpre = tb + 260; list = list_; ntc = ntc_; total = tpre[NEXP + 1] * ntc_; G = G_; c = c_; }
    __device__ __forceinline__ bool next(int i, pg8::Unit& u) const {
        const int L = i * G + c; if (L >= total) return false;
        const int rt = L / ntc, pn = L - rt * ntc;
        int lo = 0, hi = NEXP + 1;
#pragma unroll 1
        while (hi - lo > 1) { const int mid = (lo + hi) >> 1; if (tpre[mid] <= rt) lo = mid; else hi = mid; }
        const int j = rt - tpre[lo], rem = cnt[lo] - 256 * j;
        u.pn = pn; u.arow0 = start[lo] + 256 * j; u.nvalid = rem < 256 ? rem : 256; u.bt = lo * ntc + pn; return true;
    }
    __device__ __forceinline__ int arow(const pg8::Unit& u, int r) const { const int idx = u.arow0 + (r < u.nvalid ? r : u.nvalid - 1); return list ? list[idx] : idx; }
};

__device__ __forceinline__ void topk_phase(const float* LOG, const float* rbias, int* TOPI, float* TOPW, int* RANK, unsigned* cntg, int gw, int NGW, int lane) {
    const f32x2 bias = *(const f32x2*)(rbias + 2 * lane);
    for (int tok = gw; tok < NTOK; tok += NGW) {
        const f32x2 lg = *(const f32x2*)(LOG + (size_t)tok * 256 + 2 * lane);
        const float s0 = sigm(lg.x), s1 = sigm(lg.y);
        float v0 = s0 + bias.x, v1 = s1 + bias.y;
        float m1 = fmaxf(v0, v1), m2 = fminf(v0, v1);
#pragma unroll
        for (int off = 1; off < 8; off <<= 1) { const float o1 = __shfl_xor(m1, off), o2 = __shfl_xor(m2, off); const float n1 = fmaxf(m1, o1), n2 = fmaxf(fminf(m1, o1), fmaxf(m2, o2)); m1 = n1; m2 = n2; }
        const float gs = m1 + m2; const int myg = lane >> 3; int better = 0;
#pragma unroll
        for (int g = 0; g < 8; ++g) { const float sg = __shfl(gs, g * 8); better += (sg > gs || (sg == gs && g < myg)) ? 1 : 0; }
        if (better >= 4) { v0 = -INFINITY; v1 = -INFINITY; }
        int my_e = 0; float my_s = 0.f, ssum = 0.f;
#pragma unroll
        for (int k = 0; k < 8; ++k) {
            float bv = (v0 >= v1) ? v0 : v1; int bi = (v0 >= v1) ? 2 * lane : 2 * lane + 1;
#pragma unroll
            for (int off = 32; off >= 1; off >>= 1) { const float ov = __shfl_xor(bv, off); const int oi = __shfl_xor(bi, off); if (ov > bv || (ov == bv && oi < bi)) { bv = ov; bi = oi; } }
            const float ws = __shfl((bi & 1) ? s1 : s0, bi >> 1);
            if (lane == (bi >> 1)) { if (bi & 1) v1 = -INFINITY; else v0 = -INFINITY; }
            if (lane == k) { my_e = bi; my_s = ws; }
            ssum += ws;
        }
        if (lane < 8) {
            const unsigned rk = __hip_atomic_fetch_add(cntg + my_e, 1u, __ATOMIC_RELAXED, __HIP_MEMORY_SCOPE_AGENT);
            TOPI[tok * 8 + lane] = my_e; TOPW[tok * 8 + lane] = my_s / ssum * 2.5f; RANK[tok * 8 + lane] = (int)rk;
        }
    }
}
__device__ __forceinline__ void list_phase(const int* TOPI, const int* RANK, int* SLOT, int* LIST, const LAS int* tb, int gtid, int NGT) {
    const LAS int* start = tb + 130;
    for (int p = gtid; p < NSLOT; p += NGT) { const int s = start[TOPI[p]] + RANK[p]; SLOT[p] = s; LIST[s] = p >> 3; }
    for (int i = gtid; i < NTOK; i += NGT) LIST[NSLOT + i] = i;
}
__device__ __forceinline__ void combine_phase(float* X, const bf16* Y, const int* SLOT, const float* TOPW, const float* modl, int g_off,
                                              const float* ngain, const float* modn, int sh_off, int sc_off, bf16* H, const float* fgain, int gw, int NGW, int lane) {
    for (int m = gw; m < NTOK; m += NGW) {
        f32x4 acc[4];
#pragma unroll
        for (int j = 0; j < 4; ++j) acc[j] = (f32x4){0.f, 0.f, 0.f, 0.f};
        const int sl = (lane < 8) ? SLOT[m * 8 + lane] : NSLOT + m; const float wl = (lane < 8) ? TOPW[m * 8 + lane] : 1.f;
#pragma unroll
        for (int k = 0; k < 9; ++k) { const int s = __shfl(sl, k); const float w = __shfl(wl, k);
            const u32x2* yr = (const u32x2*)(Y + (size_t)s * DM) + lane;
#pragma unroll
            for (int j = 0; j < 4; ++j) { const u32x2 q = yr[64 * j]; acc[j] += (f32x4){bflo(q.x), bfhi(q.x), bflo(q.y), bfhi(q.y)} * w; } }
        f32x4* xr = (f32x4*)(X + (size_t)m * DM) + lane; const float* mb = modl + (size_t)(m >> 12) * 6144; f32x4 v[4];
#pragma unroll
        for (int j = 0; j < 4; ++j) v[j] = xr[64 * j] + ((const f32x4*)(mb + g_off))[lane + 64 * j] * acc[j];
        if (fgain) finalnorm_row(v, fgain, X + (size_t)m * DM, lane);
        else {
#pragma unroll
            for (int j = 0; j < 4; ++j) xr[64 * j] = v[j];
            const float* mn = modn + (size_t)(m >> 12) * 6144;
            normmod_row(v, ngain, mn + sh_off, mn + sc_off, H + (size_t)m * DM, lane);
        }
    }
}
__device__ __forceinline__ int q_pull(gu32* head, volatile LAS unsigned* slot, int tid) {
    __syncthreads();
    if (tid == 0) *slot = __hip_atomic_fetch_add(head, 1u, RLX_AGENT);
    __syncthreads();
    return (int)*slot;
}

__device__ __forceinline__ void hgrn_unit(int u, const bf16* P, const float* lbl, float* OF, float* OB, LAS unsigned char* lds, int tid) {
    const int b = u >> 3, h = (u >> 1) & 3, dir = u & 1, e = tid & 127, dg = tid >> 7;
    LAS float* Qs = (LAS float*)lds; LAS float* Ks = Qs + 2048; LAS float* Fs = Ks + 2048; LAS float* Vs = Fs + 2048; LAS float* PO = Vs + 2048;
    float* OUT = dir ? OB : OF;
    const float l0 = lbl[dir * GW + h * 128 + e], l1 = lbl[2 * GW + dir * GW + h * 128 + e];
    const float lb = 1.f / (1.f + __expf(l1 - l0));
    f32x2 S[16];
#pragma unroll
    for (int i = 0; i < 16; ++i) S[i] = (f32x2){0.f, 0.f};
    const int fcol = (dir ? 1536 : 1024) + h * 128 + e;
    for (int jb = 0; jb < NT_ / 16; ++jb) {
#pragma unroll
        for (int r = 0; r < 4; ++r) { const int tt = r * 4 + dg; const int t = dir ? (NT_ - 1 - (jb * 16 + tt)) : (jb * 16 + tt);
            const bf16* row = P + (size_t)(b * NT_ + t) * P0W;
            const float q = bf2f(row[h * 128 + e]), v = bf2f(row[512 + h * 128 + e]), f = bf2f(row[fcol]);
            const float fg = lb + (1.f - lb) * sigm(f);
            Qs[tt * 128 + e] = silu(q); Ks[tt * 128 + e] = 1.f - fg; Fs[tt * 128 + e] = fg; Vs[tt * 128 + e] = v; }
        __syncthreads();
#pragma unroll 1
        for (int tt = 0; tt < 16; ++tt) {
            const float v = Vs[tt * 128 + e]; f32x2 po = (f32x2){0.f, 0.f};
            const LAS f32x2* fp = (const LAS f32x2*)(Fs + tt * 128 + dg * 32); const LAS f32x2* kp = (const LAS f32x2*)(Ks + tt * 128 + dg * 32); const LAS f32x2* qp = (const LAS f32x2*)(Qs + tt * 128 + dg * 32);
#pragma unroll
            for (int i = 0; i < 16; ++i) { S[i] = fp[i] * S[i] + kp[i] * v; po += S[i] * qp[i]; }
            PO[(tt * 4 + dg) * 128 + e] = po.x + po.y;
        }
        __syncthreads();
#pragma unroll
        for (int r = 0; r < 4; ++r) { const int tt = r * 4 + dg; const int t = dir ? (NT_ - 1 - (jb * 16 + tt)) : (jb * 16 + tt);
            const float o = (PO[(tt * 4 + 0) * 128 + e] + PO[(tt * 4 + 1) * 128 + e]) + (PO[(tt * 4 + 2) * 128 + e] + PO[(tt * 4 + 3) * 128 + e]);
            OUT[(size_t)(b * NT_ + t) * GW + h * 128 + e] = o; }
    }
    __syncthreads();
}

__device__ __forceinline__ void convqk_phase(const bf16* P, const float* cw, const float* cb, bf16* QKC, int gtid, int NGT) {
    for (int idx = gtid; idx < NTOK * 128; idx += NGT) {
        const int tok = idx >> 7, c0 = (idx & 127) * 8, t = tok & (NT_ - 1);
        float acc[8];
#pragma unroll
        for (int i = 0; i < 8; ++i) acc[i] = cb[c0 + i];
#pragma unroll
        for (int j = 0; j < 5; ++j) { const int tj = t + j - 2;
            if (tj >= 0 && tj < NT_) { float x[8]; unpack8(*(const v4u*)(P + (size_t)(tok + j - 2) * P1W + c0), x);
#pragma unroll
                for (int i = 0; i < 8; ++i) acc[i] += cw[j * 1024 + c0 + i] * x[i]; } }
        const float sc = (c0 >= GW) ? 0.08838834764831845f : 1.f;
#pragma unroll
        for (int i = 0; i < 8; ++i) acc[i] = silu(acc[i]) * sc;
        *(v4u*)(QKC + (size_t)tok * DM + c0) = pack8(acc);
    }
}
__device__ __forceinline__ void mlstm_unit(int u, const bf16* P, const bf16* QKC, const float* ibias, const float* fbias, float* HF, float* HBk, LAS unsigned char* lds, int tid) {
    const int b = u >> 3, h = (u >> 1) & 3, dir = u & 1, e = tid & 127, dg = tid >> 7, lane = tid & 63, wave = tid >> 6;
    LAS float* Qs = (LAS float*)lds; LAS float* Ks = Qs + 2048; LAS float* Vs = Ks + 2048; LAS float* PO = Vs + 2048;
    LAS float* Fs = PO + 8192; LAS float* DEN = Fs + 16;
    float* OUT = dir ? HBk : HF;
    const float ib = ibias[dir * 4 + h], fb = fbias[dir * 4 + h];
    f32x2 C[16];
#pragma unroll
    for (int i = 0; i < 16; ++i) C[i] = (f32x2){0.f, 0.f};
    float nst = 0.f;
    const bool nw = ((wave & 1) == 0);
    for (int jb = 0; jb < NT_ / 16; ++jb) {
#pragma unroll
        for (int r = 0; r < 4; ++r) { const int tt = r * 4 + dg; const int t = dir ? (NT_ - 1 - (jb * 16 + tt)) : (jb * 16 + tt);
            const size_t tok = (size_t)(b * NT_ + t);
            const bf16* row = P + tok * P1W;
            const float gi = bf2f(row[3584 + dir * 8 + h]) + ib, gf = bf2f(row[3584 + dir * 8 + 4 + h]) + fb;
            const float w = __expf(gi);
            Qs[tt * 128 + e] = bf2f(QKC[tok * DM + h * 128 + e]); Ks[tt * 128 + e] = bf2f(QKC[tok * DM + GW + h * 128 + e]) * w; Vs[tt * 128 + e] = bf2f(row[1024 + h * 128 + e]);
            if (e == 0) Fs[tt] = sigm(gf); }
        __syncthreads();
#pragma unroll 1
        for (int tt = 0; tt < 16; ++tt) {
            const float v = Vs[tt * 128 + e], f = Fs[tt]; f32x2 po = (f32x2){0.f, 0.f};
            const LAS f32x2* kp = (const LAS f32x2*)(Ks + tt * 128 + dg * 32); const LAS f32x2* qp = (const LAS f32x2*)(Qs + tt * 128 + dg * 32);
#pragma unroll
            for (int i = 0; i < 16; ++i) { C[i] = C[i] * f + kp[i] * v; po += C[i] * qp[i]; }
            PO[(tt * 4 + dg) * 128 + e] = po.x + po.y;
            if (nw) { const int d = dg * 32 + (lane & 31);
                nst = nst * f + Ks[tt * 128 + d]; float pd = (lane < 32) ? nst * Qs[tt * 128 + d] : 0.f;
                pd += __shfl_xor(pd, 1); pd += __shfl_xor(pd, 2); pd += __shfl_xor(pd, 4); pd += __shfl_xor(pd, 8); pd += __shfl_xor(pd, 16);
                if (lane == 0) DEN[tt * 4 + dg] = pd; }
        }
        __syncthreads();
#pragma unroll
        for (int r = 0; r < 4; ++r) { const int tt = r * 4 + dg; const int t = dir ? (NT_ - 1 - (jb * 16 + tt)) : (jb * 16 + tt);
            const float num = (PO[(tt * 4 + 0) * 128 + e] + PO[(tt * 4 + 1) * 128 + e]) + (PO[(tt * 4 + 2) * 128 + e] + PO[(tt * 4 + 3) * 128 + e]);
            const float den = (DEN[tt * 4 + 0] + DEN[tt * 4 + 1]) + (DEN[tt * 4 + 2] + DEN[tt * 4 + 3]);
            OUT[(size_t)(b * NT_ + t) * GW + h * 128 + e] = num / fmaxf(fabsf(den), 1.f); }
    }
    __syncthreads();
}

__device__ __forceinline__ void na_unit(int u, const bf16* P, const float* rpb, bf16* CAT, int tid) {
    const int b = u >> 6, r = u & 63, col = tid & 63, head = tid >> 6;
    const int tok = b * NT_ + r * 64 + col;
    int rs = r - 4; rs = rs < 0 ? 0 : (rs > 56 ? 56 : rs);
    int cs = col - 8; cs = cs < 0 ? 0 : (cs > 48 ? 48 : cs);
    float q[64], acc[64];
#pragma unroll
    for (int c = 0; c < 8; ++c) { float t8[8]; unpack8(*(const v4u*)(P + (size_t)tok * P1W + 2048 + head * 64 + c * 8), t8);
#pragma unroll
        for (int i = 0; i < 8; ++i) { q[c * 8 + i] = t8[i] * 0.125f; acc[c * 8 + i] = 0.f; } }
    float mx = -INFINITY, l = 0.f;
#pragma unroll 1
    for (int i = 0; i < 8; ++i) {
        const float* bp = rpb + head * 465 + (rs + i - r + 7) * 31 + (cs - col + 15);
#pragma unroll 1
        for (int j = 0; j < 16; ++j) {
            const bf16* kr = P + (size_t)(b * NT_ + (rs + i) * 64 + cs + j) * P1W + 2560 + head * 64;
            float s = bp[j];
#pragma unroll
            for (int c = 0; c < 8; ++c) { float t8[8]; unpack8(*(const v4u*)(kr + c * 8), t8);
#pragma unroll
                for (int d = 0; d < 8; ++d) s += q[c * 8 + d] * t8[d]; }
            const float mn = fmaxf(mx, s), a = __expf(mx - mn), p = __expf(s - mn);
            l = l * a + p; mx = mn;
            const bf16* vr = kr + 512;
#pragma unroll
            for (int c = 0; c < 8; ++c) { float t8[8]; unpack8(*(const v4u*)(vr + c * 8), t8);
#pragma unroll
                for (int d = 0; d < 8; ++d) acc[c * 8 + d] = acc[c * 8 + d] * a + p * t8[d]; }
        }
    }
    const float il = 1.f / l;
#pragma unroll
    for (int c = 0; c < 8; ++c) { float y[8];
#pragma unroll
        for (int d = 0; d < 8; ++d) y[d] = acc[c * 8 + d] * il;
        *(v4u*)(CAT + (size_t)tok * DM + GW + head * 64 + c * 8) = pack8(y); }
}

namespace da {
using bf16x8 = __attribute__((ext_vector_type(8))) short;
using s16x4  = __attribute__((ext_vector_type(4))) short;
using f32x16 = __attribute__((ext_vector_type(16))) float;
constexpr float SCALE = 0.125f;
constexpr float THR = 8.f;
constexpr int KVBLK = 64, SHM_V = 16384, SHM_K = 16384;
#define DA_KSWZ(row, colB) ((row) * 256 + ((colB) ^ (((row) & 7) << 4)))
#define DA_SBAR() __builtin_amdgcn_sched_barrier(0)
__device__ __forceinline__ int crow(int r, int hi) { return (r & 3) + 8 * (r >> 2) + 4 * hi; }
__device__ __forceinline__ unsigned cvtpk(float lo, float hi) { unsigned r; asm volatile("v_cvt_pk_bf16_f32 %0, %1, %2" : "=v"(r) : "v"(lo), "v"(hi)); return r; }
__device__ __forceinline__ void partialSM(f32x16& p0, f32x16& p1, float& m_reg, float& mn, float& alpha) {
  constexpr float C = SCALE * 1.4426950408889634f;
  float pmax = p0[0];
#pragma unroll
  for (int r = 1; r < 16; ++r) pmax = fmaxf(pmax, p0[r]);
#pragma unroll
  for (int r = 0; r < 16; ++r) pmax = fmaxf(pmax, p1[r]);
  { auto rr = __builtin_amdgcn_permlane32_swap(__float_as_uint(pmax), __float_as_uint(pmax), false, false);
    pmax = fmaxf(__uint_as_float(rr[0]), __uint_as_float(rr[1])); }
  if (__builtin_expect(__all(pmax - m_reg <= THR / SCALE), 1)) { mn = m_reg; alpha = 1.f; }
  else { mn = fmaxf(m_reg, pmax); alpha = __builtin_amdgcn_exp2f((m_reg - mn) * C); m_reg = mn; }
  float mnC = -mn * C;
#pragma unroll
  for (int r = 0; r < 16; ++r) p0[r] = fmaf(p0[r], C, mnC);
#pragma unroll
  for (int r = 0; r < 16; ++r) p1[r] = fmaf(p1[r], C, mnC);
#pragma unroll
  for (int r = 0; r < 16; ++r) p0[r] = __builtin_amdgcn_exp2f(p0[r]);
}
__device__ __forceinline__ void finishSM(f32x16& p0, f32x16& p1, float alpha, float& l_reg, bf16x8& pa0, bf16x8& pa1, bf16x8& pa2, bf16x8& pa3) {
#pragma unroll
  for (int r = 0; r < 16; ++r) p1[r] = __builtin_amdgcn_exp2f(p1[r]);
  float ps = 0;
#pragma unroll
  for (int r = 0; r < 16; ++r) ps += p0[r];
#pragma unroll
  for (int r = 0; r < 16; ++r) ps += p1[r];
  { auto rr = __builtin_amdgcn_permlane32_swap(__float_as_uint(ps), __float_as_uint(ps), false, false);
    ps = __uint_as_float(rr[0]) + __uint_as_float(rr[1]); }
  l_reg = l_reg * alpha + ps;
#define DA_PK4(P, BASE, OUT) do { unsigned a0 = cvtpk(P[BASE + 0], P[BASE + 1]), a1 = cvtpk(P[BASE + 2], P[BASE + 3]);   \
    unsigned b0 = cvtpk(P[BASE + 4], P[BASE + 5]), b1 = cvtpk(P[BASE + 6], P[BASE + 7]);                              \
    auto r0 = __builtin_amdgcn_permlane32_swap(a0, b0, false, false); auto r1 = __builtin_amdgcn_permlane32_swap(a1, b1, false, false); \
    v4u w = {r0[0], r1[0], r0[1], r1[1]}; OUT = __builtin_bit_cast(bf16x8, w); } while (0)
  DA_PK4(p0, 0, pa0); DA_PK4(p0, 8, pa1); DA_PK4(p1, 0, pa2); DA_PK4(p1, 8, pa3);
#undef DA_PK4
}
__device__ __forceinline__ void qkt(f32x16& p0, f32x16& p1, const LAS char* Ks, const bf16x8 (&qr)[4], int r32, int hi, int mapB) {
  p0 = f32x16{}; p1 = f32x16{};
#pragma unroll
  for (int d0 = 0; d0 < 4; ++d0) { const int cb = mapB + (d0 * 16 + hi * 8) * 2;
    const bf16x8 b0 = *(const LAS bf16x8*)(Ks + DA_KSWZ(r32, cb));
    const bf16x8 b1 = *(const LAS bf16x8*)(Ks + DA_KSWZ(32 + r32, cb));
    p0 = __builtin_amdgcn_mfma_f32_32x32x16_bf16(b0, qr[d0], p0, 0, 0, 0);
    p1 = __builtin_amdgcn_mfma_f32_32x32x16_bf16(b1, qr[d0], p1, 0, 0, 0); }
}
__device__ __forceinline__ int v_st(int k, int c) { const int kk = (k & ~0xC) | ((k & 4) << 1) | ((k & 8) >> 1); return ((kk >> 3) * 4 + (c >> 5)) * 512 + ((kk & 7) * 32 + (c & 31)) * 2; }
__device__ __forceinline__ int v_rd_base(int lane) { return ((lane & 3) << 3) | (((lane >> 2) & 3) << 6) | (((lane >> 4) & 1) << 5) | (((lane >> 5) & 1) << 8); }
constexpr int v_rd_off(int d0, int ks, int half) { return d0 * 512 + ks * 4096 + half * 2048; }
template <int OFF> __device__ __forceinline__ s16x4 tr_read(int vb) {
  s16x4 r; asm volatile("ds_read_b64_tr_b16 %0, %1 offset:%2" : "=&v"(r) : "v"(vb), "i"(OFF) : "memory"); return r;
}
template <int D0> __device__ __forceinline__ void pv_one(f32x16& od, int vb, bf16x8 pa0, bf16x8 pa1, bf16x8 pa2, bf16x8 pa3) {
  const s16x4 l0 = tr_read<v_rd_off(D0, 0, 0)>(vb), h0 = tr_read<v_rd_off(D0, 0, 1)>(vb), l1 = tr_read<v_rd_off(D0, 1, 0)>(vb), h1 = tr_read<v_rd_off(D0, 1, 1)>(vb);
  const s16x4 l2 = tr_read<v_rd_off(D0, 2, 0)>(vb), h2 = tr_read<v_rd_off(D0, 2, 1)>(vb), l3 = tr_read<v_rd_off(D0, 3, 0)>(vb), h3 = tr_read<v_rd_off(D0, 3, 1)>(vb);
  asm volatile("s_waitcnt lgkmcnt(0)" ::: "memory"); DA_SBAR();
#define DA_PK(L, H) (bf16x8){L[0], L[1], L[2], L[3], H[0], H[1], H[2], H[3]}
  od = __builtin_amdgcn_mfma_f32_32x32x16_bf16(pa0, DA_PK(l0, h0), od, 0, 0, 0);
  od = __builtin_amdgcn_mfma_f32_32x32x16_bf16(pa1, DA_PK(l1, h1), od, 0, 0, 0);
  od = __builtin_amdgcn_mfma_f32_32x32x16_bf16(pa2, DA_PK(l2, h2), od, 0, 0, 0);
  od = __builtin_amdgcn_mfma_f32_32x32x16_bf16(pa3, DA_PK(l3, h3), od, 0, 0, 0);
#undef DA_PK
}
__device__ __forceinline__ void pv_d0(f32x16 (&o)[4], int vb, bf16x8 pa0, bf16x8 pa1, bf16x8 pa2, bf16x8 pa3) {
  pv_one<0>(o[0], vb, pa0, pa1, pa2, pa3); pv_one<1>(o[1], vb, pa0, pa1, pa2, pa3); pv_one<2>(o[2], vb, pa0, pa1, pa2, pa3); pv_one<3>(o[3], vb, pa0, pa1, pa2, pa3);
}
__device__ __forceinline__ void unit(int u, const bf16* P, float lam, const float* subln, bf16* CAT, LAS char* lds, int tid) {
  const int qb = u & 31, h = (u >> 5) & 3, b = u >> 7;
  const int wid = tid >> 6, lane = tid & 63, r32 = lane & 31, hi = lane >> 5, mp = wid >> 2, wq = wid & 3;
  LAS char* V_lds = lds; LAS char* K_lds = lds + 2 * SHM_V;
  LAS float* ws = (LAS float*)(lds + 2 * SHM_V + 2 * SHM_K) + wid * 64; LAS float* li_l = ws; LAS float* al_l = ws + 32;
  float m_reg = -1e30f, l_reg = 0; f32x16 o[4] = {}; bf16x8 qr[4];
  const size_t rowbase = (size_t)b * NT_;
  const bf16* Qw = P + (rowbase + qb * 128 + wq * 32 + r32) * P0W + 2560 + h * 128 + mp * 64 + hi * 8;
#pragma unroll
  for (int d0 = 0; d0 < 4; ++d0) qr[d0] = *(const bf16x8*)(Qw + d0 * 16);
  const bf16* Kh = P + rowbase * P0W + 3072 + h * 128; const bf16* Vh = P + rowbase * P0W + 3584 + h * 128;
  const int mapB = mp * 128;
  const int sr = tid >> 4, sc = (tid & 15) * 8, vst0 = v_st(sr, sc), vst1 = v_st(32 + sr, sc);
  const int vb0 = (int)(uintptr_t)V_lds + v_rd_base(lane);
  struct { bf16x8 vs0, vs1, ks0, ks1; } sr_[2];
#define DA_SLOAD(i, k0) do { sr_[i].vs0 = *(const bf16x8*)(&Vh[(size_t)((k0) + sr) * P0W + sc]); sr_[i].vs1 = *(const bf16x8*)(&Vh[(size_t)((k0) + 32 + sr) * P0W + sc]); \
    sr_[i].ks0 = *(const bf16x8*)(&Kh[(size_t)((k0) + sr) * P0W + sc]); sr_[i].ks1 = *(const bf16x8*)(&Kh[(size_t)((k0) + 32 + sr) * P0W + sc]); } while (0)
#define DA_SWRITE(bb, i) do { *(LAS bf16x8*)(V_lds + (bb) * SHM_V + vst0) = sr_[i].vs0;          \
    *(LAS bf16x8*)(V_lds + (bb) * SHM_V + vst1) = sr_[i].vs1; const int kc = sc * 2;               \
    *(LAS bf16x8*)(K_lds + (bb) * SHM_K + DA_KSWZ(sr, kc)) = sr_[i].ks0;                       \
    *(LAS bf16x8*)(K_lds + (bb) * SHM_K + DA_KSWZ(32 + sr, kc)) = sr_[i].ks1; } while (0)
#define DA_SWAIT() asm volatile("s_waitcnt vmcnt(4)" ::: "memory")
#define DA_RESC(a) do { if (__any((a) < 1.f)) { if (hi == 0) al_l[r32] = (a); asm volatile("s_waitcnt lgkmcnt(0)" ::: "memory"); \
    _Pragma("unroll") for (int d = 0; d < 4; ++d) _Pragma("unroll") for (int r = 0; r < 16; ++r) o[d][r] *= al_l[crow(r, hi)]; } } while (0)
  f32x16 pA0, pA1, pB0, pB1; float mnA, mnB, alA, alB; bf16x8 pa0, pa1, pa2, pa3; constexpr int NT = NT_ / KVBLK;
  DA_SLOAD(0, 0); asm volatile("s_waitcnt vmcnt(0)" ::: "memory"); DA_SWRITE(0, 0); __syncthreads();
  qkt(pA0, pA1, K_lds, qr, r32, hi, mapB); partialSM(pA0, pA1, m_reg, mnA, alA);
  DA_SLOAD(1, KVBLK); DA_SLOAD(0, 2 * KVBLK);
  DA_SWAIT(); DA_SWRITE(1, 1); __syncthreads();
  for (int j = 1; j + 1 < NT; j += 2) {
    DA_SBAR(); qkt(pB0, pB1, K_lds + SHM_K, qr, r32, hi, mapB);
    finishSM(pA0, pA1, alA, l_reg, pa0, pa1, pa2, pa3); DA_SBAR();
    DA_SLOAD(1, (j + 2) * KVBLK); DA_SBAR();
    pv_d0(o, vb0, pa0, pa1, pa2, pa3); partialSM(pB0, pB1, m_reg, mnB, alB);
    __syncthreads(); DA_SWAIT(); DA_SWRITE(0, 0);
    DA_RESC(alB); __syncthreads();
    DA_SBAR(); qkt(pA0, pA1, K_lds, qr, r32, hi, mapB);
    finishSM(pB0, pB1, alB, l_reg, pa0, pa1, pa2, pa3); DA_SBAR();
    if (j + 3 < NT) DA_SLOAD(0, (j + 3) * KVBLK); DA_SBAR();
    pv_d0(o, vb0 + SHM_V, pa0, pa1, pa2, pa3); partialSM(pA0, pA1, m_reg, mnA, alA);
    __syncthreads(); DA_SWAIT(); DA_SWRITE(1, 1);
    DA_RESC(alA); __syncthreads();
  }
  DA_SBAR(); qkt(pB0, pB1, K_lds + SHM_K, qr, r32, hi, mapB);
  finishSM(pA0, pA1, alA, l_reg, pa0, pa1, pa2, pa3); DA_SBAR();
  pv_d0(o, vb0, pa0, pa1, pa2, pa3); partialSM(pB0, pB1, m_reg, mnB, alB);
  __syncthreads(); DA_RESC(alB);
  finishSM(pB0, pB1, alB, l_reg, pa0, pa1, pa2, pa3); DA_SBAR();
  pv_d0(o, vb0 + SHM_V, pa0, pa1, pa2, pa3);
  if (hi == 0) li_l[r32] = l_reg; asm volatile("s_waitcnt lgkmcnt(0)" ::: "memory");
  float rli[16];
#pragma unroll
  for (int r = 0; r < 16; ++r) rli[r] = __builtin_amdgcn_rcpf(li_l[crow(r, hi)]);
  __syncthreads();
  LAS float* X = (LAS float*)lds;
  if (mp == 1) {
#pragma unroll
    for (int d0 = 0; d0 < 4; ++d0)
#pragma unroll
      for (int r = 0; r < 16; ++r) X[(wq * 32 + crow(r, hi)) * 128 + d0 * 32 + r32] = o[d0][r] * rli[r];
  }
  __syncthreads();
  if (mp == 0) {
#pragma unroll
    for (int d0 = 0; d0 < 4; ++d0)
#pragma unroll
      for (int r = 0; r < 16; ++r) { const int ix = (wq * 32 + crow(r, hi)) * 128 + d0 * 32 + r32; X[ix] = o[d0][r] * rli[r] - lam * X[ix]; }
  }
  __syncthreads();
  { const int row = tid >> 2, qtr = tid & 3; const LAS f32x4* xp = (const LAS f32x4*)(X + row * 128 + qtr * 32); f32x4 xv[8]; float ss = 0.f;
#pragma unroll
    for (int i = 0; i < 8; ++i) { xv[i] = xp[i]; ss += (xv[i].x * xv[i].x + xv[i].y * xv[i].y) + (xv[i].z * xv[i].z + xv[i].w * xv[i].w); }
    ss += __shfl_xor(ss, 1); ss += __shfl_xor(ss, 2);
    const float rr = 0.8f / sqrtf(ss * (1.f / 128.f) + EPS);
    bf16* op = CAT + (rowbase + qb * 128 + row) * DM + GW + h * 128 + qtr * 32;
#pragma unroll
    for (int i = 0; i < 4; ++i) { const f32x4 g0 = *(const f32x4*)(subln + qtr * 32 + i * 8), g1 = *(const f32x4*)(subln + qtr * 32 + i * 8 + 4);
      const f32x4 y0 = xv[2 * i] * rr * g0, y1 = xv[2 * i + 1] * rr * g1;
      v4u w; w.x = pk2(y0.x, y0.y); w.y = pk2(y0.z, y0.w); w.z = pk2(y1.x, y1.y); w.w = pk2(y1.z, y1.w);
      *(v4u*)(op + i * 8) = w; } }
  __syncthreads();
#undef DA_SLOAD
#undef DA_SWRITE
#undef DA_SWAIT
#undef DA_RESC
}
}
#ifndef STOP_AFTER
#define STOP_AFTER 25
#endif
constexpr int N_PHASES = 26;
struct Args { const float* in[44]; float* out; unsigned char* ws; int ph_lo, ph_hi; };
__global__ void __launch_bounds__(NWAVES * 64, 2) fwd_kernel(Args args) {
    extern __shared__ __attribute__((aligned(16))) unsigned char lds_raw[];
    LAS unsigned char* lds = (LAS unsigned char*)lds_raw;
    volatile LAS unsigned* MISC = (volatile LAS unsigned*)(lds + MISC_OFF);
    LAS int* TB = (LAS int*)(lds + TBL_OFF);
    const int tid0 = threadIdx.x, wave = __builtin_amdgcn_readfirstlane(tid0 >> 6);
    const int G = gridDim.x, bx = blockIdx.x;
    const int gw = bx * NWAVES + wave, NGW = G * NWAVES, NGT = G * NWAVES * 64;
    unsigned char* ws = args.ws;
    gu32* ctl = (gu32*)(ws + WS_CTL);
    const float* x_in = args.in[0]; const float* c_in = args.in[1]; const float* lbl = args.in[2];
    const float* const* L0 = args.in + 3; const float* const* L1 = args.in + 23; const float* fnorm = args.in[43];
    float* xo = args.out;
    float* TAB = (float*)(ws + WS_TAB); float* MOD = (float*)(ws + WS_MOD);
    bf16* WIN0 = (bf16*)(ws + WS_WIN0); bf16* WIN1 = (bf16*)(ws + WS_WIN1); bf16* WOUT0 = (bf16*)(ws + WS_WOUT0); bf16* WOUT1 = (bf16*)(ws + WS_WOUT1);
    bf16* ROUT0 = (bf16*)(ws + WS_ROUT0); bf16* ROUT1 = (bf16*)(ws + WS_ROUT1); bf16* GU = (bf16*)(ws + WS_GU); bf16* DN = (bf16*)(ws + WS_DN);
    bf16* H2A = (bf16*)(ws + WS_H2A); bf16* H2B = (bf16*)(ws + WS_H2B); bf16* PROJ = (bf16*)(ws + WS_PROJ); bf16* CAT = (bf16*)(ws + WS_CAT);
    float* OF = (float*)(ws + WS_OF); float* OB = (float*)(ws + WS_OB); bf16* QKC = (bf16*)(ws + WS_QKC);
    bf16* YB = (bf16*)(ws + WS_Y); bf16* HB = (bf16*)(ws + WS_HB); float* LOG = (float*)(ws + WS_LOG);
    int* TOPI = (int*)(ws + WS_TOPI); float* TOPW = (float*)(ws + WS_TOPW); int* RANK = (int*)(ws + WS_RANK); int* SLOT = (int*)(ws + WS_SLOT); int* LIST = (int*)(ws + WS_LIST);

    for (int u = tid0; u < (LDS_BYTES - LDSCTL_OFF) / 4; u += NWAVES * 64) ((LAS unsigned*)(lds + LDSCTL_OFF))[u] = 0u;
    __syncthreads();
    XcdBarrier bar = xcd_barrier_post((unsigned*)(ctl + CW_BAR), MISC + 8);
    const int lo = args.ph_lo, hi = args.ph_hi;
#define IN(k) (lo <= (k) && (k) < hi)
#define FRESH() int tid = wave * 64 + pg8::fresh_lane(); asm volatile("" : "+v"(tid)); const int lane = tid & 63; const int gtid = bx * (NWAVES * 64) + tid; (void)lane; (void)gtid
#define SEAM(k) do { if (IN(k) && IN((k) + 1)) xcd_barrier(bar); } while (0)
    LAS float* scr = (LAS float*)(lds + wave * 8448);

    if (IN(0)) { FRESH();
        if (bx < 192) mod_unit(bx, c_in, L0[2], L0[3], L1[2], L1[3], MOD, lds, tid, wave, lane);
        int jbase = 0;
        TR_JOB(L0[4], 4096, 1024, 0, 4096, WIN0, 0);
        TR_JOB(L1[4], 3600, 1024, 0, 2048, WIN1, 0);
        TR_JOB(L1[4], 3600, 1024, 2064, 1536, WIN1, 2048);
        TR_JOB(L1[4], 3600, 1024, 2048, 16, WIN1, 3584);
        TR_JOB(L0[5], 1024, 1024, 0, 1024, WOUT0, 0);
        TR_JOB(L1[5], 1024, 1024, 0, 1024, WOUT1, 0);
        TR_JOB(L0[12], 128, 1024, 0, 128, ROUT0, 0);
        TR_JOB(L1[12], 128, 1024, 0, 128, ROUT1, 0);
        { const v4u z = {0u, 0u, 0u, 0u};
          for (int i = gtid; i < 224 * 128; i += NGT) *(v4u*)(WIN1 + (size_t)3616 * 1024 + (size_t)i * 8) = z;
          for (int i = gtid; i < 128 * 128; i += NGT) { *(v4u*)(ROUT0 + (size_t)128 * 1024 + (size_t)i * 8) = z; *(v4u*)(ROUT1 + (size_t)128 * 1024 + (size_t)i * 8) = z; } }
        for (int t = gtid; t < NT_; t += NGT) {
            const float invf[8] = {1.0f, 0.1939227432f, 0.0376060307f, 0.00729266461f, 0.00141421356f, 0.000274248188f, 5.31829573e-05f, 1.03133852e-05f};
#pragma unroll
            for (int i = 0; i < 8; ++i) { const float ang = (float)t * invf[i]; double rev = (double)ang * 0.15915494309189535; rev -= floor(rev); const float rv = (float)rev;
                TAB[t * 16 + i] = __builtin_amdgcn_cosf(rv); TAB[t * 16 + 8 + i] = __builtin_amdgcn_sinf(rv); }
        }
    }
    SEAM(0);
    if (IN(1)) { FRESH(); normmod_phase(x_in, L0[0], MOD, 0, 1024, H2A, gw, NGW, lane); }
    SEAM(1);
    if (IN(2)) { FRESH(); pg8::DenseOrder S; S.init(NTOK, P0W, G, bx); EpiStoreBf16 E{PROJ, P0W};
        pg8::gemm_phase<EpiStoreBf16, pg8::DenseOrder, true>(lds, H2A, WIN0, DM, S, E, wave); }
    SEAM(2);
    if (IN(3)) { FRESH(); rope_phase(PROJ, TAB, gtid, NGT); }
    SEAM(3);
    if (IN(4)) { FRESH();
        if (bx < 64) hgrn_unit(bx, PROJ, lbl, OF, OB, lds, tid);
        float lam;
        { float a = L0[7][lane] * L0[8][lane], b2 = L0[9][lane] * L0[10][lane]; a = wave_sum(a); b2 = wave_sum(b2); lam = __expf(a) - __expf(b2) + 0.2f; }
        for (;;) { const int u = q_pull(ctl + CW_Q0, MISC + 0, tid); if (u >= 1024) break; da::unit(u, PROJ, lam, L0[11], CAT, (LAS char*)lds, tid); }
        for (;;) { const int u = q_pull(ctl + CW_Q0 + 64, MISC + 1, tid); if (u >= 1032) break;
#pragma unroll 1
            for (int k = 0; k < 6; ++k) expert_item(L0[14], L0[15], L0[16], L0[17], L0[18], L0[19], GU, DN, u * 48 + wave * 6 + k, scr, lane); }
    }
    SEAM(4);
    if (IN(5)) { FRESH(); gateout_phase<0>(OF, OB, L0[6], PROJ, P0W, 2048, CAT, gw, NGW, lane); }
    SEAM(5);
    if (IN(6)) { FRESH(); pg8::DenseOrder S; S.init(NTOK, DM, G, bx); EpiResid E{x_in, xo, MOD + 2048};
        pg8::gemm_phase<EpiResid, pg8::DenseOrder, true>(lds, CAT, WOUT0, DM, S, E, wave); }
    SEAM(6);
    if (IN(7)) { FRESH(); normmod_phase(xo, L0[1], MOD, 3072, 4096, H2A, gw, NGW, lane); }
    SEAM(7);
    if (IN(8)) { FRESH(); pg8::DenseOrder S; S.init(NTOK, 256, G, bx); EpiF32 E{LOG, 256};
        pg8::gemm_phase<EpiF32, pg8::DenseOrder, true>(lds, H2A, ROUT0, DM, S, E, wave); }
    SEAM(8);
    if (IN(9)) { FRESH(); topk_phase(LOG, L0[13], TOPI, TOPW, RANK, (unsigned*)(ctl + CW_CNT0), gw, NGW, lane); }
    SEAM(9);
    if (IN(10)) { FRESH(); moe_tables((const unsigned*)(ctl + CW_CNT0), TB, tid); list_phase(TOPI, RANK, SLOT, LIST, TB, gtid, NGT); }
    SEAM(10);
    if (IN(11)) { FRESH(); moe_tables((const unsigned*)(ctl + CW_CNT0), TB, tid); GroupOrder S; S.init(TB, LIST, 2, G, bx); EpiGateUp E{HB};
        pg8::gemm_phase<EpiGateUp, GroupOrder, true>(lds, H2A, GU, DM, S, E, wave); }
    SEAM(11);
    if (IN(12)) { FRESH(); moe_tables((const unsigned*)(ctl + CW_CNT0), TB, tid); GroupOrder S; S.init(TB, nullptr, 4, G, bx); EpiDown E{YB};
        pg8::gemm_phase<EpiDown, GroupOrder, true>(lds, HB, DN, EFF, S, E, wave); }
    SEAM(12);
    if (IN(13)) { FRESH(); combine_phase(xo, YB, SLOT, TOPW, MOD, 5120, L1[0], MOD + 8 * 6144, 0, 1024, H2B, nullptr, gw, NGW, lane); }
    SEAM(13);
    if (IN(14)) { FRESH(); pg8::DenseOrder S; S.init(NTOK, P1W, G, bx); EpiStoreBf16 E{PROJ, P1W};
        pg8::gemm_phase<EpiStoreBf16, pg8::DenseOrder, true>(lds, H2B, WIN1, DM, S, E, wave); }
    SEAM(14);
    if (IN(15)) { FRESH(); convqk_phase(PROJ, L1[6], L1[7], QKC, gtid, NGT); }
    SEAM(15);
    if (IN(16)) { FRESH();
        if (bx < 64) mlstm_unit(bx, PROJ, QKC, L1[8], L1[9], OF, OB, lds, tid);
        for (;;) { const int u = q_pull(ctl + CW_Q0 + 128, MISC + 2, tid); if (u >= 512) break; na_unit(u, PROJ, L1[11], CAT, tid); }
        for (;;) { const int u = q_pull(ctl + CW_Q0 + 192, MISC + 3, tid); if (u >= 1032) break;
#pragma unroll 1
            for (int k = 0; k < 6; ++k) expert_item(L1[14], L1[15], L1[16], L1[17], L1[18], L1[19], GU, DN, u * 48 + wave * 6 + k, scr, lane); }
    }
    SEAM(16);
    if (IN(17)) { FRESH(); gateout_phase<1>(OF, OB, L1[10], PROJ, P1W, 1536, CAT, gw, NGW, lane); }
    SEAM(17);
    if (IN(18)) { FRESH(); pg8::DenseOrder S; S.init(NTOK, DM, G, bx); EpiResid E{xo, xo, MOD + 8 * 6144 + 2048};
        pg8::gemm_phase<EpiResid, pg8::DenseOrder, true>(lds, CAT, WOUT1, DM, S, E, wave); }
    SEAM(18);
    if (IN(19)) { FRESH(); normmod_phase(xo, L1[1], MOD + 8 * 6144, 3072, 4096, H2A, gw, NGW, lane); }
    SEAM(19);
    if (IN(20)) { FRESH(); pg8::DenseOrder S; S.init(NTOK, 256, G, bx); EpiF32 E{LOG, 256};
        pg8::gemm_phase<EpiF32, pg8::DenseOrder, true>(lds, H2A, ROUT1, DM, S, E, wave); }
    SEAM(20);
    if (IN(21)) { FRESH(); topk_phase(LOG, L1[13], TOPI, TOPW, RANK, (unsigned*)(ctl + CW_CNT1), gw, NGW, lane); }
    SEAM(21);
    if (IN(22)) { FRESH(); moe_tables((const unsigned*)(ctl + CW_CNT1), TB, tid); list_phase(TOPI, RANK, SLOT, LIST, TB, gtid, NGT); }
    SEAM(22);
    if (IN(23)) { FRESH(); moe_tables((const unsigned*)(ctl + CW_CNT1), TB, tid); GroupOrder S; S.init(TB, LIST, 2, G, bx); EpiGateUp E{HB};
        pg8::gemm_phase<EpiGateUp, GroupOrder, true>(lds, H2A, GU, DM, S, E, wave); }
    SEAM(23);
    if (IN(24)) { FRESH(); moe_tables((const unsigned*)(ctl + CW_CNT1), TB, tid); GroupOrder S; S.init(TB, nullptr, 4, G, bx); EpiDown E{YB};
        pg8::gemm_phase<EpiDown, GroupOrder, true>(lds, HB, DN, EFF, S, E, wave); }
    SEAM(24);
    if (IN(25)) { FRESH(); combine_phase(xo, YB, SLOT, TOPW, MOD + 8 * 6144, 5120, nullptr, nullptr, 0, 0, nullptr, fnorm, gw, NGW, lane); }
    if (hi < N_PHASES && hi > 0 && IN(hi - 1)) { FRESH();
        xcd_barrier(bar);
        const float* src = (hi - 1 >= 6) ? (const float*)xo : x_in;
        for (int m = gw; m < NTOK; m += NGW) { const f32x4* xr = (const f32x4*)(src + (size_t)m * DM) + lane; f32x4 v[4];
#pragma unroll
            for (int j = 0; j < 4; ++j) v[j] = xr[64 * j];
            finalnorm_row(v, fnorm, xo + (size_t)m * DM, lane); }
    }
#undef IN
#undef SEAM
}

extern "C" void kernel_launch(void* const* d_in, const int* in_sizes, int n_in, void* d_out, int out_size, void* d_ws, size_t ws_size, hipStream_t stream) {
    static int grid = 0;
    if (grid == 0) {
        if (n_in != 44 || in_sizes[0] != NTOK * DM || out_size != NTOK * DM || ws_size < WS_END) {
            fprintf(stderr, "kernel_launch: shape mismatch: n_in %d in0 %d out %d ws %zu (need %zu)\n", n_in, n_in > 0 ? in_sizes[0] : -1, out_size, ws_size, (size_t)WS_END); grid = -1; return; }
        int dev = 0, cus = 0, per_cu = 0;
        if (hipGetDevice(&dev) != hipSuccess || hipDeviceGetAttribute(&cus, hipDeviceAttributeMultiprocessorCount, dev) != hipSuccess) { grid = -1; return; }
        if (hipFuncSetAttribute((const void*)fwd_kernel, hipFuncAttributeMaxDynamicSharedMemorySize, LDS_BYTES) != hipSuccess) { fprintf(stderr, "kernel_launch: hipFuncSetAttribute failed\n"); grid = -1; return; }
        if (hipOccupancyMaxActiveBlocksPerMultiprocessor(&per_cu, (const void*)fwd_kernel, NWAVES * 64, LDS_BYTES) != hipSuccess || per_cu < 1) { fprintf(stderr, "kernel_launch: occupancy query reports %d\n", per_cu); }
        (void)hipGetLastError();
        grid = cus;
    }
    if (grid < 0) return;
    if (hipMemsetAsync((char*)d_ws + WS_CTL, 0, CTL_ZERO_BYTES, stream) != hipSuccess) return;
    Args a{};
    for (int i = 0; i < 44; ++i) a.in[i] = (const float*)d_in[i];
    a.out = (float*)d_out; a.ws = (unsigned char*)d_ws; a.ph_lo = 0; a.ph_hi = STOP_AFTER + 1;
    hipLaunchKernelGGL(fwd_kernel, dim3(grid), dim3(NWAVES * 64), LDS_BYTES, stream, a);
    const hipError_t le = hipPeekAtLastError();
    if (le != hipSuccess) fprintf(stderr, "kernel_launch: launch failed: %s\n", hipGetErrorName(le));
}
```

```cpp
#include <hip/hip_runtime.h>
#include <cstdio>
#include <cstdint>

namespace pg8 {
#define PG8_LAS __attribute__((address_space(3)))
typedef unsigned short bf16_t;
typedef short bf16x8 __attribute__((ext_vector_type(8)));
typedef float f32x4 __attribute__((ext_vector_type(4)));
typedef unsigned u32x4 __attribute__((ext_vector_type(4)));
constexpr int BM = 256, BK = 64, HALF = 128, HTB = HALF * BK * 2  , STAGE_BYTES = 8 * HTB, NXCD = 8, WGM = 8;

__host__ __device__ __forceinline__ int lds_byte(int r, int c) { const int st = (r >> 4) * 2 + (c >> 5), rr = r & 15, cc = c & 31, ob = rr * 64 + cc * 2; return st * 1024 + (ob ^ (((ob >> 9) & 1) << 5)); }
__host__ __device__ __forceinline__ void stage_rc(int b, int& R, int& C) { const int st = b / 1024, sb = b % 1024, swz = sb ^ (((sb >> 9) & 1) << 5); R = (st >> 1) * 16 + swz / 64; C = (st & 1) * 32 + (swz % 64) / 2; }
__host__ __device__ __forceinline__ int perm32(int rho) { const int n = rho >> 4, i = rho & 15; return 8 * (i >> 2) + 4 * n + (i & 3); }

__device__ __forceinline__ int fresh_lane() { int l; asm volatile("v_mbcnt_lo_u32_b32 %0, -1, 0\n\tv_mbcnt_hi_u32_b32 %0, -1, %0" : "=v"(l)); return l; }

struct Unit { int pn, arow0, nvalid, bt; };

struct DenseOrder {
    int nM, nN, nwg, G, c;
    __device__ __forceinline__ void init(int M, int N, int G_, int c_) { nM = M / BM; nN = N / BM; nwg = nM * nN; G = G_; c = c_; }
    __device__ __forceinline__ bool next(int i, Unit& u) const {
        const long L = (long)i * G + c; if (L >= nwg) return false;
        int wgid = (int)L; { const int q = nwg / NXCD, r = nwg % NXCD, xcd = wgid % NXCD, off = wgid / NXCD; wgid = (xcd < r ? xcd * (q + 1) : r * (q + 1) + (xcd - r) * q) + off; }
        const int nig = WGM * nN, gid = wgid / nig, fm = gid * WGM, gsz = (nM - fm) < WGM ? (nM - fm) : WGM;
        const int pm = fm + ((wgid % nig) % gsz); u.pn = (wgid % nig) / gsz; u.arow0 = pm * BM; u.nvalid = BM; u.bt = u.pn; return true;
    }
    __device__ __forceinline__ int arow(const Unit& u, int r) const { return u.arow0 + r; }
};

__device__ __forceinline__ unsigned cvt_pk_bf16(float lo, float hi) { unsigned r; asm volatile("v_cvt_pk_bf16_f32 %0, %1, %2" : "=v"(r) : "v"(lo), "v"(hi)); return r; }

template <class Epi, class Sched, bool ALIGN_EPI>
__device__ __forceinline__ void gemm_phase(PG8_LAS unsigned char* lds, const bf16_t* A, const bf16_t* Bt, const int K, const Sched& S, const Epi& E, const int wid  ) {
    int tid = wid * 64 + pg8::fresh_lane(); asm volatile("" : "+v"(tid));
    const int lane = tid & 63, wr = wid >> 2, wc = wid & 3, fr = lane & 15, fq = lane >> 4;
    const int nt = K / BK;
    unsigned voffB[2];
#pragma unroll
    for (int i = 0; i < 2; ++i) { int R, C; stage_rc(tid * 16 + i * 8192, R, C); const int Rb = Epi::PERM ? ((R & ~31) + perm32(R & 31)) : R;
        voffB[i] = (unsigned)(Rb * K + C) * 2u; }
#define PG8_AOFF(U, o00, o01, o10, o11) do { int _t = wid * 64 + pg8::fresh_lane(); asm volatile("" : "+v"(_t)); int _R0, _C0, _R1, _C1; stage_rc(_t * 16, _R0, _C0); stage_rc(_t * 16 + 8192, _R1, _C1); \
        o00 = (unsigned)S.arow(U, _R0) * K2 + (unsigned)_C0 * 2u; o01 = (unsigned)S.arow(U, _R1) * K2 + (unsigned)_C1 * 2u; \
        o10 = (unsigned)S.arow(U, HALF + _R0) * K2 + (unsigned)_C0 * 2u; o11 = (unsigned)S.arow(U, HALF + _R1) * K2 + (unsigned)_C1 * 2u; } while (0)
    const unsigned K2 = (unsigned)K * 2u;
    const unsigned kstep = (unsigned)(BK * 2);
    const size_t hstep = (size_t)HALF * K * 2;
    const size_t tstep = 2 * hstep;
    const unsigned ldsw = (unsigned)wid * 1024u;
    const int aoff = lds_byte(wr * 64 + fr, fq * 8), boff = lds_byte(wc * 32 + fr, fq * 8);
    const char* Ab = (const char*)A; const char* Bb = (const char*)Bt;
#define PG8_SA(b, h) (((b) * 2 + (h)) * HTB)
#define PG8_SB(b, h) ((4 + (b) * 2 + (h)) * HTB)
#define PG8_STAGE_B(bufoff, gbase) do { _Pragma("unroll") for (int _i = 0; _i < 2; ++_i) \
        __builtin_amdgcn_global_load_lds((const unsigned*)((const char*)(gbase) + voffB[_i]), (PG8_LAS unsigned*)(lds + (bufoff) + ldsw + _i * 8192), 16, 0, 0); } while (0)
#define PG8_STAGE_A(bufoff, kbyte, o0, o1) do { \
        __builtin_amdgcn_global_load_lds((const unsigned*)(Ab + (size_t)((kbyte) + (o0))), (PG8_LAS unsigned*)(lds + (bufoff) + ldsw), 16, 0, 0); \
        __builtin_amdgcn_global_load_lds((const unsigned*)(Ab + (size_t)((kbyte) + (o1))), (PG8_LAS unsigned*)(lds + (bufoff) + ldsw + 8192), 16, 0, 0); } while (0)
#define PG8_LDA(dst, b, h) do { _Pragma("unroll") for (int m = 0; m < 4; ++m) _Pragma("unroll") for (int k = 0; k < 2; ++k) dst[m][k] = *(const PG8_LAS bf16x8*)(lds + PG8_SA(b, h) + aoff + m * 2048 + k * 1024); } while (0)
#define PG8_LDB(dst, b, h) do { _Pragma("unroll") for (int n = 0; n < 2; ++n) _Pragma("unroll") for (int k = 0; k < 2; ++k) dst[n][k] = *(const PG8_LAS bf16x8*)(lds + PG8_SB(b, h) + boff + n * 2048 + k * 1024); } while (0)
#define PG8_MMA(ai, bj, At, Bt_) do { __builtin_amdgcn_s_setprio(1); _Pragma("unroll") for (int m = 0; m < 4; ++m) _Pragma("unroll") for (int n = 0; n < 2; ++n) _Pragma("unroll") for (int k = 0; k < 2; ++k) \
        acc[ai][bj][m][n] = __builtin_amdgcn_mfma_f32_16x16x32_bf16(Bt_[n][k], At[m][k], acc[ai][bj][m][n], 0, 0, 0); __builtin_amdgcn_s_setprio(0); } while (0)
#define PG8_WAIT_V(n) asm volatile("s_waitcnt vmcnt(" #n ")" ::: "memory")
#define PG8_WAIT_L(n) asm volatile("s_waitcnt lgkmcnt(" #n ")" ::: "memory")
#define PG8_BAR __builtin_amdgcn_s_barrier()
#define PG8_SCHED __builtin_amdgcn_sched_barrier(0)
    Unit cur, nxt; int ui = 0;
    if (!S.next(0, cur)) return;
    f32x4 acc[2][2][4][2];
#pragma unroll
    for (int a = 0; a < 2; ++a)
#pragma unroll
        for (int b = 0; b < 2; ++b)
#pragma unroll
            for (int m = 0; m < 4; ++m)
#pragma unroll
                for (int n = 0; n < 2; ++n) acc[a][b][m][n] = (f32x4){0.f, 0.f, 0.f, 0.f};
    bf16x8 At[4][2], B0[2][2], B1[2][2];
    unsigned c00, c01, c10, c11, n00, n01, n10, n11;
    PG8_AOFF(cur, c00, c01, c10, c11);
    const char* cB = Bb + (size_t)cur.bt * tstep;
    PG8_STAGE_B(PG8_SB(0, 0), cB); PG8_STAGE_B(PG8_SB(0, 1), cB + hstep); PG8_STAGE_A(PG8_SA(0, 0), 0u, c00, c01); PG8_STAGE_A(PG8_SA(0, 1), 0u, c10, c11);
    if (wr == 1) PG8_BAR;
    PG8_WAIT_V(2); PG8_BAR;
    PG8_STAGE_B(PG8_SB(1, 0), cB + kstep); PG8_STAGE_A(PG8_SA(1, 0), kstep, c00, c01); PG8_STAGE_B(PG8_SB(1, 1), cB + hstep + kstep);
    PG8_WAIT_V(6); PG8_BAR;
    for (;;) {
        const bool has_next = S.next(ui + 1, nxt);
        if (has_next) { PG8_AOFF(nxt, n00, n01, n10, n11); } else { n00 = c00; n01 = c01; n10 = c10; n11 = c11; }
        const char* nB = has_next ? Bb + (size_t)nxt.bt * tstep : cB;
        for (int t = 0; t < nt; t += 2) {
            const bool last = (t == nt - 2);
            const unsigned kb1 = (unsigned)(t + 1) * kstep;
            const unsigned kb2 = last ? 0u : (unsigned)(t + 2) * kstep, kb3 = kb2 + kstep;
            const unsigned a00 = last ? n00 : c00, a01 = last ? n01 : c01, a10 = last ? n10 : c10, a11 = last ? n11 : c11;
            const char* b2 = last ? nB : cB + (size_t)(t + 2) * kstep; const char* b3 = b2 + kstep;
            PG8_LDB(B0, 0, 0); PG8_LDB(B1, 0, 1); PG8_SCHED; PG8_LDA(At, 0, 0); PG8_STAGE_A(PG8_SA(1, 1), kb1, c10, c11);
            PG8_WAIT_V(8); PG8_WAIT_L(0); PG8_BAR; PG8_MMA(0, 0, At, B0); PG8_MMA(0, 1, At, B1); PG8_BAR; PG8_SCHED;
            PG8_LDA(At, 0, 1); PG8_STAGE_B(PG8_SB(0, 0), b2); PG8_STAGE_B(PG8_SB(0, 1), b2 + hstep); PG8_STAGE_A(PG8_SA(0, 0), kb2, a00, a01);
            PG8_WAIT_V(8); PG8_WAIT_L(0); PG8_BAR; PG8_MMA(1, 0, At, B0); PG8_MMA(1, 1, At, B1); PG8_BAR; PG8_SCHED;
            PG8_LDB(B0, 1, 0); PG8_LDB(B1, 1, 1); PG8_SCHED; PG8_LDA(At, 1, 0); PG8_STAGE_A(PG8_SA(0, 1), kb2, a10, a11);
            PG8_WAIT_V(8); PG8_WAIT_L(0); PG8_BAR; PG8_MMA(0, 0, At, B0); PG8_MMA(0, 1, At, B1); PG8_BAR; PG8_SCHED;
            PG8_LDA(At, 1, 1); PG8_STAGE_B(PG8_SB(1, 0), b3); PG8_STAGE_B(PG8_SB(1, 1), b3 + hstep); PG8_STAGE_A(PG8_SA(1, 0), kb3, a00, a01);
            PG8_WAIT_V(8); PG8_WAIT_L(0); PG8_BAR; PG8_MMA(1, 0, At, B0); PG8_MMA(1, 1, At, B1); PG8_BAR; PG8_SCHED;
        }
        if constexpr (ALIGN_EPI) { if (wr == 0) PG8_BAR; }
        E(acc, cur, wr, wc, fr, fq);
        if (!has_next) break;
#pragma unroll
        for (int a = 0; a < 2; ++a)
#pragma unroll
            for (int b = 0; b < 2; ++b)
#pragma unroll
                for (int m = 0; m < 4; ++m)
#pragma unroll
                    for (int n = 0; n < 2; ++n) acc[a][b][m][n] = (f32x4){0.f, 0.f, 0.f, 0.f};
        cur = nxt; cB = nB; c00 = n00; c01 = n01; c10 = n10; c11 = n11; ++ui;
        if constexpr (ALIGN_EPI) { if (wr == 1) PG8_BAR; }
    }
    PG8_WAIT_V(0);
    if constexpr (!ALIGN_EPI) { if (wr == 0) PG8_BAR; }
    PG8_BAR;
#undef PG8_AOFF
#undef PG8_SA
#undef PG8_SB
#undef PG8_STAGE_A
#undef PG8_STAGE_B
#undef PG8_LDA
#undef PG8_LDB
#undef PG8_MMA
#undef PG8_WAIT_V
#undef PG8_WAIT_L
#undef PG8_BAR
#undef PG8_SCHED
}
}
constexpr int NB = 8, NT_ = 4096, DM = 1024, NTOK = NB * NT_;
constexpr int GW = 512;
constexpr int P0W = 4096, P1W = 3840;
constexpr int NEXP = 128, EFF = 256, NSLOT = NTOK * 8, NSLOT_ALL = NSLOT + NTOK;
constexpr float EPS = 1e-6f;
constexpr int NWAVES = 8;

constexpr size_t MiB = 1u << 20;
constexpr size_t WS_CTL = 0, CTL_ZERO_BYTES = 1 * MiB;
constexpr size_t WS_TAB = 1 * MiB;
constexpr size_t WS_MOD = WS_TAB + 256 * 1024;
constexpr size_t WS_WIN0 = 2 * MiB, WS_WIN1 = 10 * MiB, WS_WOUT0 = 18 * MiB, WS_WOUT1 = 20 * MiB, WS_ROUT0 = 22 * MiB, WS_ROUT1 = 23 * MiB;
constexpr size_t WS_GU = 24 * MiB;
constexpr size_t WS_DN = 153 * MiB;
constexpr size_t WS_H2A = 218 * MiB;
constexpr size_t WS_PROJ = 282 * MiB;
constexpr size_t WS_CAT = 538 * MiB;
constexpr size_t WS_OF = 602 * MiB, WS_OB = 666 * MiB;
constexpr size_t WS_QKC = 730 * MiB;
constexpr size_t WS_Y = 218 * MiB;
constexpr size_t WS_HB = 794 * MiB;
constexpr size_t WS_H2B = 794 * MiB;
constexpr size_t WS_LOG = 938 * MiB;
constexpr size_t WS_TOPI = 970 * MiB, WS_TOPW = 971 * MiB, WS_RANK = 972 * MiB, WS_SLOT = 973 * MiB, WS_LIST = 974 * MiB;
constexpr size_t WS_END = 976 * MiB;
constexpr int CW_TMO = 0, CW_BAR = 4096, CW_Q0 = 8192, CW_Q1 = 8256, CW_CNT0 = 8448, CW_CNT1 = 8704;

constexpr int RING_BYTES = 131072;
constexpr int LDSCTL_OFF = RING_BYTES, MISC_OFF = LDSCTL_OFF + 320;
constexpr int LDS_BYTES = 147456;
constexpr int TBL_OFF = MISC_OFF + 128;

#define GAS __attribute__((address_space(1)))
#define LAS __attribute__((address_space(3)))
typedef unsigned short bf16;
typedef unsigned v4u __attribute__((ext_vector_type(4)));
typedef float f32x4 __attribute__((ext_vector_type(4)));
typedef short bf16x8 __attribute__((ext_vector_type(8)));
typedef GAS unsigned gu32;
typedef GAS unsigned long long gu64;
#define RLX_AGENT __ATOMIC_RELAXED, __HIP_MEMORY_SCOPE_AGENT
#define LDS_WAIT() asm volatile("s_waitcnt lgkmcnt(0)" ::: "memory")
#define VM_WAIT() asm volatile("s_waitcnt vmcnt(0)" ::: "memory")
__device__ __forceinline__ unsigned long long rt() { return __builtin_amdgcn_s_memrealtime(); }
__device__ __forceinline__ unsigned f2bf(float f) { unsigned u = __builtin_bit_cast(unsigned, f); return (u + 0x7fffu + ((u >> 16) & 1u)) >> 16; }
__device__ __forceinline__ unsigned pk2(float lo, float hi) { return f2bf(lo) | (f2bf(hi) << 16); }
#define XB_TMO      128
#define XB_XCNT(j)  (256  + 64 * (j))
#define XB_XSUB(j)  (1280 + 64 * (j))
#define XB_XGEN(j)  (2304 + 64 * (j))
#define XB_TOP      3328
#define XB_TOPGEN   3392
#define XCD_BAR_WORDS 3456
#define XB_SPIN_CAP (1u << 18)

__device__ __forceinline__ unsigned xb_ld(unsigned* p)              { return __hip_atomic_load(p, __ATOMIC_RELAXED, __HIP_MEMORY_SCOPE_AGENT); }
__device__ __forceinline__ unsigned xb_add(unsigned* p, unsigned v) { return __hip_atomic_fetch_add(p, v, __ATOMIC_RELAXED, __HIP_MEMORY_SCOPE_AGENT); }
__device__ __forceinline__ unsigned xb_xcc_id() { return (unsigned)__builtin_amdgcn_s_getreg((3 << 11) | 20) & 0xFu; }
#define XB_SPIN(cond, bar) do { unsigned _sp = 0; while (cond) { __builtin_amdgcn_s_sleep(1); \
    if ((++_sp & 255u) == 0u) { if (xb_ld(&(bar)[XB_TMO])) break; if (_sp > XB_SPIN_CAP) { atomicAdd(&(bar)[XB_TMO], 1u); break; } } } } while (0)

struct XcdBarrier {
    unsigned* bar; unsigned x;
    volatile LAS unsigned* st;
};

__device__ __forceinline__ XcdBarrier xcd_barrier_post(unsigned* bar, volatile LAS unsigned* st) {
    XcdBarrier b; b.bar = bar; b.x = xb_xcc_id(); b.st = st;
    if (threadIdx.x == 0) (void)xb_add(&bar[XB_XCNT(b.x)], 1u);
    return b;
}
__device__ __forceinline__ void xcd_barrier_complete(unsigned* bar, unsigned x, unsigned& nloc, unsigned& nx) {
    const unsigned G = gridDim.x * gridDim.y * gridDim.z;
    unsigned sum, cnt, mine, sp = 0u;
    for (;;) {
        sum = 0u; cnt = 0u; mine = 0u;
#pragma unroll
        for (unsigned j = 0; j < 16; ++j) { const unsigned c = xb_ld(&bar[XB_XCNT(j)]); sum += c; cnt += (c > 0u) ? 1u : 0u; mine = (j == x) ? c : mine; }
        if (sum == G) break;
        __builtin_amdgcn_s_sleep(1);
        if ((++sp & 255u) == 0u) { if (xb_ld(&bar[XB_TMO])) break; if (sp > XB_SPIN_CAP) { atomicAdd(&bar[XB_TMO], 1u); break; } }
    }
    nloc = mine > 0u ? mine : 1u; nx = cnt > 0u ? cnt : 1u;
}

__device__ __forceinline__ void xcd_barrier(const XcdBarrier& b) {
    asm volatile("s_waitcnt vmcnt(0)" ::: "memory");
    __syncthreads();
    if (threadIdx.x == 0) {
        unsigned* bar = b.bar;
        __builtin_amdgcn_s_waitcnt(0);
        unsigned nloc = b.st[0], nx = b.st[1];
        if (nloc == 0u) { xcd_barrier_complete(bar, b.x, nloc, nx); b.st[0] = nloc; b.st[1] = nx; }
        const unsigned old = xb_add(&bar[XB_XSUB(b.x)], 1u);
        const unsigned gen = old / nloc;
        if (old + 1u == (gen + 1u) * nloc) {
            __builtin_amdgcn_fence(__ATOMIC_RELEASE, "agent");
            asm volatile("s_waitcnt vmcnt(0)" ::: "memory");
            const unsigned og = xb_add(&bar[XB_TOP], 1u);
            const unsigned tg = og / nx;
            if (og + 1u == (tg + 1u) * nx) xb_add(&bar[XB_TOPGEN], 1u);
            else XB_SPIN(xb_ld(&bar[XB_TOPGEN]) == tg, bar);
            __builtin_amdgcn_fence(__ATOMIC_ACQUIRE, "agent");
            xb_add(&bar[XB_XGEN(b.x)], 1u);
            asm volatile("s_waitcnt vmcnt(0)" ::: "memory");
        } else {
            XB_SPIN(xb_ld(&bar[XB_XGEN(b.x)]) == gen, bar);
            __builtin_amdgcn_fence(__ATOMIC_ACQUIRE, "agent");
            asm volatile("s_waitcnt vmcnt(0)" ::: "memory");
        }
    }
    __syncthreads();
}
typedef float f32x2 __attribute__((ext_vector_type(2)));
typedef unsigned u32x2 __attribute__((ext_vector_type(2)));
__device__ __forceinline__ float bflo(unsigned w) { return __builtin_bit_cast(float, w << 16); }
__device__ __forceinline__ float bfhi(unsigned w) { return __builtin_bit_cast(float, w & 0xffff0000u); }
__device__ __forceinline__ float bf2f(bf16 b) { return __builtin_bit_cast(float, (unsigned)b << 16); }
__device__ __forceinline__ float wave_sum(float v) {
#pragma unroll
    for (int o = 1; o < 64; o <<= 1) v += __shfl_xor(v, o);
    return v;
}
__device__ __forceinline__ float sigm(float x) { return __builtin_amdgcn_rcpf(1.f + __expf(-x)); }
__device__ __forceinline__ float sigm_div(float x) { return 1.f / (1.f + __expf(-x)); }
__device__ __forceinline__ float silu(float x) { return x * __builtin_amdgcn_rcpf(1.f + __expf(-x)); }
__device__ __forceinline__ void unpack8(v4u w, float (&f)[8]) { f[0] = bflo(w.x); f[1] = bfhi(w.x); f[2] = bflo(w.y); f[3] = bfhi(w.y); f[4] = bflo(w.z); f[5] = bfhi(w.z); f[6] = bflo(w.w); f[7] = bfhi(w.w); }
__device__ __forceinline__ v4u pack8(const float (&f)[8]) { v4u w; w.x = pk2(f[0], f[1]); w.y = pk2(f[2], f[3]); w.z = pk2(f[4], f[5]); w.w = pk2(f[6], f[7]); return w; }

__device__ __forceinline__ void tr_item(const float* W, int ldw, int k0, int c0, int cvalid, bf16* WT, int ldt, int r0, LAS float* scr, int lane) {
#pragma unroll 8
    for (int i = 0; i < 32; ++i) { const int kk = 2 * i + (lane >> 5), n = lane & 31; scr[kk * 33 + n] = (n < cvalid) ? W[(size_t)(k0 + kk) * ldw + c0 + n] : 0.f; }
    LDS_WAIT(); asm volatile("" ::: "memory");
    const int c = lane & 7;
#pragma unroll
    for (int j = 0; j < 4; ++j) { const int n = (lane >> 3) + 8 * j; const LAS float* s = scr + (8 * c) * 33 + n;
        v4u o; o.x = pk2(s[0 * 33], s[1 * 33]); o.y = pk2(s[2 * 33], s[3 * 33]); o.z = pk2(s[4 * 33], s[5 * 33]); o.w = pk2(s[6 * 33], s[7 * 33]);
        *(v4u*)(WT + (size_t)(r0 + n) * ldt + k0 + 8 * c) = o; }
    LDS_WAIT(); asm volatile("" ::: "memory");
}
__device__ __forceinline__ void expert_item(const float* gate, const float* up, const float* down, const float* sgate, const float* sup, const float* sdown,
                                            bf16* GU, bf16* DN, int it, LAS float* scr, int lane) {
    const int e = it / 384, r = it - e * 384;
    const bool sh = (e == NEXP);
    if (r < 256) {
        const bool isup = r >= 128; const int rr = r & 127, sub = rr >> 6, q = rr & 63, kb = q >> 2, nb = q & 3;
        const float* W = sh ? (isup ? sup : sgate) : ((isup ? up : gate) + (size_t)e * (DM * EFF));
        tr_item(W, EFF, kb * 64, sub * 128 + nb * 32, 32, GU + (size_t)e * (512 * DM), DM, 256 * sub + (isup ? 128 : 0) + nb * 32, scr, lane);
    } else {
        const int rr = r - 256, kb = rr >> 5, nb = rr & 31;
        const float* W = sh ? sdown : down + (size_t)e * (EFF * DM);
        tr_item(W, DM, kb * 64, nb * 32, 32, DN + (size_t)e * (DM * EFF), EFF, nb * 32, scr, lane);
    }
}
#define TR_JOB(W_, ldw_, K_, c0_, ncols_, WT_, r0_) do { const int _nb = ((ncols_) + 31) / 32, _ni = ((K_) / 64) * _nb; \
        for (int _it = (gw + NGW - (jbase % NGW)) % NGW; _it < _ni; _it += NGW) { const int _kb = _it / _nb, _nk = _it % _nb; const int _cv = (ncols_) - _nk * 32; \
            tr_item(W_, ldw_, _kb * 64, (c0_) + _nk * 32, _cv < 32 ? _cv : 32, WT_, K_, (r0_) + _nk * 32, scr, lane); } jbase += _ni; } while (0)

__device__ __forceinline__ void mod_unit(int u, const float* c, const float* wm0, const float* bm0, const float* wm1, const float* bm1, float* MOD, LAS unsigned char* lds, int tid, int wave, int lane) {
    LAS float* sc = (LAS float*)(lds + 69632);
    LAS float* red = (LAS float*)(lds + 69632 + 32768);
    const int l = u / 96, cb = u % 96; const float* wm = l ? wm1 : wm0; const float* bm = l ? bm1 : bm0;
    for (int i = tid; i < NB * DM; i += 512) sc[i] = silu(c[i]);
    __syncthreads();
    float acc[8];
#pragma unroll
    for (int b = 0; b < 8; ++b) acc[b] = 0.f;
    const float* wp = wm + (size_t)(wave * 128) * 6144 + cb * 64 + lane;
    for (int k0 = 0; k0 < 128; k0 += 8) {
        float w[8];
#pragma unroll
        for (int j = 0; j < 8; ++j) w[j] = wp[(size_t)(k0 + j) * 6144];
#pragma unroll
        for (int j = 0; j < 8; ++j)
#pragma unroll
            for (int b = 0; b < 8; ++b) acc[b] += sc[b * DM + wave * 128 + k0 + j] * w[j];
    }
#pragma unroll
    for (int b = 0; b < 8; ++b) red[(wave * 8 + b) * 64 + lane] = acc[b];
    __syncthreads();
    { const int b = tid >> 6; float s = 0.f;
#pragma unroll
      for (int w = 0; w < 8; ++w) s += red[(w * 8 + b) * 64 + lane];
      MOD[(size_t)(l * 8 + b) * 6144 + cb * 64 + lane] = s + bm[cb * 64 + lane]; }
    __syncthreads();
}

__device__ __forceinline__ void normmod_row(const f32x4 (&v)[4], const float* gain, const float* shift, const float* scale, bf16* orow, int lane) {
    float ss = 0.f;
#pragma unroll
    for (int j = 0; j < 4; ++j) ss += (v[j].x * v[j].x + v[j].y * v[j].y) + (v[j].z * v[j].z + v[j].w * v[j].w);
    const float r = 1.f / sqrtf(wave_sum(ss) * (1.f / DM) + EPS);
    unsigned long long* o8 = (unsigned long long*)orow + lane;
#pragma unroll
    for (int j = 0; j < 4; ++j) { const f32x4 g = ((const f32x4*)gain)[lane + 64 * j], sh = ((const f32x4*)shift)[lane + 64 * j], sc = ((const f32x4*)scale)[lane + 64 * j];
        const f32x4 y = v[j] * r * g * (sc + 1.f) + sh;
        o8[64 * j] = (unsigned long long)pk2(y.x, y.y) | ((unsigned long long)pk2(y.z, y.w) << 32); }
}
__device__ __forceinline__ void normmod_phase(const float* X, const float* gain, const float* modl  , int sh_off, int sc_off, bf16* H, int gw, int NGW, int lane) {
    for (int m = gw; m < NTOK; m += NGW) {
        const f32x4* xr = (const f32x4*)(X + (size_t)m * DM) + lane; f32x4 v[4];
#pragma unroll
        for (int j = 0; j < 4; ++j) v[j] = xr[64 * j];
        const float* mb = modl + (size_t)(m >> 12) * 6144;
        normmod_row(v, gain, mb + sh_off, mb + sc_off, H + (size_t)m * DM, lane);
    }
}
__device__ __forceinline__ void finalnorm_row(const f32x4 (&v)[4], const float* gain, float* orow, int lane) {
    float ss = 0.f;
#pragma unroll
    for (int j = 0; j < 4; ++j) ss += (v[j].x * v[j].x + v[j].y * v[j].y) + (v[j].z * v[j].z + v[j].w * v[j].w);
    const float r = 1.f / sqrtf(wave_sum(ss) * (1.f / DM) + EPS);
#pragma unroll
    for (int j = 0; j < 4; ++j) ((f32x4*)orow)[lane + 64 * j] = v[j] * r * ((const f32x4*)gain)[lane + 64 * j];
}

__device__ __forceinline__ void rope_phase(bf16* P, const float* tab, int gtid, int NGT) {
    for (int idx = gtid; idx < NTOK * 16; idx += NGT) {
        const int tok = idx >> 4, grp = idx & 15, t = tok & (NT_ - 1);
        bf16* p = P + (size_t)tok * P0W + (grp < 8 ? 2560 : 3072) + (grp & 7) * 64;
        const v4u a = *(const v4u*)p, b = *(const v4u*)(p + 8);
        float x1[8], x2[8], cs[8], sn[8], y1[8], y2[8];
        unpack8(a, x1); unpack8(b, x2);
        const f32x4* tp = (const f32x4*)(tab + (size_t)t * 16);
        const f32x4 c0 = tp[0], c1 = tp[1], s0 = tp[2], s1 = tp[3];
        cs[0] = c0.x; cs[1] = c0.y; cs[2] = c0.z; cs[3] = c0.w; cs[4] = c1.x; cs[5] = c1.y; cs[6] = c1.z; cs[7] = c1.w;
        sn[0] = s0.x; sn[1] = s0.y; sn[2] = s0.z; sn[3] = s0.w; sn[4] = s1.x; sn[5] = s1.y; sn[6] = s1.z; sn[7] = s1.w;
#pragma unroll
        for (int i = 0; i < 8; ++i) { y1[i] = x1[i] * cs[i] - x2[i] * sn[i]; y2[i] = x2[i] * cs[i] + x1[i] * sn[i]; }
        *(v4u*)p = pack8(y1); *(v4u*)(p + 8) = pack8(y2);
    }
}

template <int ACT  >
__device__ __forceinline__ void gateout_phase(const float* OF, const float* OB, const float* gain, const bf16* P, int pitch, int gcol, bf16* CAT, int gw, int NGW, int lane) {
    const int hh = lane >> 4, e0 = (lane & 15) * 8;
    const f32x4 g0 = *(const f32x4*)(gain + e0), g1 = *(const f32x4*)(gain + e0 + 4);
    for (int m = gw; m < NTOK; m += NGW) {
        const float* pf = OF + (size_t)m * GW + hh * 128 + e0; const float* pb = OB + (size_t)m * GW + hh * 128 + e0;
        const f32x4 a0 = *(const f32x4*)pf + *(const f32x4*)pb, a1 = *(const f32x4*)(pf + 4) + *(const f32x4*)(pb + 4);
        float ss = (a0.x * a0.x + a0.y * a0.y) + (a0.z * a0.z + a0.w * a0.w) + (a1.x * a1.x + a1.y * a1.y) + (a1.z * a1.z + a1.w * a1.w);
        ss += __shfl_xor(ss, 1); ss += __shfl_xor(ss, 2); ss += __shfl_xor(ss, 4); ss += __shfl_xor(ss, 8);
        const float r = 1.f / sqrtf(ss * (1.f / 128.f) + EPS);
        float gv[8]; unpack8(*(const v4u*)(P + (size_t)m * pitch + gcol + hh * 128 + e0), gv);
        float y[8];
        const f32x4 n0 = a0 * r * g0, n1 = a1 * r * g1;
        y[0] = n0.x; y[1] = n0.y; y[2] = n0.z; y[3] = n0.w; y[4] = n1.x; y[5] = n1.y; y[6] = n1.z; y[7] = n1.w;
#pragma unroll
        for (int i = 0; i < 8; ++i) y[i] *= (ACT == 0) ? silu(gv[i]) : sigm(gv[i]);
        *(v4u*)(CAT + (size_t)m * DM + hh * 128 + e0) = pack8(y);
    }
}

struct EpiStoreBf16 {
    static constexpr bool PERM = true;
    bf16* O; int ldc;
    __device__ __forceinline__ void operator()(const pg8::f32x4 (&acc)[2][2][4][2], const pg8::Unit& u, int wr, int wc, int fr, int fq) const {
        const int row0 = u.arow0 + wr * 64 + fr, col0 = u.pn * 256 + wc * 32 + 8 * fq;
#pragma unroll
        for (int ai = 0; ai < 2; ++ai)
#pragma unroll
            for (int m = 0; m < 4; ++m) { bf16* rowp = O + (size_t)(row0 + ai * 128 + m * 16) * ldc + col0;
#pragma unroll
                for (int bj = 0; bj < 2; ++bj) { const pg8::f32x4 v0 = acc[ai][bj][m][0], v1 = acc[ai][bj][m][1];
                    v4u w; w.x = pg8::cvt_pk_bf16(v0[0], v0[1]); w.y = pg8::cvt_pk_bf16(v0[2], v0[3]); w.z = pg8::cvt_pk_bf16(v1[0], v1[1]); w.w = pg8::cvt_pk_bf16(v1[2], v1[3]);
                    *(v4u*)(rowp + bj * 128) = w; } }
    }
};
struct EpiResid {
    static constexpr bool PERM = false;
    const float* xin; float* out; const float* gm;
    __device__ __forceinline__ void operator()(const pg8::f32x4 (&acc)[2][2][4][2], const pg8::Unit& u, int wr, int wc, int fr, int fq) const {
        const int row0 = u.arow0 + wr * 64 + fr, col0 = u.pn * 256 + wc * 32 + 4 * fq;
#pragma unroll
        for (int ai = 0; ai < 2; ++ai)
#pragma unroll
            for (int m = 0; m < 4; ++m) { const int row = row0 + ai * 128 + m * 16; const float* gp = gm + (size_t)(row >> 12) * 6144 + col0; const size_t ro = (size_t)row * DM + col0;
#pragma unroll
                for (int bj = 0; bj < 2; ++bj)
#pragma unroll
                    for (int n = 0; n < 2; ++n) { const int c = bj * 128 + n * 16;
                        const pg8::f32x4 x4 = *(const pg8::f32x4*)(xin + ro + c), g4 = *(const pg8::f32x4*)(gp + c);
                        *(pg8::f32x4*)(out + ro + c) = x4 + g4 * acc[ai][bj][m][n]; } }
    }
};
struct EpiF32 {
    static constexpr bool PERM = false;
    float* C; int ldc;
    __device__ __forceinline__ void operator()(const pg8::f32x4 (&acc)[2][2][4][2], const pg8::Unit& u, int wr, int wc, int fr, int fq) const {
        const int row0 = u.arow0 + wr * 64 + fr, col0 = u.pn * 256 + wc * 32 + 4 * fq;
#pragma unroll
        for (int ai = 0; ai < 2; ++ai)
#pragma unroll
            for (int m = 0; m < 4; ++m) { float* rowp = C + (size_t)(row0 + ai * 128 + m * 16) * ldc + col0;
#pragma unroll
                for (int bj = 0; bj < 2; ++bj)
#pragma unroll
                    for (int n = 0; n < 2; ++n) *(pg8::f32x4*)(rowp + bj * 128 + n * 16) = acc[ai][bj][m][n]; }
    }
};
struct EpiGateUp {
    static constexpr bool PERM = true;
    bf16* HB;
    __device__ __forceinline__ void operator()(const pg8::f32x4 (&acc)[2][2][4][2], const pg8::Unit& u, int wr, int wc, int fr, int fq) const {
        const int col0 = u.pn * 128 + wc * 32 + 8 * fq;
#pragma unroll
        for (int ai = 0; ai < 2; ++ai)
#pragma unroll
            for (int m = 0; m < 4; ++m) { const int rl = ai * 128 + wr * 64 + m * 16 + fr;
                float y[8];
#pragma unroll
                for (int n = 0; n < 2; ++n)
#pragma unroll
                    for (int j = 0; j < 4; ++j) y[4 * n + j] = silu(acc[ai][0][m][n][j]) * acc[ai][1][m][n][j];
                if (rl < u.nvalid) *(v4u*)(HB + (size_t)(u.arow0 + rl) * EFF + col0) = pack8(y); }
    }
};
struct EpiDown {
    static constexpr bool PERM = true;
    bf16* Y;
    __device__ __forceinline__ void operator()(const pg8::f32x4 (&acc)[2][2][4][2], const pg8::Unit& u, int wr, int wc, int fr, int fq) const {
        const int col0 = u.pn * 256 + wc * 32 + 8 * fq;
#pragma unroll
        for (int ai = 0; ai < 2; ++ai)
#pragma unroll
            for (int m = 0; m < 4; ++m) { const int rl = ai * 128 + wr * 64 + m * 16 + fr; bf16* rowp = Y + (size_t)(u.arow0 + rl) * DM + col0;
#pragma unroll
                for (int bj = 0; bj < 2; ++bj) { const pg8::f32x4 v0 = acc[ai][bj][m][0], v1 = acc[ai][bj][m][1];
                    v4u w; w.x = pg8::cvt_pk_bf16(v0[0], v0[1]); w.y = pg8::cvt_pk_bf16(v0[2], v0[3]); w.z = pg8::cvt_pk_bf16(v1[0], v1[1]); w.w = pg8::cvt_pk_bf16(v1[2], v1[3]);
                    if (rl < u.nvalid) *(v4u*)(rowp + bj * 128) = w; } }
    }
};

__device__ __forceinline__ void moe_tables(const unsigned* cntg, LAS int* tb, int tid) {
    LAS int* cnt = tb; LAS int* start = tb + 130; LAS int* tpre = tb + 260;
    __syncthreads();
    if (tid < NEXP) cnt[tid] = (int)__hip_atomic_load(cntg + tid, __ATOMIC_RELAXED, __HIP_MEMORY_SCOPE_AGENT);
    if (tid == NEXP) cnt[NEXP] = NTOK;
    __syncthreads();
    if (tid == 0) { int s = 0, t = 0; for (int e = 0; e < NEXP; ++e) { start[e] = s; tpre[e] = t; s += cnt[e]; t += (cnt[e] + 255) >> 8; }
        start[NEXP] = NSLOT; tpre[NEXP] = t; t += NTOK / 256; start[NEXP + 1] = NSLOT_ALL; tpre[NEXP + 1] = t; }
    __syncthreads();
}
struct GroupOrder {
    const LAS int* cnt; const LAS int* start; const LAS int* tpre; const int* list; int ntc, total, G, c;
    __device__ __forceinline__ void init(const LAS int* tb, const int* list_, int ntc_, int G_, int c_) { cnt = tb; start = tb + 130; tpre = tb + 260; list = list_; ntc = ntc_; total = tpre[NEXP + 1] * ntc_; G = G_; c = c_; }
    __device__ __forceinline__ bool next(int i, pg8::Unit& u) const {
        const int L = i * G + c; if (L >= total) return false;
        const int rt = L / ntc, pn = L - rt * ntc;
        int lo = 0, hi = NEXP + 1;
#pragma unroll 1
        while (hi - lo > 1) { const int mid = (lo + hi) >> 1; if (tpre[mid] <= rt) lo = mid; else hi = mid; }
        const int j = rt - tpre[lo], rem = cnt[lo] - 256 * j;
        u.pn = pn; u.arow0 = start[lo] + 256 * j; u.nvalid = rem < 256 ? rem : 256; u.bt = lo * ntc + pn; return true;
    }
    __device__ __forceinline__ int arow(const pg8::Unit& u, int r) const { const int idx = u.arow0 + (r < u.nvalid ? r : u.nvalid - 1); return list ? list[idx] : idx; }
};

__device__ __forceinline__ void topk_phase(const float* LOG, const float* rbias, int* TOPI, float* TOPW, int* RANK, unsigned* cntg, int gw, int NGW, int lane) {
    const f32x2 bias = *(const f32x2*)(rbias + 2 * lane);
    for (int tok = gw; tok < NTOK; tok += NGW) {
        const f32x2 lg = *(const f32x2*)(LOG + (size_t)tok * 256 + 2 * lane);
        const float s0 = sigm_div(lg.x), s1 = sigm_div(lg.y);
        float v0 = s0 + bias.x, v1 = s1 + bias.y;
        float m1 = fmaxf(v0, v1), m2 = fminf(v0, v1);
#pragma unroll
        for (int off = 1; off < 8; off <<= 1) { const float o1 = __shfl_xor(m1, off), o2 = __shfl_xor(m2, off); const float n1 = fmaxf(m1, o1), n2 = fmaxf(fminf(m1, o1), fmaxf(m2, o2)); m1 = n1; m2 = n2; }
        const float gs = m1 + m2; const int myg = lane >> 3; int better = 0;
#pragma unroll
        for (int g = 0; g < 8; ++g) { const float sg = __shfl(gs, g * 8); better += (sg > gs || (sg == gs && g < myg)) ? 1 : 0; }
        if (better >= 4) { v0 = -INFINITY; v1 = -INFINITY; }
        int my_e = 0; float my_s = 0.f, ssum = 0.f;
#pragma unroll
        for (int k = 0; k < 8; ++k) {
            float bv = (v0 >= v1) ? v0 : v1; int bi = (v0 >= v1) ? 2 * lane : 2 * lane + 1;
#pragma unroll
            for (int off = 32; off >= 1; off >>= 1) { const float ov = __shfl_xor(bv, off); const int oi = __shfl_xor(bi, off); if (ov > bv || (ov == bv && oi < bi)) { bv = ov; bi = oi; } }
            const float ws = __shfl((bi & 1) ? s1 : s0, bi >> 1);
            if (lane == (bi >> 1)) { if (bi & 1) v1 = -INFINITY; else v0 = -INFINITY; }
            if (lane == k) { my_e = bi; my_s = ws; }
            ssum += ws;
        }
        if (lane < 8) {
            const unsigned rk = __hip_atomic_fetch_add(cntg + my_e, 1u, __ATOMIC_RELAXED, __HIP_MEMORY_SCOPE_AGENT);
            TOPI[tok * 8 + lane] = my_e; TOPW[tok * 8 + lane] = my_s / ssum * 2.5f; RANK[tok * 8 + lane] = (int)rk;
        }
    }
}
__device__ __forceinline__ void list_phase(const int* TOPI, const int* RANK, int* SLOT, int* LIST, const LAS int* tb, int gtid, int NGT) {
    const LAS int* start = tb + 130;
    for (int p = gtid; p < NSLOT; p += NGT) { const int s = start[TOPI[p]] + RANK[p]; SLOT[p] = s; LIST[s] = p >> 3; }
    for (int i = gtid; i < NTOK; i += NGT) LIST[NSLOT + i] = i;
}
__device__ __forceinline__ void combine_phase(float* X, const bf16* Y, const int* SLOT, const float* TOPW, const float* modl, int g_off,
                                              const float* ngain, const float* modn, int sh_off, int sc_off, bf16* H, const float* fgain, int gw, int NGW, int lane) {
    for (int m = gw; m < NTOK; m += NGW) {
        f32x4 acc[4];
#pragma unroll
        for (int j = 0; j < 4; ++j) acc[j] = (f32x4){0.f, 0.f, 0.f, 0.f};
        const int sl = (lane < 8) ? SLOT[m * 8 + lane] : NSLOT + m; const float wl = (lane < 8) ? TOPW[m * 8 + lane] : 1.f;
#pragma unroll
        for (int k = 0; k < 9; ++k) { const int s = __shfl(sl, k); const float w = __shfl(wl, k);
            const u32x2* yr = (const u32x2*)(Y + (size_t)s * DM) + lane;
#pragma unroll
            for (int j = 0; j < 4; ++j) { const u32x2 q = yr[64 * j]; acc[j] += (f32x4){bflo(q.x), bfhi(q.x), bflo(q.y), bfhi(q.y)} * w; } }
        f32x4* xr = (f32x4*)(X + (size_t)m * DM) + lane; const float* mb = modl + (size_t)(m >> 12) * 6144; f32x4 v[4];
#pragma unroll
        for (int j = 0; j < 4; ++j) v[j] = xr[64 * j] + ((const f32x4*)(mb + g_off))[lane + 64 * j] * acc[j];
        if (fgain) finalnorm_row(v, fgain, X + (size_t)m * DM, lane);
        else {
#pragma unroll
            for (int j = 0; j < 4; ++j) xr[64 * j] = v[j];
            const float* mn = modn + (size_t)(m >> 12) * 6144;
            normmod_row(v, ngain, mn + sh_off, mn + sc_off, H + (size_t)m * DM, lane);
        }
    }
}
__device__ __forceinline__ int q_pull(gu32* head, volatile LAS unsigned* slot, int tid) {
    __syncthreads();
    if (tid == 0) *slot = __hip_atomic_fetch_add(head, 1u, RLX_AGENT);
    __syncthreads();
    return (int)*slot;
}

__device__ __forceinline__ void convqk_phase(const bf16* P, const float* cw, const float* cb, bf16* QKC, int gtid, int NGT) {
    for (int idx = gtid; idx < NTOK * 128; idx += NGT) {
        const int tok = idx >> 7, c0 = (idx & 127) * 8, t = tok & (NT_ - 1);
        float acc[8];
#pragma unroll
        for (int i = 0; i < 8; ++i) acc[i] = cb[c0 + i];
#pragma unroll
        for (int j = 0; j < 5; ++j) { const int tj = t + j - 2;
            if (tj >= 0 && tj < NT_) { float x[8]; unpack8(*(const v4u*)(P + (size_t)(tok + j - 2) * P1W + c0), x);
#pragma unroll
                for (int i = 0; i < 8; ++i) acc[i] += cw[j * 1024 + c0 + i] * x[i]; } }
        const float sc = (c0 >= GW) ? 0.08838834764831845f : 1.f;
#pragma unroll
        for (int i = 0; i < 8; ++i) acc[i] = silu(acc[i]) * sc;
        *(v4u*)(QKC + (size_t)tok * DM + c0) = pack8(acc);
    }
}
__device__ __forceinline__ void na_unit(int u, const bf16* P, const float* rpb, bf16* CAT, int tid) {
    const int b = u >> 6, r = u & 63, col = tid & 63, head = tid >> 6;
    const int tok = b * NT_ + r * 64 + col;
    int rs = r - 4; rs = rs < 0 ? 0 : (rs > 56 ? 56 : rs);
    int cs = col - 8; cs = cs < 0 ? 0 : (cs > 48 ? 48 : cs);
    float q[64], acc[64];
#pragma unroll
    for (int c = 0; c < 8; ++c) { float t8[8]; unpack8(*(const v4u*)(P + (size_t)tok * P1W + 2048 + head * 64 + c * 8), t8);
#pragma unroll
        for (int i = 0; i < 8; ++i) { q[c * 8 + i] = t8[i] * 0.125f; acc[c * 8 + i] = 0.f; } }
    float mx = -INFINITY, l = 0.f;
#pragma unroll 1
    for (int i = 0; i < 8; ++i) {
        const float* bp = rpb + head * 465 + (rs + i - r + 7) * 31 + (cs - col + 15);
#pragma unroll 1
        for (int j = 0; j < 16; ++j) {
            const bf16* kr = P + (size_t)(b * NT_ + (rs + i) * 64 + cs + j) * P1W + 2560 + head * 64;
            float s = bp[j];
#pragma unroll
            for (int c = 0; c < 8; ++c) { float t8[8]; unpack8(*(const v4u*)(kr + c * 8), t8);
#pragma unroll
                for (int d = 0; d < 8; ++d) s += q[c * 8 + d] * t8[d]; }
            const float mn = fmaxf(mx, s), a = __expf(mx - mn), p = __expf(s - mn);
            l = l * a + p; mx = mn;
            const bf16* vr = kr + 512;
#pragma unroll
            for (int c = 0; c < 8; ++c) { float t8[8]; unpack8(*(const v4u*)(vr + c * 8), t8);
#pragma unroll
                for (int d = 0; d < 8; ++d) acc[c * 8 + d] = acc[c * 8 + d] * a + p * t8[d]; }
        }
    }
    const float il = 1.f / l;
#pragma unroll
    for (int c = 0; c < 8; ++c) { float y[8];
#pragma unroll
        for (int d = 0; d < 8; ++d) y[d] = acc[c * 8 + d] * il;
        *(v4u*)(CAT + (size_t)tok * DM + GW + head * 64 + c * 8) = pack8(y); }
}

namespace da {
using bf16x8 = __attribute__((ext_vector_type(8))) short;
using s16x4  = __attribute__((ext_vector_type(4))) short;
using f32x16 = __attribute__((ext_vector_type(16))) float;
constexpr float SCALE = 0.125f;
constexpr float THR = 8.f;
constexpr int KVBLK = 64, SHM_V = 16384, SHM_K = 16384;
#define DA_KSWZ(row, colB) ((row) * 256 + ((colB) ^ (((row) & 7) << 4)))
#define DA_SBAR() __builtin_amdgcn_sched_barrier(0)
__device__ __forceinline__ int crow(int r, int hi) { return (r & 3) + 8 * (r >> 2) + 4 * hi; }
__device__ __forceinline__ unsigned cvtpk(float lo, float hi) { unsigned r; asm volatile("v_cvt_pk_bf16_f32 %0, %1, %2" : "=v"(r) : "v"(lo), "v"(hi)); return r; }
__device__ __forceinline__ void partialSM(f32x16& p0, f32x16& p1, float& m_reg, float& mn, float& alpha) {
  constexpr float C = SCALE * 1.4426950408889634f;
  float pmax = p0[0];
#pragma unroll
  for (int r = 1; r < 16; ++r) pmax = fmaxf(pmax, p0[r]);
#pragma unroll
  for (int r = 0; r < 16; ++r) pmax = fmaxf(pmax, p1[r]);
  { auto rr = __builtin_amdgcn_permlane32_swap(__float_as_uint(pmax), __float_as_uint(pmax), false, false);
    pmax = fmaxf(__uint_as_float(rr[0]), __uint_as_float(rr[1])); }
  if (__builtin_expect(__all(pmax - m_reg <= THR / SCALE), 1)) { mn = m_reg; alpha = 1.f; }
  else { mn = fmaxf(m_reg, pmax); alpha = __builtin_amdgcn_exp2f((m_reg - mn) * C); m_reg = mn; }
  float mnC = -mn * C;
#pragma unroll
  for (int r = 0; r < 16; ++r) p0[r] = fmaf(p0[r], C, mnC);
#pragma unroll
  for (int r = 0; r < 16; ++r) p1[r] = fmaf(p1[r], C, mnC);
#pragma unroll
  for (int r = 0; r < 16; ++r) p0[r] = __builtin_amdgcn_exp2f(p0[r]);
}
__device__ __forceinline__ void finishSM(f32x16& p0, f32x16& p1, float alpha, float& l_reg, bf16x8& pa0, bf16x8& pa1, bf16x8& pa2, bf16x8& pa3) {
#pragma unroll
  for (int r = 0; r < 16; ++r) p1[r] = __builtin_amdgcn_exp2f(p1[r]);
  float ps = 0;
#pragma unroll
  for (int r = 0; r < 16; ++r) ps += p0[r];
#pragma unroll
  for (int r = 0; r < 16; ++r) ps += p1[r];
  { auto rr = __builtin_amdgcn_permlane32_swap(__float_as_uint(ps), __float_as_uint(ps), false, false);
    ps = __uint_as_float(rr[0]) + __uint_as_float(rr[1]); }
  l_reg = l_reg * alpha + ps;
#define DA_PK4(P, BASE, OUT) do { unsigned a0 = cvtpk(P[BASE + 0], P[BASE + 1]), a1 = cvtpk(P[BASE + 2], P[BASE + 3]);   \
    unsigned b0 = cvtpk(P[BASE + 4], P[BASE + 5]), b1 = cvtpk(P[BASE + 6], P[BASE + 7]);                              \
    auto r0 = __builtin_amdgcn_permlane32_swap(a0, b0, false, false); auto r1 = __builtin_amdgcn_permlane32_swap(a1, b1, false, false); \
    v4u w = {r0[0], r1[0], r0[1], r1[1]}; OUT = __builtin_bit_cast(bf16x8, w); } while (0)
  DA_PK4(p0, 0, pa0); DA_PK4(p0, 8, pa1); DA_PK4(p1, 0, pa2); DA_PK4(p1, 8, pa3);
#undef DA_PK4
}
__device__ __forceinline__ void qkt(f32x16& p0, f32x16& p1, const LAS char* Ks, const bf16x8 (&qr)[4], int r32, int hi, int mapB) {
  p0 = f32x16{}; p1 = f32x16{};
#pragma unroll
  for (int d0 = 0; d0 < 4; ++d0) { const int cb = mapB + (d0 * 16 + hi * 8) * 2;
    const bf16x8 b0 = *(const LAS bf16x8*)(Ks + DA_KSWZ(r32, cb));
    const bf16x8 b1 = *(const LAS bf16x8*)(Ks + DA_KSWZ(32 + r32, cb));
    p0 = __builtin_amdgcn_mfma_f32_32x32x16_bf16(b0, qr[d0], p0, 0, 0, 0);
    p1 = __builtin_amdgcn_mfma_f32_32x32x16_bf16(b1, qr[d0], p1, 0, 0, 0); }
}
__device__ __forceinline__ int v_st(int k, int c) { const int kk = (k & ~0xC) | ((k & 4) << 1) | ((k & 8) >> 1); return ((kk >> 3) * 4 + (c >> 5)) * 512 + ((kk & 7) * 32 + (c & 31)) * 2; }
__device__ __forceinline__ int v_rd_base(int lane) { return ((lane & 3) << 3) | (((lane >> 2) & 3) << 6) | (((lane >> 4) & 1) << 5) | (((lane >> 5) & 1) << 8); }
constexpr int v_rd_off(int d0, int ks, int half) { return d0 * 512 + ks * 4096 + half * 2048; }
template <int OFF> __device__ __forceinline__ s16x4 tr_read(int vb) {
  s16x4 r; asm volatile("ds_read_b64_tr_b16 %0, %1 offset:%2" : "=&v"(r) : "v"(vb), "i"(OFF) : "memory"); return r;
}
template <int D0> __device__ __forceinline__ void pv_one(f32x16& od, int vb, bf16x8 pa0, bf16x8 pa1, bf16x8 pa2, bf16x8 pa3) {
  const s16x4 l0 = tr_read<v_rd_off(D0, 0, 0)>(vb), h0 = tr_read<v_rd_off(D0, 0, 1)>(vb), l1 = tr_read<v_rd_off(D0, 1, 0)>(vb), h1 = tr_read<v_rd_off(D0, 1, 1)>(vb);
  const s16x4 l2 = tr_read<v_rd_off(D0, 2, 0)>(vb), h2 = tr_read<v_rd_off(D0, 2, 1)>(vb), l3 = tr_read<v_rd_off(D0, 3, 0)>(vb), h3 = tr_read<v_rd_off(D0, 3, 1)>(vb);
  asm volatile("s_waitcnt lgkmcnt(0)" ::: "memory"); DA_SBAR();
#define DA_PK(L, H) (bf16x8){L[0], L[1], L[2], L[3], H[0], H[1], H[2], H[3]}
  od = __builtin_amdgcn_mfma_f32_32x32x16_bf16(pa0, DA_PK(l0, h0), od, 0, 0, 0);
  od = __builtin_amdgcn_mfma_f32_32x32x16_bf16(pa1, DA_PK(l1, h1), od, 0, 0, 0);
  od = __builtin_amdgcn_mfma_f32_32x32x16_bf16(pa2, DA_PK(l2, h2), od, 0, 0, 0);
  od = __builtin_amdgcn_mfma_f32_32x32x16_bf16(pa3, DA_PK(l3, h3), od, 0, 0, 0);
#undef DA_PK
}
__device__ __forceinline__ void pv_d0(f32x16 (&o)[4], int vb, bf16x8 pa0, bf16x8 pa1, bf16x8 pa2, bf16x8 pa3) {
  pv_one<0>(o[0], vb, pa0, pa1, pa2, pa3); pv_one<1>(o[1], vb, pa0, pa1, pa2, pa3); pv_one<2>(o[2], vb, pa0, pa1, pa2, pa3); pv_one<3>(o[3], vb, pa0, pa1, pa2, pa3);
}
__device__ __forceinline__ void unit(int u, const bf16* P, float lam, const float* subln, bf16* CAT, LAS char* lds, int tid) {
  const int qb = u & 31, h = (u >> 5) & 3, b = u >> 7;
  const int wid = tid >> 6, lane = tid & 63, r32 = lane & 31, hi = lane >> 5, mp = wid >> 2, wq = wid & 3;
  LAS char* V_lds = lds; LAS char* K_lds = lds + 2 * SHM_V;
  LAS float* ws = (LAS float*)(lds + 2 * SHM_V + 2 * SHM_K) + wid * 64; LAS float* li_l = ws; LAS float* al_l = ws + 32;
  float m_reg = -1e30f, l_reg = 0; f32x16 o[4] = {}; bf16x8 qr[4];
  const size_t rowbase = (size_t)b * NT_;
  const bf16* Qw = P + (rowbase + qb * 128 + wq * 32 + r32) * P0W + 2560 + h * 128 + mp * 64 + hi * 8;
#pragma unroll
  for (int d0 = 0; d0 < 4; ++d0) qr[d0] = *(const bf16x8*)(Qw + d0 * 16);
  const bf16* Kh = P + rowbase * P0W + 3072 + h * 128; const bf16* Vh = P + rowbase * P0W + 3584 + h * 128;
  const int mapB = mp * 128;
  const int sr = tid >> 4, sc = (tid & 15) * 8, vst0 = v_st(sr, sc), vst1 = v_st(32 + sr, sc);
  const int vb0 = (int)(uintptr_t)V_lds + v_rd_base(lane);
  struct { bf16x8 vs0, vs1, ks0, ks1; } sr_[2];
#define DA_SLOAD(i, k0) do { sr_[i].vs0 = *(const bf16x8*)(&Vh[(size_t)((k0) + sr) * P0W + sc]); sr_[i].vs1 = *(const bf16x8*)(&Vh[(size_t)((k0) + 32 + sr) * P0W + sc]); \
    sr_[i].ks0 = *(const bf16x8*)(&Kh[(size_t)((k0) + sr) * P0W + sc]); sr_[i].ks1 = *(const bf16x8*)(&Kh[(size_t)((k0) + 32 + sr) * P0W + sc]); } while (0)
#define DA_SWRITE(bb, i) do { *(LAS bf16x8*)(V_lds + (bb) * SHM_V + vst0) = sr_[i].vs0;          \
    *(LAS bf16x8*)(V_lds + (bb) * SHM_V + vst1) = sr_[i].vs1; const int kc = sc * 2;               \
    *(LAS bf16x8*)(K_lds + (bb) * SHM_K + DA_KSWZ(sr, kc)) = sr_[i].ks0;                       \
    *(LAS bf16x8*)(K_lds + (bb) * SHM_K + DA_KSWZ(32 + sr, kc)) = sr_[i].ks1; } while (0)
#define DA_SWAIT() asm volatile("s_waitcnt vmcnt(4)" ::: "memory")
#define DA_RESC(a) do { if (__any((a) < 1.f)) { if (hi == 0) al_l[r32] = (a); asm volatile("s_waitcnt lgkmcnt(0)" ::: "memory"); \
    _Pragma("unroll") for (int d = 0; d < 4; ++d) _Pragma("unroll") for (int r = 0; r < 16; ++r) o[d][r] *= al_l[crow(r, hi)]; } } while (0)
  f32x16 pA0, pA1, pB0, pB1; float mnA, mnB, alA, alB; bf16x8 pa0, pa1, pa2, pa3; constexpr int NT = NT_ / KVBLK;
  DA_SLOAD(0, 0); asm volatile("s_waitcnt vmcnt(0)" ::: "memory"); DA_SWRITE(0, 0); __syncthreads();
  qkt(pA0, pA1, K_lds, qr, r32, hi, mapB); partialSM(pA0, pA1, m_reg, mnA, alA);
  DA_SLOAD(1, KVBLK); DA_SLOAD(0, 2 * KVBLK);
  DA_SWAIT(); DA_SWRITE(1, 1); __syncthreads();
  for (int j = 1; j + 1 < NT; j += 2) {
    DA_SBAR(); qkt(pB0, pB1, K_lds + SHM_K, qr, r32, hi, mapB);
    finishSM(pA0, pA1, alA, l_reg, pa0, pa1, pa2, pa3); DA_SBAR();
    DA_SLOAD(1, (j + 2) * KVBLK); DA_SBAR();
    pv_d0(o, vb0, pa0, pa1, pa2, pa3); partialSM(pB0, pB1, m_reg, mnB, alB);
    __syncthreads(); DA_SWAIT(); DA_SWRITE(0, 0);
    DA_RESC(alB); __syncthreads();
    DA_SBAR(); qkt(pA0, pA1, K_lds, qr, r32, hi, mapB);
    finishSM(pB0, pB1, alB, l_reg, pa0, pa1, pa2, pa3); DA_SBAR();
    if (j + 3 < NT) DA_SLOAD(0, (j + 3) * KVBLK); DA_SBAR();
    pv_d0(o, vb0 + SHM_V, pa0, pa1, pa2, pa3); partialSM(pA0, pA1, m_reg, mnA, alA);
    __syncthreads(); DA_SWAIT(); DA_SWRITE(1, 1);
    DA_RESC(alA); __syncthreads();
  }
  DA_SBAR(); qkt(pB0, pB1, K_lds + SHM_K, qr, r32, hi, mapB);
  finishSM(pA0, pA1, alA, l_reg, pa0, pa1, pa2, pa3); DA_SBAR();
  pv_d0(o, vb0, pa0, pa1, pa2, pa3); partialSM(pB0, pB1, m_reg, mnB, alB);
  __syncthreads(); DA_RESC(alB);
  finishSM(pB0, pB1, alB, l_reg, pa0, pa1, pa2, pa3); DA_SBAR();
  pv_d0(o, vb0 + SHM_V, pa0, pa1, pa2, pa3);
  if (hi == 0) li_l[r32] = l_reg; asm volatile("s_waitcnt lgkmcnt(0)" ::: "memory");
  float rli[16];
#pragma unroll
  for (int r = 0; r < 16; ++r) rli[r] = __builtin_amdgcn_rcpf(li_l[crow(r, hi)]);
  __syncthreads();
  LAS float* X = (LAS float*)lds;
  if (mp == 1) {
#pragma unroll
    for (int d0 = 0; d0 < 4; ++d0)
#pragma unroll
      for (int r = 0; r < 16; ++r) X[(wq * 32 + crow(r, hi)) * 128 + d0 * 32 + r32] = o[d0][r] * rli[r];
  }
  __syncthreads();
  if (mp == 0) {
#pragma unroll
    for (int d0 = 0; d0 < 4; ++d0)
#pragma unroll
      for (int r = 0; r < 16; ++r) { const int ix = (wq * 32 + crow(r, hi)) * 128 + d0 * 32 + r32; X[ix] = o[d0][r] * rli[r] - lam * X[ix]; }
  }
  __syncthreads();
  { const int row = tid >> 2, qtr = tid & 3; const LAS f32x4* xp = (const LAS f32x4*)(X + row * 128 + qtr * 32); f32x4 xv[8]; float ss = 0.f;
#pragma unroll
    for (int i = 0; i < 8; ++i) { xv[i] = xp[i]; ss += (xv[i].x * xv[i].x + xv[i].y * xv[i].y) + (xv[i].z * xv[i].z + xv[i].w * xv[i].w); }
    ss += __shfl_xor(ss, 1); ss += __shfl_xor(ss, 2);
    const float rr = 0.8f / sqrtf(ss * (1.f / 128.f) + EPS);
    bf16* op = CAT + (rowbase + qb * 128 + row) * DM + GW + h * 128 + qtr * 32;
#pragma unroll
    for (int i = 0; i < 4; ++i) { const f32x4 g0 = *(const f32x4*)(subln + qtr * 32 + i * 8), g1 = *(const f32x4*)(subln + qtr * 32 + i * 8 + 4);
      const f32x4 y0 = xv[2 * i] * rr * g0, y1 = xv[2 * i + 1] * rr * g1;
      v4u w; w.x = pk2(y0.x, y0.y); w.y = pk2(y0.z, y0.w); w.z = pk2(y1.x, y1.y); w.w = pk2(y1.z, y1.w);
      *(v4u*)(op + i * 8) = w; } }
  __syncthreads();
#undef DA_SLOAD
#undef DA_SWRITE
#undef DA_SWAIT
#undef DA_RESC
}
}
namespace sc {
using bf16x8 = __attribute__((ext_vector_type(8))) short;
using f32x16 = __attribute__((ext_vector_type(16))) float;
constexpr int RS = 272;
constexpr int TS = 144;
template <int NS> __device__ __forceinline__ void mm(f32x16& c, const LAS char* xb, int xs, const LAS char* yb, int ys, int kb0, int lane) {
    const int r = lane & 31, h = lane >> 5;
    const LAS char* xp = xb + r * xs + kb0 + h * 16; const LAS char* yp = yb + r * ys + kb0 + h * 16;
#pragma unroll
    for (int s = 0; s < NS; ++s) { const bf16x8 a = *(const LAS bf16x8*)(xp + s * 32), b = *(const LAS bf16x8*)(yp + s * 32); c = __builtin_amdgcn_mfma_f32_32x32x16_bf16(a, b, c, 0, 0, 0); }
}
__device__ __forceinline__ unsigned long long pk4(float a, float b, float c, float d) { return (unsigned long long)pk2(a, b) | ((unsigned long long)pk2(c, d) << 32); }

__device__ __forceinline__ void hgrn_unit(int u, const bf16* P, const float* lbl, float* OF, float* OB, LAS unsigned char* ldsu, int tid) {
    const int b = u >> 3, h = (u >> 1) & 3, dir = u & 1, wave = __builtin_amdgcn_readfirstlane(tid >> 6);
    LAS char* lds = (LAS char*)ldsu;
    LAS char* QM = lds; LAS char* KM = lds + 17408; LAS char* KMt = lds + 34816; LAS char* Vt = lds + 53248; LAS char* ST = lds + 71680; LAS char* AA = lds + 106496;
    LAS float* GT = (LAS float*)(lds + 115712); LAS float* CM = (LAS float*)(lds + 117760); LAS float* DL = (LAS float*)(lds + 118272); LAS float* FC = (LAS float*)(lds + 118784);
    float* OUT = dir ? OB : OF;
    float lb; { const int d = tid & 127; const float l0 = lbl[dir * GW + h * 128 + d], l1 = lbl[2 * GW + dir * GW + h * 128 + d]; lb = __builtin_amdgcn_rcpf(1.f + __expf(l1 - l0)); }
    const bf16* Pq = P + (size_t)b * NT_ * P0W + h * 128 + (tid & 127);
    const int fofs = dir ? 1536 : 1024;
    const int et = wave & 3, dt0 = 2 * (wave >> 2), tt = wave >> 2;
    const int tg = tid >> 7;
    f32x16 S0 = {}, S1 = {};
    unsigned short rq[16], rf[16], rv[16];
#define HG_LOAD(c) do { _Pragma("unroll") for (int j = 0; j < 16; ++j) { const int tl = (c) * 64 + tg * 16 + j; const int tok = dir ? (NT_ - 1 - tl) : tl; \
        const bf16* p = Pq + (size_t)tok * P0W; rq[j] = p[0]; rv[j] = p[512]; rf[j] = p[fofs]; } } while (0)
    HG_LOAD(0);
#pragma unroll 1
    for (int c = 0; c < NT_ / 64; ++c) {
        int tl_ = tid; asm volatile("" : "+v"(tl_)); const int d = tl_ & 127, lane = tl_ & 63;
        float qv[16], kv[16], cum[16]; float run = 0.f;
#pragma unroll
        for (int j = 0; j < 16; ++j) { const float fg = lb + (1.f - lb) * sigm(bf2f(rf[j])); run += __logf(fg); cum[j] = run; kv[j] = 1.f - fg; qv[j] = silu(bf2f(rq[j])); }
        GT[tg * 128 + d] = run;
        __syncthreads();
        const float g0 = GT[d], g1 = GT[128 + d], g2 = GT[256 + d], g3 = GT[384 + d];
        const float cmid = g0 + g1, cL = cmid + g2 + g3;
        const float off = (tg == 0 ? 0.f : tg == 1 ? g0 : tg == 2 ? cmid : cmid + g2) - cmid;
        if (tg == 0) { CM[d] = __expf(cmid); DL[d] = __expf(cL); FC[d] = __expf(cL - cmid); }
        { unsigned kmw[8];
#pragma unroll
          for (int j = 0; j < 16; j += 2) {
              float x0 = off + cum[j], x1 = off + cum[j + 1];
              x0 = fminf(fmaxf(x0, -80.f), 80.f); x1 = fminf(fmaxf(x1, -80.f), 80.f);
              const float qm0 = qv[j] * __expf(x0), qm1 = qv[j + 1] * __expf(x1), km0 = kv[j] * __expf(-x0), km1 = kv[j + 1] * __expf(-x1);
              const unsigned qmp = pk2(qm0, qm1), kmp = pk2(km0, km1);
              const int t0 = tg * 16 + j;
              *(LAS unsigned short*)(QM + t0 * RS + d * 2) = (unsigned short)qmp; *(LAS unsigned short*)(QM + (t0 + 1) * RS + d * 2) = (unsigned short)(qmp >> 16);
              *(LAS unsigned short*)(KM + t0 * RS + d * 2) = (unsigned short)kmp; *(LAS unsigned short*)(KM + (t0 + 1) * RS + d * 2) = (unsigned short)(kmp >> 16);
              kmw[j >> 1] = kmp; }
          *(LAS v4u*)(KMt + d * TS + tg * 32) = (v4u){kmw[0], kmw[1], kmw[2], kmw[3]}; *(LAS v4u*)(KMt + d * TS + tg * 32 + 16) = (v4u){kmw[4], kmw[5], kmw[6], kmw[7]};
          v4u v0, v1; v0.x = rv[0] | ((unsigned)rv[1] << 16); v0.y = rv[2] | ((unsigned)rv[3] << 16); v0.z = rv[4] | ((unsigned)rv[5] << 16); v0.w = rv[6] | ((unsigned)rv[7] << 16);
          v1.x = rv[8] | ((unsigned)rv[9] << 16); v1.y = rv[10] | ((unsigned)rv[11] << 16); v1.z = rv[12] | ((unsigned)rv[13] << 16); v1.w = rv[14] | ((unsigned)rv[15] << 16);
          *(LAS v4u*)(Vt + d * TS + tg * 32) = v0; *(LAS v4u*)(Vt + d * TS + tg * 32 + 16) = v1; }
        if (c + 1 < NT_ / 64) HG_LOAD(c + 1);
        __syncthreads();
        { const int e = 32 * et + (lane & 31);
#pragma unroll
          for (int k = 0; k < 2; ++k)
#pragma unroll
              for (int i4 = 0; i4 < 4; ++i4) { const int d0 = 32 * (dt0 + k) + 8 * i4 + 4 * (lane >> 5); const f32x4 cm = *(const LAS f32x4*)(CM + d0);
                  const f32x16& S = k ? S1 : S0;
                  *(LAS unsigned long long*)(ST + e * RS + d0 * 2) = pk4(S[4 * i4] * cm.x, S[4 * i4 + 1] * cm.y, S[4 * i4 + 2] * cm.z, S[4 * i4 + 3] * cm.w); } }
        __syncthreads();
        f32x16 acc = {};
        mm<8>(acc, QM + 32 * tt * RS, RS, ST + 32 * et * RS, RS, 0, lane);
        if (wave < 3) { const int st = wave >> 1, t2 = (wave + 1) >> 1;
            f32x16 at = {};
            mm<8>(at, KM + 32 * st * RS, RS, QM + 32 * t2 * RS, RS, 0, lane);
            const int tg_ = 32 * t2 + (lane & 31);
#pragma unroll
            for (int i4 = 0; i4 < 4; ++i4) { const int s0 = 32 * st + 8 * i4 + 4 * (lane >> 5);
                *(LAS unsigned long long*)(AA + tg_ * TS + s0 * 2) = pk4(s0 <= tg_ ? at[4 * i4] : 0.f, s0 + 1 <= tg_ ? at[4 * i4 + 1] : 0.f, s0 + 2 <= tg_ ? at[4 * i4 + 2] : 0.f, s0 + 3 <= tg_ ? at[4 * i4 + 3] : 0.f); } }
#pragma unroll
        for (int k = 0; k < 2; ++k) { f32x16 p = {};
            mm<4>(p, KMt + 32 * (dt0 + k) * TS, TS, Vt + 32 * et * TS, TS, 0, lane);
            f32x16& S = k ? S1 : S0;
#pragma unroll
            for (int i4 = 0; i4 < 4; ++i4) { const int d0 = 32 * (dt0 + k) + 8 * i4 + 4 * (lane >> 5); const f32x4 dl = *(const LAS f32x4*)(DL + d0), fc = *(const LAS f32x4*)(FC + d0);
                S[4 * i4] = dl.x * S[4 * i4] + fc.x * p[4 * i4]; S[4 * i4 + 1] = dl.y * S[4 * i4 + 1] + fc.y * p[4 * i4 + 1];
                S[4 * i4 + 2] = dl.z * S[4 * i4 + 2] + fc.z * p[4 * i4 + 2]; S[4 * i4 + 3] = dl.w * S[4 * i4 + 3] + fc.w * p[4 * i4 + 3]; } }
        __syncthreads();
        if (tt == 0) mm<2>(acc, AA, TS, Vt + 32 * et * TS, TS, 0, lane); else mm<4>(acc, AA + 32 * TS, TS, Vt + 32 * et * TS, TS, 0, lane);
#pragma unroll
        for (int i = 0; i < 16; ++i) { const int tl = c * 64 + 32 * tt + 8 * (i >> 2) + 4 * (lane >> 5) + (i & 3); const int tok = dir ? (NT_ - 1 - tl) : tl;
            OUT[(size_t)(b * NT_ + tok) * GW + h * 128 + 32 * et + (lane & 31)] = acc[i]; }
    }
#undef HG_LOAD
    __syncthreads();
}

__device__ __forceinline__ void mlstm_unit(int u, const bf16* P, const bf16* QKC, const float* ibias, const float* fbias, float* HF, float* HBk, LAS unsigned char* ldsu, int tid) {
    const int b = u >> 3, h = (u >> 1) & 3, dir = u & 1, tg = tid >> 7, wave = __builtin_amdgcn_readfirstlane(tid >> 6);
    LAS char* lds = (LAS char*)ldsu;
    LAS char* Qs = lds; LAS char* Ks = lds + 17408; LAS char* KWt = lds + 34816; LAS char* Vt = lds + 53248; LAS char* ST = lds + 71680; LAS char* AA = lds + 106496;
    LAS float* ROWF = (LAS float*)(lds + 115712); LAS float* COLF = ROWF + 64; LAS float* WS = COLF + 64; LAS float* DENI = WS + 64; LAS float* DENA = DENI + 64;
    LAS float* NV = DENA + 128; LAS float* SCL = NV + 128;
    float* OUT = dir ? HBk : HF;
    const float ib = ibias[dir * 4 + h], fb = fbias[dir * 4 + h];
    const bf16* Pv = P + (size_t)b * NT_ * P1W + 1024 + h * 128 + (tid & 127); const bf16* Pg = P + (size_t)b * NT_ * P1W + 3584 + dir * 8 + h;
    const bf16* Qg = QKC + (size_t)b * NT_ * DM + h * 128 + (tid & 127);
    const int et = wave & 3, dt0 = 2 * (wave >> 2), tt = wave >> 2;
    f32x16 S0 = {}, S1 = {};
    if (tid < 128) NV[tid] = 0.f;
    unsigned short rq[16], rk[16], rv[16]; float gi = 0.f, gf = 0.f;
#define ML_LOAD(c) do { _Pragma("unroll") for (int j = 0; j < 16; ++j) { const int tl = (c) * 64 + tg * 16 + j; const int tok = dir ? (NT_ - 1 - tl) : tl; \
        rq[j] = Qg[(size_t)tok * DM]; rk[j] = Qg[(size_t)tok * DM + GW]; rv[j] = Pv[(size_t)tok * P1W]; } \
        if (tid < 64) { const int tl = (c) * 64 + tid; const int tok = dir ? (NT_ - 1 - tl) : tl; gi = bf2f(Pg[(size_t)tok * P1W]); gf = bf2f(Pg[(size_t)tok * P1W + 4]); } } while (0)
    ML_LOAD(0);
#pragma unroll 1
    for (int c = 0; c < NT_ / 64; ++c) {
        int tl_ = tid; asm volatile("" : "+v"(tl_)); const int d = tl_ & 127, lane = tl_ & 63;
        if (tid < 64) { const float ig = gi + ib, x = gf + fb; const float lf = -__logf(1.f + __expf(-x));
            float cs = lf;
#pragma unroll
            for (int o = 1; o < 64; o <<= 1) { const float t = __shfl_up(cs, o); if (lane >= o) cs += t; }
            const float cL = __shfl(cs, 63);
            ROWF[tid] = __expf(cs); COLF[tid] = __expf(ig - cs); WS[tid] = __expf(cL - cs + ig); if (tid == 0) SCL[0] = __expf(cL); }
        __syncthreads();
        { unsigned kw[8];
#pragma unroll
          for (int j = 0; j < 16; j += 2) { const int t0 = tg * 16 + j;
              *(LAS unsigned short*)(Qs + t0 * RS + d * 2) = rq[j]; *(LAS unsigned short*)(Qs + (t0 + 1) * RS + d * 2) = rq[j + 1];
              *(LAS unsigned short*)(Ks + t0 * RS + d * 2) = rk[j]; *(LAS unsigned short*)(Ks + (t0 + 1) * RS + d * 2) = rk[j + 1];
              kw[j >> 1] = pk2(bf2f(rk[j]) * WS[t0], bf2f(rk[j + 1]) * WS[t0 + 1]); }
          *(LAS v4u*)(KWt + d * TS + tg * 32) = (v4u){kw[0], kw[1], kw[2], kw[3]}; *(LAS v4u*)(KWt + d * TS + tg * 32 + 16) = (v4u){kw[4], kw[5], kw[6], kw[7]};
          v4u v0, v1; v0.x = rv[0] | ((unsigned)rv[1] << 16); v0.y = rv[2] | ((unsigned)rv[3] << 16); v0.z = rv[4] | ((unsigned)rv[5] << 16); v0.w = rv[6] | ((unsigned)rv[7] << 16);
          v1.x = rv[8] | ((unsigned)rv[9] << 16); v1.y = rv[10] | ((unsigned)rv[11] << 16); v1.z = rv[12] | ((unsigned)rv[13] << 16); v1.w = rv[14] | ((unsigned)rv[15] << 16);
          *(LAS v4u*)(Vt + d * TS + tg * 32) = v0; *(LAS v4u*)(Vt + d * TS + tg * 32 + 16) = v1; }
        if (c + 1 < NT_ / 64) ML_LOAD(c + 1);
        __syncthreads();
        { const int e = 32 * et + (lane & 31);
#pragma unroll
          for (int k = 0; k < 2; ++k)
#pragma unroll
              for (int i4 = 0; i4 < 4; ++i4) { const int d0 = 32 * (dt0 + k) + 8 * i4 + 4 * (lane >> 5); const f32x16& S = k ? S1 : S0;
                  *(LAS unsigned long long*)(ST + e * RS + d0 * 2) = pk4(S[4 * i4], S[4 * i4 + 1], S[4 * i4 + 2], S[4 * i4 + 3]); } }
        { const int t = tid >> 3, part = tid & 7; float qf[16]; unpack8(*(const LAS v4u*)(Qs + t * RS + part * 32), *(float(*)[8])&qf[0]); unpack8(*(const LAS v4u*)(Qs + t * RS + part * 32 + 16), *(float(*)[8])&qf[8]);
          float s = 0.f;
#pragma unroll
          for (int i = 0; i < 16; ++i) s += qf[i] * NV[part * 16 + i];
          s += __shfl_xor(s, 1); s += __shfl_xor(s, 2); s += __shfl_xor(s, 4);
          if (part == 0) DENI[t] = s * ROWF[t]; }
        __syncthreads();
        f32x16 acc = {};
        mm<8>(acc, Qs + 32 * tt * RS, RS, ST + 32 * et * RS, RS, 0, lane);
#pragma unroll
        for (int i4 = 0; i4 < 4; ++i4) { const f32x4 rf = *(const LAS f32x4*)(ROWF + 32 * tt + 8 * i4 + 4 * (lane >> 5));
            acc[4 * i4] *= rf.x; acc[4 * i4 + 1] *= rf.y; acc[4 * i4 + 2] *= rf.z; acc[4 * i4 + 3] *= rf.w; }
        if (wave < 3) { const int st = wave >> 1, t2 = (wave + 1) >> 1;
            f32x16 at = {};
            mm<8>(at, Ks + 32 * st * RS, RS, Qs + 32 * t2 * RS, RS, 0, lane);
            const int tg_ = 32 * t2 + (lane & 31); const float rowf = ROWF[tg_]; float dsum = 0.f;
#pragma unroll
            for (int i4 = 0; i4 < 4; ++i4) { const int s0 = 32 * st + 8 * i4 + 4 * (lane >> 5); const f32x4 cf = *(const LAS f32x4*)(COLF + s0);
                const float a0 = s0 <= tg_ ? at[4 * i4] * cf.x * rowf : 0.f, a1 = s0 + 1 <= tg_ ? at[4 * i4 + 1] * cf.y * rowf : 0.f;
                const float a2 = s0 + 2 <= tg_ ? at[4 * i4 + 2] * cf.z * rowf : 0.f, a3 = s0 + 3 <= tg_ ? at[4 * i4 + 3] * cf.w * rowf : 0.f;
                dsum += (a0 + a1) + (a2 + a3);
                *(LAS unsigned long long*)(AA + tg_ * TS + s0 * 2) = pk4(a0, a1, a2, a3); }
            dsum += __shfl_xor(dsum, 32);
            if (lane < 32) DENA[st * 64 + tg_] = dsum;
            if (wave == 0 && lane < 32) DENA[64 + lane] = 0.f; }
        { const float dls = SCL[0];
#pragma unroll
          for (int k = 0; k < 2; ++k) { f32x16 p = {};
              mm<4>(p, KWt + 32 * (dt0 + k) * TS, TS, Vt + 32 * et * TS, TS, 0, lane);
              f32x16& S = k ? S1 : S0;
#pragma unroll
              for (int i = 0; i < 16; ++i) S[i] = dls * S[i] + p[i]; }
          if (tid < 128) { float s = 0.f;
#pragma unroll
              for (int q8 = 0; q8 < 8; ++q8) { float f8[8]; unpack8(*(const LAS v4u*)(KWt + tid * TS + q8 * 16), f8);
#pragma unroll
                  for (int i = 0; i < 8; ++i) s += f8[i]; }
              NV[tid] = dls * NV[tid] + s; } }
        __syncthreads();
        if (tt == 0) mm<2>(acc, AA, TS, Vt + 32 * et * TS, TS, 0, lane); else mm<4>(acc, AA + 32 * TS, TS, Vt + 32 * et * TS, TS, 0, lane);
#pragma unroll
        for (int i = 0; i < 16; ++i) { const int tc = 32 * tt + 8 * (i >> 2) + 4 * (lane >> 5) + (i & 3); const int tl = c * 64 + tc; const int tok = dir ? (NT_ - 1 - tl) : tl;
            const float den = DENI[tc] + DENA[tc] + DENA[64 + tc];
            OUT[(size_t)(b * NT_ + tok) * GW + h * 128 + 32 * et + (lane & 31)] = acc[i] / fmaxf(fabsf(den), 1.f); }
    }
#undef ML_LOAD
    __syncthreads();
}
}
#ifndef STOP_AFTER
#define STOP_AFTER 25
#endif
constexpr int N_PHASES = 26;
struct Args { const float* in[44]; float* out; unsigned char* ws; int ph_lo, ph_hi; };
__global__ void __launch_bounds__(NWAVES * 64, 2) fwd_kernel(Args args) {
    extern __shared__ __attribute__((aligned(16))) unsigned char lds_raw[];
    LAS unsigned char* lds = (LAS unsigned char*)lds_raw;
    volatile LAS unsigned* MISC = (volatile LAS unsigned*)(lds + MISC_OFF);
    LAS int* TB = (LAS int*)(lds + TBL_OFF);
    const int tid0 = threadIdx.x, wave = __builtin_amdgcn_readfirstlane(tid0 >> 6);
    const int G = gridDim.x, bx = blockIdx.x;
    const int gw = bx * NWAVES + wave, NGW = G * NWAVES, NGT = G * NWAVES * 64;
    unsigned char* ws = args.ws;
    gu32* ctl = (gu32*)(ws + WS_CTL);
    const float* x_in = args.in[0]; const float* c_in = args.in[1]; const float* lbl = args.in[2];
    const float* const* L0 = args.in + 3; const float* const* L1 = args.in + 23; const float* fnorm = args.in[43];
    float* xo = args.out;
    float* TAB = (float*)(ws + WS_TAB); float* MOD = (float*)(ws + WS_MOD);
    bf16* WIN0 = (bf16*)(ws + WS_WIN0); bf16* WIN1 = (bf16*)(ws + WS_WIN1); bf16* WOUT0 = (bf16*)(ws + WS_WOUT0); bf16* WOUT1 = (bf16*)(ws + WS_WOUT1);
    bf16* ROUT0 = (bf16*)(ws + WS_ROUT0); bf16* ROUT1 = (bf16*)(ws + WS_ROUT1); bf16* GU = (bf16*)(ws + WS_GU); bf16* DN = (bf16*)(ws + WS_DN);
    bf16* H2A = (bf16*)(ws + WS_H2A); bf16* H2B = (bf16*)(ws + WS_H2B); bf16* PROJ = (bf16*)(ws + WS_PROJ); bf16* CAT = (bf16*)(ws + WS_CAT);
    float* OF = (float*)(ws + WS_OF); float* OB = (float*)(ws + WS_OB); bf16* QKC = (bf16*)(ws + WS_QKC);
    bf16* YB = (bf16*)(ws + WS_Y); bf16* HB = (bf16*)(ws + WS_HB); float* LOG = (float*)(ws + WS_LOG);
    int* TOPI = (int*)(ws + WS_TOPI); float* TOPW = (float*)(ws + WS_TOPW); int* RANK = (int*)(ws + WS_RANK); int* SLOT = (int*)(ws + WS_SLOT); int* LIST = (int*)(ws + WS_LIST);

    for (int u = tid0; u < (LDS_BYTES - LDSCTL_OFF) / 4; u += NWAVES * 64) ((LAS unsigned*)(lds + LDSCTL_OFF))[u] = 0u;
    __syncthreads();
    XcdBarrier bar = xcd_barrier_post((unsigned*)(ctl + CW_BAR), MISC + 8);
    const int lo = args.ph_lo, hi = args.ph_hi;
#define IN(k) (lo <= (k) && (k) < hi)
#define FRESH() int tid = wave * 64 + pg8::fresh_lane(); asm volatile("" : "+v"(tid)); const int lane = tid & 63; const int gtid = bx * (NWAVES * 64) + tid; (void)lane; (void)gtid
#define SEAM(k) do { if (IN(k) && IN((k) + 1)) xcd_barrier(bar); } while (0)
    LAS float* scr = (LAS float*)(lds + wave * 8448);

    if (IN(0)) { FRESH();
        if (bx < 192) mod_unit(bx, c_in, L0[2], L0[3], L1[2], L1[3], MOD, lds, tid, wave, lane);
        int jbase = 0;
        TR_JOB(L0[4], 4096, 1024, 0, 4096, WIN0, 0);
        TR_JOB(L1[4], 3600, 1024, 0, 2048, WIN1, 0);
        TR_JOB(L1[4], 3600, 1024, 2064, 1536, WIN1, 2048);
        TR_JOB(L1[4], 3600, 1024, 2048, 16, WIN1, 3584);
        TR_JOB(L0[5], 1024, 1024, 0, 1024, WOUT0, 0);
        TR_JOB(L1[5], 1024, 1024, 0, 1024, WOUT1, 0);
        TR_JOB(L0[12], 128, 1024, 0, 128, ROUT0, 0);
        TR_JOB(L1[12], 128, 1024, 0, 128, ROUT1, 0);
        { const v4u z = {0u, 0u, 0u, 0u};
          for (int i = gtid; i < 224 * 128; i += NGT) *(v4u*)(WIN1 + (size_t)3616 * 1024 + (size_t)i * 8) = z;
          for (int i = gtid; i < 128 * 128; i += NGT) { *(v4u*)(ROUT0 + (size_t)128 * 1024 + (size_t)i * 8) = z; *(v4u*)(ROUT1 + (size_t)128 * 1024 + (size_t)i * 8) = z; } }
        for (int t = gtid; t < NT_; t += NGT) {
            const float invf[8] = {1.0f, 0.1939227432f, 0.0376060307f, 0.00729266461f, 0.00141421356f, 0.000274248188f, 5.31829573e-05f, 1.03133852e-05f};
#pragma unroll
            for (int i = 0; i < 8; ++i) { const float ang = (float)t * invf[i]; double rev = (double)ang * 0.15915494309189535; rev -= floor(rev); const float rv = (float)rev;
                TAB[t * 16 + i] = __builtin_amdgcn_cosf(rv); TAB[t * 16 + 8 + i] = __builtin_amdgcn_sinf(rv); }
        }
    }
    SEAM(0);
    if (IN(1)) { FRESH(); normmod_phase(x_in, L0[0], MOD, 0, 1024, H2A, gw, NGW, lane); }
    SEAM(1);
    if (IN(2)) { FRESH(); pg8::DenseOrder S; S.init(NTOK, P0W, G, bx); EpiStoreBf16 E{PROJ, P0W};
        pg8::gemm_phase<EpiStoreBf16, pg8::DenseOrder, true>(lds, H2A, WIN0, DM, S, E, wave); }
    SEAM(2);
    if (IN(3)) { FRESH(); rope_phase(PROJ, TAB, gtid, NGT); }
    SEAM(3);
    if (IN(4)) { FRESH();
        if (bx < 64) sc::hgrn_unit(bx, PROJ, lbl, OF, OB, lds, tid);
        float lam;
        { float a = L0[7][lane] * L0[8][lane], b2 = L0[9][lane] * L0[10][lane]; a = wave_sum(a); b2 = wave_sum(b2); lam = __expf(a) - __expf(b2) + 0.2f; }
        for (;;) { const int u = q_pull(ctl + CW_Q0, MISC + 0, tid); if (u >= 1024) break; da::unit(u, PROJ, lam, L0[11], CAT, (LAS char*)lds, tid); }
        for (;;) { const int u = q_pull(ctl + CW_Q0 + 64, MISC + 1, tid); if (u >= 1032) break;
#pragma unroll 1
            for (int k = 0; k < 6; ++k) expert_item(L0[14], L0[15], L0[16], L0[17], L0[18], L0[19], GU, DN, u * 48 + wave * 6 + k, scr, lane); }
    }
    SEAM(4);
    if (IN(5)) { FRESH(); gateout_phase<0>(OF, OB, L0[6], PROJ, P0W, 2048, CAT, gw, NGW, lane); }
    SEAM(5);
    if (IN(6)) { FRESH(); pg8::DenseOrder S; S.init(NTOK, DM, G, bx); EpiResid E{x_in, xo, MOD + 2048};
        pg8::gemm_phase<EpiResid, pg8::DenseOrder, true>(lds, CAT, WOUT0, DM, S, E, wave); }
    SEAM(6);
    if (IN(7)) { FRESH(); normmod_phase(xo, L0[1], MOD, 3072, 4096, H2A, gw, NGW, lane); }
    SEAM(7);
    if (IN(8)) { FRESH(); pg8::DenseOrder S; S.init(NTOK, 256, G, bx); EpiF32 E{LOG, 256};
        pg8::gemm_phase<EpiF32, pg8::DenseOrder, true>(lds, H2A, ROUT0, DM, S, E, wave); }
    SEAM(8);
    if (IN(9)) { FRESH(); topk_phase(LOG, L0[13], TOPI, TOPW, RANK, (unsigned*)(ctl + CW_CNT0), gw, NGW, lane); }
    SEAM(9);
    if (IN(10)) { FRESH(); moe_tables((const unsigned*)(ctl + CW_CNT0), TB, tid); list_phase(TOPI, RANK, SLOT, LIST, TB, gtid, NGT); }
    SEAM(10);
    if (IN(11)) { FRESH(); moe_tables((const unsigned*)(ctl + CW_CNT0), TB, tid); GroupOrder S; S.init(TB, LIST, 2, G, bx); EpiGateUp E{HB};
        pg8::gemm_phase<EpiGateUp, GroupOrder, true>(lds, H2A, GU, DM, S, E, wave); }
    SEAM(11);
    if (IN(12)) { FRESH(); moe_tables((const unsigned*)(ctl + CW_CNT0), TB, tid); GroupOrder S; S.init(TB, nullptr, 4, G, bx); EpiDown E{YB};
        pg8::gemm_phase<EpiDown, GroupOrder, true>(lds, HB, DN, EFF, S, E, wave); }
    SEAM(12);
    if (IN(13)) { FRESH(); combine_phase(xo, YB, SLOT, TOPW, MOD, 5120, L1[0], MOD + 8 * 6144, 0, 1024, H2B, nullptr, gw, NGW, lane); }
    SEAM(13);
    if (IN(14)) { FRESH(); pg8::DenseOrder S; S.init(NTOK, P1W, G, bx); EpiStoreBf16 E{PROJ, P1W};
        pg8::gemm_phase<EpiStoreBf16, pg8::DenseOrder, true>(lds, H2B, WIN1, DM, S, E, wave); }
    SEAM(14);
    if (IN(15)) { FRESH(); convqk_phase(PROJ, L1[6], L1[7], QKC, gtid, NGT); }
    SEAM(15);
    if (IN(16)) { FRESH();
        if (bx < 64) sc::mlstm_unit(bx, PROJ, QKC, L1[8], L1[9], OF, OB, lds, tid);
        for (;;) { const int u = q_pull(ctl + CW_Q0 + 128, MISC + 2, tid); if (u >= 512) break; na_unit(u, PROJ, L1[11], CAT, tid); }
        for (;;) { const int u = q_pull(ctl + CW_Q0 + 192, MISC + 3, tid); if (u >= 1032) break;
#pragma unroll 1
            for (int k = 0; k < 6; ++k) expert_item(L1[14], L1[15], L1[16], L1[17], L1[18], L1[19], GU, DN, u * 48 + wave * 6 + k, scr, lane); }
    }
    SEAM(16);
    if (IN(17)) { FRESH(); gateout_phase<1>(OF, OB, L1[10], PROJ, P1W, 1536, CAT, gw, NGW, lane); }
    SEAM(17);
    if (IN(18)) { FRESH(); pg8::DenseOrder S; S.init(NTOK, DM, G, bx); EpiResid E{xo, xo, MOD + 8 * 6144 + 2048};
        pg8::gemm_phase<EpiResid, pg8::DenseOrder, true>(lds, CAT, WOUT1, DM, S, E, wave); }
    SEAM(18);
    if (IN(19)) { FRESH(); normmod_phase(xo, L1[1], MOD + 8 * 6144, 3072, 4096, H2A, gw, NGW, lane); }
    SEAM(19);
    if (IN(20)) { FRESH(); pg8::DenseOrder S; S.init(NTOK, 256, G, bx); EpiF32 E{LOG, 256};
        pg8::gemm_phase<EpiF32, pg8::DenseOrder, true>(lds, H2A, ROUT1, DM, S, E, wave); }
    SEAM(20);
    if (IN(21)) { FRESH(); topk_phase(LOG, L1[13], TOPI, TOPW, RANK, (unsigned*)(ctl + CW_CNT1), gw, NGW, lane); }
    SEAM(21);
    if (IN(22)) { FRESH(); moe_tables((const unsigned*)(ctl + CW_CNT1), TB, tid); list_phase(TOPI, RANK, SLOT, LIST, TB, gtid, NGT); }
    SEAM(22);
    if (IN(23)) { FRESH(); moe_tables((const unsigned*)(ctl + CW_CNT1), TB, tid); GroupOrder S; S.init(TB, LIST, 2, G, bx); EpiGateUp E{HB};
        pg8::gemm_phase<EpiGateUp, GroupOrder, true>(lds, H2A, GU, DM, S, E, wave); }
    SEAM(23);
    if (IN(24)) { FRESH(); moe_tables((const unsigned*)(ctl + CW_CNT1), TB, tid); GroupOrder S; S.init(TB, nullptr, 4, G, bx); EpiDown E{YB};
        pg8::gemm_phase<EpiDown, GroupOrder, true>(lds, HB, DN, EFF, S, E, wave); }
    SEAM(24);
    if (IN(25)) { FRESH(); combine_phase(xo, YB, SLOT, TOPW, MOD + 8 * 6144, 5120, nullptr, nullptr, 0, 0, nullptr, fnorm, gw, NGW, lane); }
    if (hi < N_PHASES && hi > 0 && IN(hi - 1)) { FRESH();
        xcd_barrier(bar);
        const float* src = (hi - 1 >= 6) ? (const float*)xo : x_in;
        for (int m = gw; m < NTOK; m += NGW) { const f32x4* xr = (const f32x4*)(src + (size_t)m * DM) + lane; f32x4 v[4];
#pragma unroll
            for (int j = 0; j < 4; ++j) v[j] = xr[64 * j];
            finalnorm_row(v, fnorm, xo + (size_t)m * DM, lane); }
    }
#undef IN
#undef SEAM
}

extern "C" void kernel_launch(void* const* d_in, const int* in_sizes, int n_in, void* d_out, int out_size, void* d_ws, size_t ws_size, hipStream_t stream) {
    static int grid = 0;
    if (grid == 0) {
        if (n_in != 44 || in_sizes[0] != NTOK * DM || out_size != NTOK * DM || ws_size < WS_END) {
            fprintf(stderr, "kernel_launch: shape mismatch: n_in %d in0 %d out %d ws %zu (need %zu)\n", n_in, n_in > 0 ? in_sizes[0] : -1, out_size, ws_size, (size_t)WS_END); grid = -1; return; }
        int dev = 0, cus = 0, per_cu = 0;
        if (hipGetDevice(&dev) != hipSuccess || hipDeviceGetAttribute(&cus, hipDeviceAttributeMultiprocessorCount, dev) != hipSuccess) { grid = -1; return; }
        if (hipFuncSetAttribute((const void*)fwd_kernel, hipFuncAttributeMaxDynamicSharedMemorySize, LDS_BYTES) != hipSuccess) { fprintf(stderr, "kernel_launch: hipFuncSetAttribute failed\n"); grid = -1; return; }
        if (hipOccupancyMaxActiveBlocksPerMultiprocessor(&per_cu, (const void*)fwd_kernel, NWAVES * 64, LDS_BYTES) != hipSuccess || per_cu < 1) { fprintf(stderr, "kernel_launch: occupancy query reports %d\n", per_cu); }
        (void)hipGetLastError();
        grid = cus;
    }
    if (grid < 0) return;
    if (hipMemsetAsync((char*)d_ws + WS_CTL, 0, CTL_ZERO_BYTES, stream) != hipSuccess) return;
    Args a{};
    for (int i = 0; i < 44; ++i) a.in[i] = (const float*)d_in[i];
    a.out = (float*)d_out; a.ws = (unsigned char*)d_ws; a.ph_lo = 0; a.ph_hi = STOP_AFTER + 1;
    hipLaunchKernelGGL(fwd_kernel, dim3(grid), dim3(NWAVES * 64), LDS_BYTES, stream, a);
    const hipError_t le = hipPeekAtLastError();
    if (le != hipSuccess) fprintf(stderr, "kernel_launch: launch failed: %s\n", hipGetErrorName(le));
}
```

```cpp
#include <hip/hip_runtime.h>
#include <cstdio>
#include <cstdint>

namespace pg8 {
#define PG8_LAS __attribute__((address_space(3)))
typedef unsigned short bf16_t;
typedef short bf16x8 __attribute__((ext_vector_type(8)));
typedef float f32x4 __attribute__((ext_vector_type(4)));
typedef unsigned u32x4 __attribute__((ext_vector_type(4)));
constexpr int BM = 256, BK = 64, HALF = 128, HTB = HALF * BK * 2  , STAGE_BYTES = 8 * HTB, NXCD = 8, WGM = 8;

__host__ __device__ __forceinline__ int lds_byte(int r, int c) { const int st = (r >> 4) * 2 + (c >> 5), rr = r & 15, cc = c & 31, ob = rr * 64 + cc * 2; return st * 1024 + (ob ^ (((ob >> 9) & 1) << 5)); }
__host__ __device__ __forceinline__ void stage_rc(int b, int& R, int& C) { const int st = b / 1024, sb = b % 1024, swz = sb ^ (((sb >> 9) & 1) << 5); R = (st >> 1) * 16 + swz / 64; C = (st & 1) * 32 + (swz % 64) / 2; }
__host__ __device__ __forceinline__ int perm32(int rho) { const int n = rho >> 4, i = rho & 15; return 8 * (i >> 2) + 4 * n + (i & 3); }

__device__ __forceinline__ int fresh_lane() { int l; asm volatile("v_mbcnt_lo_u32_b32 %0, -1, 0\n\tv_mbcnt_hi_u32_b32 %0, -1, %0" : "=v"(l)); return l; }

struct Unit { int pn, arow0, nvalid, bt; };

struct DenseOrder {
    int nM, nN, nwg, G, c;
    __device__ __forceinline__ void init(int M, int N, int G_, int c_) { nM = M / BM; nN = N / BM; nwg = nM * nN; G = G_; c = c_; }
    __device__ __forceinline__ bool next(int i, Unit& u) const {
        const long L = (long)i * G + c; if (L >= nwg) return false;
        int wgid = (int)L; { const int q = nwg / NXCD, r = nwg % NXCD, xcd = wgid % NXCD, off = wgid / NXCD; wgid = (xcd < r ? xcd * (q + 1) : r * (q + 1) + (xcd - r) * q) + off; }
        const int nig = WGM * nN, gid = wgid / nig, fm = gid * WGM, gsz = (nM - fm) < WGM ? (nM - fm) : WGM;
        const int pm = fm + ((wgid % nig) % gsz); u.pn = (wgid % nig) / gsz; u.arow0 = pm * BM; u.nvalid = BM; u.bt = u.pn; return true;
    }
    __device__ __forceinline__ int arow(const Unit& u, int r) const { return u.arow0 + r; }
};

__device__ __forceinline__ unsigned cvt_pk_bf16(float lo, float hi) { unsigned r; asm volatile("v_cvt_pk_bf16_f32 %0, %1, %2" : "=v"(r) : "v"(lo), "v"(hi)); return r; }

template <class Epi, class Sched, bool ALIGN_EPI>
__device__ __forceinline__ void gemm_phase(PG8_LAS unsigned char* lds, const bf16_t* A, const bf16_t* Bt, const int K, const Sched& S, const Epi& E, const int wid  ) {
    int tid = wid * 64 + pg8::fresh_lane(); asm volatile("" : "+v"(tid));
    const int lane = tid & 63, wr = wid >> 2, wc = wid & 3, fr = lane & 15, fq = lane >> 4;
    const int nt = K / BK;
    unsigned voffB[2];
#pragma unroll
    for (int i = 0; i < 2; ++i) { int R, C; stage_rc(tid * 16 + i * 8192, R, C); const int Rb = Epi::PERM ? ((R & ~31) + perm32(R & 31)) : R;
        voffB[i] = (unsigned)(Rb * K + C) * 2u; }
#define PG8_AOFF(U, o00, o01, o10, o11) do { int _t = wid * 64 + pg8::fresh_lane(); asm volatile("" : "+v"(_t)); int _R0, _C0, _R1, _C1; stage_rc(_t * 16, _R0, _C0); stage_rc(_t * 16 + 8192, _R1, _C1); \
        o00 = (unsigned)S.arow(U, _R0) * K2 + (unsigned)_C0 * 2u; o01 = (unsigned)S.arow(U, _R1) * K2 + (unsigned)_C1 * 2u; \
        o10 = (unsigned)S.arow(U, HALF + _R0) * K2 + (unsigned)_C0 * 2u; o11 = (unsigned)S.arow(U, HALF + _R1) * K2 + (unsigned)_C1 * 2u; } while (0)
    const unsigned K2 = (unsigned)K * 2u;
    const unsigned kstep = (unsigned)(BK * 2);
    const size_t hstep = (size_t)HALF * K * 2;
    const size_t tstep = 2 * hstep;
    const unsigned ldsw = (unsigned)wid * 1024u;
    const int aoff = lds_byte(wr * 64 + fr, fq * 8), boff = lds_byte(wc * 32 + fr, fq * 8);
    const char* Ab = (const char*)A; const char* Bb = (const char*)Bt;
#define PG8_SA(b, h) (((b) * 2 + (h)) * HTB)
#define PG8_SB(b, h) ((4 + (b) * 2 + (h)) * HTB)
#define PG8_STAGE_B(bufoff, gbase) do { _Pragma("unroll") for (int _i = 0; _i < 2; ++_i) \
        __builtin_amdgcn_global_load_lds((const unsigned*)((const char*)(gbase) + voffB[_i]), (PG8_LAS unsigned*)(lds + (bufoff) + ldsw + _i * 8192), 16, 0, 0); } while (0)
#define PG8_STAGE_A(bufoff, kbyte, o0, o1) do { \
        __builtin_amdgcn_global_load_lds((const unsigned*)(Ab + (size_t)((kbyte) + (o0))), (PG8_LAS unsigned*)(lds + (bufoff) + ldsw), 16, 0, 0); \
        __builtin_amdgcn_global_load_lds((const unsigned*)(Ab + (size_t)((kbyte) + (o1))), (PG8_LAS unsigned*)(lds + (bufoff) + ldsw + 8192), 16, 0, 0); } while (0)
#define PG8_LDA(dst, b, h) do { _Pragma("unroll") for (int m = 0; m < 4; ++m) _Pragma("unroll") for (int k = 0; k < 2; ++k) dst[m][k] = *(const PG8_LAS bf16x8*)(lds + PG8_SA(b, h) + aoff + m * 2048 + k * 1024); } while (0)
#define PG8_LDB(dst, b, h) do { _Pragma("unroll") for (int n = 0; n < 2; ++n) _Pragma("unroll") for (int k = 0; k < 2; ++k) dst[n][k] = *(const PG8_LAS bf16x8*)(lds + PG8_SB(b, h) + boff + n * 2048 + k * 1024); } while (0)
#define PG8_MMA(ai, bj, At, Bt_) do { __builtin_amdgcn_s_setprio(1); _Pragma("unroll") for (int m = 0; m < 4; ++m) _Pragma("unroll") for (int n = 0; n < 2; ++n) _Pragma("unroll") for (int k = 0; k < 2; ++k) \
        acc[ai][bj][m][n] = __builtin_amdgcn_mfma_f32_16x16x32_bf16(Bt_[n][k], At[m][k], acc[ai][bj][m][n], 0, 0, 0); __builtin_amdgcn_s_setprio(0); } while (0)
#define PG8_WAIT_V(n) asm volatile("s_waitcnt vmcnt(" #n ")" ::: "memory")
#define PG8_WAIT_L(n) asm volatile("s_waitcnt lgkmcnt(" #n ")" ::: "memory")
#define PG8_BAR __builtin_amdgcn_s_barrier()
#define PG8_SCHED __builtin_amdgcn_sched_barrier(0)
    Unit cur, nxt; int ui = 0;
    if (!S.next(0, cur)) return;
    f32x4 acc[2][2][4][2];
#pragma unroll
    for (int a = 0; a < 2; ++a)
#pragma unroll
        for (int b = 0; b < 2; ++b)
#pragma unroll
            for (int m = 0; m < 4; ++m)
#pragma unroll
                for (int n = 0; n < 2; ++n) acc[a][b][m][n] = (f32x4){0.f, 0.f, 0.f, 0.f};
    bf16x8 At[4][2], B0[2][2], B1[2][2];
    unsigned c00, c01, c10, c11, n00, n01, n10, n11;
    PG8_AOFF(cur, c00, c01, c10, c11);
    const char* cB = Bb + (size_t)cur.bt * tstep;
    PG8_STAGE_B(PG8_SB(0, 0), cB); PG8_STAGE_B(PG8_SB(0, 1), cB + hstep); PG8_STAGE_A(PG8_SA(0, 0), 0u, c00, c01); PG8_STAGE_A(PG8_SA(0, 1), 0u, c10, c11);
    if (wr == 1) PG8_BAR;
    PG8_WAIT_V(2); PG8_BAR;
    PG8_STAGE_B(PG8_SB(1, 0), cB + kstep); PG8_STAGE_A(PG8_SA(1, 0), kstep, c00, c01); PG8_STAGE_B(PG8_SB(1, 1), cB + hstep + kstep);
    PG8_WAIT_V(6); PG8_BAR;
    for (;;) {
        const bool has_next = S.next(ui + 1, nxt);
        if (has_next) { PG8_AOFF(nxt, n00, n01, n10, n11); } else { n00 = c00; n01 = c01; n10 = c10; n11 = c11; }
        const char* nB = has_next ? Bb + (size_t)nxt.bt * tstep : cB;
        for (int t = 0; t < nt; t += 2) {
            const bool last = (t == nt - 2);
            const unsigned kb1 = (unsigned)(t + 1) * kstep;
            const unsigned kb2 = last ? 0u : (unsigned)(t + 2) * kstep, kb3 = kb2 + kstep;
            const unsigned a00 = last ? n00 : c00, a01 = last ? n01 : c01, a10 = last ? n10 : c10, a11 = last ? n11 : c11;
            const char* b2 = last ? nB : cB + (size_t)(t + 2) * kstep; const char* b3 = b2 + kstep;
            PG8_LDB(B0, 0, 0); PG8_LDB(B1, 0, 1); PG8_SCHED; PG8_LDA(At, 0, 0); PG8_STAGE_A(PG8_SA(1, 1), kb1, c10, c11);
            PG8_WAIT_V(8); PG8_WAIT_L(0); PG8_BAR; PG8_MMA(0, 0, At, B0); PG8_MMA(0, 1, At, B1); PG8_BAR; PG8_SCHED;
            PG8_LDA(At, 0, 1); PG8_STAGE_B(PG8_SB(0, 0), b2); PG8_STAGE_B(PG8_SB(0, 1), b2 + hstep); PG8_STAGE_A(PG8_SA(0, 0), kb2, a00, a01);
            PG8_WAIT_V(8); PG8_WAIT_L(0); PG8_BAR; PG8_MMA(1, 0, At, B0); PG8_MMA(1, 1, At, B1); PG8_BAR; PG8_SCHED;
            PG8_LDB(B0, 1, 0); PG8_LDB(B1, 1, 1); PG8_SCHED; PG8_LDA(At, 1, 0); PG8_STAGE_A(PG8_SA(0, 1), kb2, a10, a11);
            PG8_WAIT_V(8); PG8_WAIT_L(0); PG8_BAR; PG8_MMA(0, 0, At, B0); PG8_MMA(0, 1, At, B1); PG8_BAR; PG8_SCHED;
            PG8_LDA(At, 1, 1); PG8_STAGE_B(PG8_SB(1, 0), b3); PG8_STAGE_B(PG8_SB(1, 1), b3 + hstep); PG8_STAGE_A(PG8_SA(1, 0), kb3, a00, a01);
            PG8_WAIT_V(8); PG8_WAIT_L(0); PG8_BAR; PG8_MMA(1, 0, At, B0); PG8_MMA(1, 1, At, B1); PG8_BAR; PG8_SCHED;
        }
        if constexpr (ALIGN_EPI) { if (wr == 0) PG8_BAR; }
        E(acc, cur, wr, wc, fr, fq);
        if (!has_next) break;
#pragma unroll
        for (int a = 0; a < 2; ++a)
#pragma unroll
            for (int b = 0; b < 2; ++b)
#pragma unroll
                for (int m = 0; m < 4; ++m)
#pragma unroll
                    for (int n = 0; n < 2; ++n) acc[a][b][m][n] = (f32x4){0.f, 0.f, 0.f, 0.f};
        cur = nxt; cB = nB; c00 = n00; c01 = n01; c10 = n10; c11 = n11; ++ui;
        if constexpr (ALIGN_EPI) { if (wr == 1) PG8_BAR; }
    }
    PG8_WAIT_V(0);
    if constexpr (!ALIGN_EPI) { if (wr == 0) PG8_BAR; }
    PG8_BAR;
#undef PG8_AOFF
#undef PG8_SA
#undef PG8_SB
#undef PG8_STAGE_A
#undef PG8_STAGE_B
#undef PG8_LDA
#undef PG8_LDB
#undef PG8_MMA
#undef PG8_WAIT_V
#undef PG8_WAIT_L
#undef PG8_BAR
#undef PG8_SCHED
}
}
#ifndef DUPMASK
#define DUPMASK 0u
#endif
#define NREP(k) (((DUPMASK >> (k)) & 1u) ? 2 : 1)
constexpr int NB = 8, NT_ = 4096, DM = 1024, NTOK = NB * NT_;
constexpr int GW = 512;
constexpr int P0W = 4096, P1W = 3840;
constexpr int NEXP = 128, EFF = 256, NSLOT = NTOK * 8, NSLOT_ALL = NSLOT + NTOK;
constexpr float EPS = 1e-6f;
constexpr int NWAVES = 8;

constexpr size_t MiB = 1u << 20;
constexpr size_t WS_CTL = 0, CTL_ZERO_BYTES = 1 * MiB;
constexpr size_t WS_TAB = 1 * MiB;
constexpr size_t WS_MOD = WS_TAB + 256 * 1024;
constexpr size_t WS_WIN0 = 2 * MiB, WS_WIN1 = 10 * MiB, WS_WOUT0 = 18 * MiB, WS_WOUT1 = 20 * MiB, WS_ROUT0 = 22 * MiB, WS_ROUT1 = 23 * MiB;
constexpr size_t WS_GU = 24 * MiB;
constexpr size_t WS_DN = 153 * MiB;
constexpr size_t WS_H2A = 218 * MiB;
constexpr size_t WS_PROJ = 282 * MiB;
constexpr size_t WS_CAT = 538 * MiB;
constexpr size_t WS_OF = 602 * MiB, WS_OB = 666 * MiB;
constexpr size_t WS_QKC = 730 * MiB;
constexpr size_t WS_Y = 218 * MiB;
constexpr size_t WS_HB = 794 * MiB;
constexpr size_t WS_H2B = 794 * MiB;
constexpr size_t WS_LOG = 938 * MiB;
constexpr size_t WS_TOPI = 970 * MiB, WS_TOPW = 971 * MiB, WS_RANK = 972 * MiB, WS_SLOT = 973 * MiB, WS_LIST = 974 * MiB;
constexpr size_t WS_END = 976 * MiB;
constexpr int CW_TMO = 0, CW_BAR = 16384  , CW_Q0 = 8192  , CW_CNT0 = 9216  , CW_CNT1 = 9472;

constexpr int RING_BYTES = 131072;
constexpr int LDSCTL_OFF = RING_BYTES, MISC_OFF = LDSCTL_OFF + 320;
constexpr int LDS_BYTES = 147456;
constexpr int TBL_OFF = MISC_OFF + 128;

#define GAS __attribute__((address_space(1)))
#define LAS __attribute__((address_space(3)))
typedef unsigned short bf16;
typedef unsigned v4u __attribute__((ext_vector_type(4)));
typedef float f32x4 __attribute__((ext_vector_type(4)));
typedef short bf16x8 __attribute__((ext_vector_type(8)));
typedef GAS unsigned gu32;
typedef GAS unsigned long long gu64;
#define RLX_AGENT __ATOMIC_RELAXED, __HIP_MEMORY_SCOPE_AGENT
#define LDS_WAIT() asm volatile("s_waitcnt lgkmcnt(0)" ::: "memory")
#define VM_WAIT() asm volatile("s_waitcnt vmcnt(0)" ::: "memory")
__device__ __forceinline__ unsigned long long rt() { return __builtin_amdgcn_s_memrealtime(); }
__device__ __forceinline__ unsigned f2bf(float f) { unsigned u = __builtin_bit_cast(unsigned, f); return (u + 0x7fffu + ((u >> 16) & 1u)) >> 16; }
__device__ __forceinline__ unsigned pk2(float lo, float hi) { return f2bf(lo) | (f2bf(hi) << 16); }
#define XB_TMO      128
#define XB_XCNT(j)  (256  + 64 * (j))
#define XB_XSUB(j)  (1280 + 64 * (j))
#define XB_XGEN(j)  (2304 + 64 * (j))
#define XB_TOP      3328
#define XB_TOPGEN   3392
#define XCD_BAR_WORDS 3456
#define XB_SPIN_CAP (1u << 18)

__device__ __forceinline__ unsigned xb_ld(unsigned* p)              { return __hip_atomic_load(p, __ATOMIC_RELAXED, __HIP_MEMORY_SCOPE_AGENT); }
__device__ __forceinline__ unsigned xb_add(unsigned* p, unsigned v) { return __hip_atomic_fetch_add(p, v, __ATOMIC_RELAXED, __HIP_MEMORY_SCOPE_AGENT); }
__device__ __forceinline__ unsigned xb_xcc_id() { return (unsigned)__builtin_amdgcn_s_getreg((3 << 11) | 20) & 0xFu; }
#define XB_SPIN(cond, bar) do { unsigned _sp = 0; while (cond) { __builtin_amdgcn_s_sleep(1); \
    if ((++_sp & 255u) == 0u) { if (xb_ld(&(bar)[XB_TMO])) break; if (_sp > XB_SPIN_CAP) { atomicAdd(&(bar)[XB_TMO], 1u); break; } } } } while (0)

struct XcdBarrier {
    unsigned* bar; unsigned x;
    volatile LAS unsigned* st;
};

__device__ __forceinline__ XcdBarrier xcd_barrier_post(unsigned* bar, volatile LAS unsigned* st) {
    XcdBarrier b; b.bar = bar; b.x = xb_xcc_id(); b.st = st;
    if (threadIdx.x == 0) (void)xb_add(&bar[XB_XCNT(b.x)], 1u);
    return b;
}
__device__ __forceinline__ void xcd_barrier_complete(unsigned* bar, unsigned x, unsigned& nloc, unsigned& nx) {
    const unsigned G = gridDim.x * gridDim.y * gridDim.z;
    unsigned sum, cnt, mine, sp = 0u;
    for (;;) {
        sum = 0u; cnt = 0u; mine = 0u;
#pragma unroll
        for (unsigned j = 0; j < 16; ++j) { const unsigned c = xb_ld(&bar[XB_XCNT(j)]); sum += c; cnt += (c > 0u) ? 1u : 0u; mine = (j == x) ? c : mine; }
        if (sum == G) break;
        __builtin_amdgcn_s_sleep(1);
        if ((++sp & 255u) == 0u) { if (xb_ld(&bar[XB_TMO])) break; if (sp > XB_SPIN_CAP) { atomicAdd(&bar[XB_TMO], 1u); break; } }
    }
    nloc = mine > 0u ? mine : 1u; nx = cnt > 0u ? cnt : 1u;
}

__device__ __forceinline__ void xcd_barrier(const XcdBarrier& b) {
    asm volatile("s_waitcnt vmcnt(0)" ::: "memory");
    __syncthreads();
    if (threadIdx.x == 0) {
        unsigned* bar = b.bar;
        __builtin_amdgcn_s_waitcnt(0);
        unsigned nloc = b.st[0], nx = b.st[1];
        if (nloc == 0u) { xcd_barrier_complete(bar, b.x, nloc, nx); b.st[0] = nloc; b.st[1] = nx; }
        const unsigned old = xb_add(&bar[XB_XSUB(b.x)], 1u);
        const unsigned gen = old / nloc;
        if (old + 1u == (gen + 1u) * nloc) {
            __builtin_amdgcn_fence(__ATOMIC_RELEASE, "agent");
            asm volatile("s_waitcnt vmcnt(0)" ::: "memory");
            const unsigned og = xb_add(&bar[XB_TOP], 1u);
            const unsigned tg = og / nx;
            if (og + 1u == (tg + 1u) * nx) xb_add(&bar[XB_TOPGEN], 1u);
            else XB_SPIN(xb_ld(&bar[XB_TOPGEN]) == tg, bar);
            __builtin_amdgcn_fence(__ATOMIC_ACQUIRE, "agent");
            xb_add(&bar[XB_XGEN(b.x)], 1u);
            asm volatile("s_waitcnt vmcnt(0)" ::: "memory");
        } else {
            XB_SPIN(xb_ld(&bar[XB_XGEN(b.x)]) == gen, bar);
            __builtin_amdgcn_fence(__ATOMIC_ACQUIRE, "agent");
            asm volatile("s_waitcnt vmcnt(0)" ::: "memory");
        }
    }
    __syncthreads();
}
typedef float f32x2 __attribute__((ext_vector_type(2)));
typedef unsigned u32x2 __attribute__((ext_vector_type(2)));
__device__ __forceinline__ float bflo(unsigned w) { return __builtin_bit_cast(float, w << 16); }
__device__ __forceinline__ float bfhi(unsigned w) { return __builtin_bit_cast(float, w & 0xffff0000u); }
__device__ __forceinline__ float bf2f(bf16 b) { return __builtin_bit_cast(float, (unsigned)b << 16); }
__device__ __forceinline__ float wave_sum(float v) {
#pragma unroll
    for (int o = 1; o < 64; o <<= 1) v += __shfl_xor(v, o);
    return v;
}
__device__ __forceinline__ float sigm(float x) { return __builtin_amdgcn_rcpf(1.f + __expf(-x)); }
__device__ __forceinline__ float sigm_div(float x) { return 1.f / (1.f + __expf(-x)); }
__device__ __forceinline__ float silu(float x) { return x * __builtin_amdgcn_rcpf(1.f + __expf(-x)); }
__device__ __forceinline__ void unpack8(v4u w, float (&f)[8]) { f[0] = bflo(w.x); f[1] = bfhi(w.x); f[2] = bflo(w.y); f[3] = bfhi(w.y); f[4] = bflo(w.z); f[5] = bfhi(w.z); f[6] = bflo(w.w); f[7] = bfhi(w.w); }
__device__ __forceinline__ v4u pack8(const float (&f)[8]) { v4u w; w.x = pk2(f[0], f[1]); w.y = pk2(f[2], f[3]); w.z = pk2(f[4], f[5]); w.w = pk2(f[6], f[7]); return w; }

__device__ __forceinline__ void tr_item(const float* W, int ldw, int k0, int c0, int cvalid, bf16* WT, int ldt, int r0, LAS float* scr, int lane) {
    float wv[32];
#pragma unroll
    for (int i = 0; i < 32; ++i) { const int kk = 2 * i + (lane >> 5), n = lane & 31; wv[i] = (n < cvalid) ? W[(size_t)(k0 + kk) * ldw + c0 + n] : 0.f; }
#pragma unroll
    for (int i = 0; i < 32; ++i) { const int kk = 2 * i + (lane >> 5), n = lane & 31; scr[kk * 33 + n] = wv[i]; }
    LDS_WAIT(); asm volatile("" ::: "memory");
    const int c = lane & 7;
#pragma unroll
    for (int j = 0; j < 4; ++j) { const int n = (lane >> 3) + 8 * j; const LAS float* s = scr + (8 * c) * 33 + n;
        v4u o; o.x = pk2(s[0 * 33], s[1 * 33]); o.y = pk2(s[2 * 33], s[3 * 33]); o.z = pk2(s[4 * 33], s[5 * 33]); o.w = pk2(s[6 * 33], s[7 * 33]);
        *(v4u*)(WT + (size_t)(r0 + n) * ldt + k0 + 8 * c) = o; }
    LDS_WAIT(); asm volatile("" ::: "memory");
}
__device__ __forceinline__ void expert_item(const float* gate, const float* up, const float* down, const float* sgate, const float* sup, const float* sdown,
                                            bf16* GU, bf16* DN, int it, LAS float* scr, int lane) {
    const int e = it / 384, r = it - e * 384;
    const bool sh = (e == NEXP);
    if (r < 256) {
        const bool isup = r >= 128; const int rr = r & 127, sub = rr >> 6, q = rr & 63, kb = q >> 2, nb = q & 3;
        const float* W = sh ? (isup ? sup : sgate) : ((isup ? up : gate) + (size_t)e * (DM * EFF));
        tr_item(W, EFF, kb * 64, sub * 128 + nb * 32, 32, GU + (size_t)e * (512 * DM), DM, 256 * sub + (isup ? 128 : 0) + nb * 32, scr, lane);
    } else {
        const int rr = r - 256, kb = rr >> 5, nb = rr & 31;
        const float* W = sh ? sdown : down + (size_t)e * (EFF * DM);
        tr_item(W, DM, kb * 64, nb * 32, 32, DN + (size_t)e * (DM * EFF), EFF, nb * 32, scr, lane);
    }
}
#define TR_JOB(W_, ldw_, K_, c0_, ncols_, WT_, r0_) do { const int _nb = ((ncols_) + 31) / 32, _ni = ((K_) / 64) * _nb; \
        for (int _it = (gw + NGW - (jbase % NGW)) % NGW; _it < _ni; _it += NGW) { const int _kb = _it / _nb, _nk = _it % _nb; const int _cv = (ncols_) - _nk * 32; \
            tr_item(W_, ldw_, _kb * 64, (c0_) + _nk * 32, _cv < 32 ? _cv : 32, WT_, K_, (r0_) + _nk * 32, scr, lane); } jbase += _ni; } while (0)

__device__ __forceinline__ void mod_unit(int u, const float* c, const float* wm0, const float* bm0, const float* wm1, const float* bm1, float* MOD, LAS unsigned char* lds, int tid, int wave, int lane) {
    LAS float* sc = (LAS float*)(lds + 69632);
    LAS float* red = (LAS float*)(lds + 69632 + 32768);
    const int l = u / 96, cb = u % 96; const float* wm = l ? wm1 : wm0; const float* bm = l ? bm1 : bm0;
    for (int i = tid; i < NB * DM; i += 512) sc[i] = silu(c[i]);
    __syncthreads();
    float acc[8];
#pragma unroll
    for (int b = 0; b < 8; ++b) acc[b] = 0.f;
    const float* wp = wm + (size_t)(wave * 128) * 6144 + cb * 64 + lane;
    for (int k0 = 0; k0 < 128; k0 += 8) {
        float w[8];
#pragma unroll
        for (int j = 0; j < 8; ++j) w[j] = wp[(size_t)(k0 + j) * 6144];
#pragma unroll
        for (int j = 0; j < 8; ++j)
#pragma unroll
            for (int b = 0; b < 8; ++b) acc[b] += sc[b * DM + wave * 128 + k0 + j] * w[j];
    }
#pragma unroll
    for (int b = 0; b < 8; ++b) red[(wave * 8 + b) * 64 + lane] = acc[b];
    __syncthreads();
    { const int b = tid >> 6; float s = 0.f;
#pragma unroll
      for (int w = 0; w < 8; ++w) s += red[(w * 8 + b) * 64 + lane];
      MOD[(size_t)(l * 8 + b) * 6144 + cb * 64 + lane] = s + bm[cb * 64 + lane]; }
    __syncthreads();
}

__device__ __forceinline__ void normmod_row(const f32x4 (&v)[4], const float* gain, const float* shift, const float* scale, bf16* orow, int lane) {
    float ss = 0.f;
#pragma unroll
    for (int j = 0; j < 4; ++j) ss += (v[j].x * v[j].x + v[j].y * v[j].y) + (v[j].z * v[j].z + v[j].w * v[j].w);
    const float r = 1.f / sqrtf(wave_sum(ss) * (1.f / DM) + EPS);
    unsigned long long* o8 = (unsigned long long*)orow + lane;
#pragma unroll
    for (int j = 0; j < 4; ++j) { const f32x4 g = ((const f32x4*)gain)[lane + 64 * j], sh = ((const f32x4*)shift)[lane + 64 * j], sc = ((const f32x4*)scale)[lane + 64 * j];
        const f32x4 y = v[j] * r * g * (sc + 1.f) + sh;
        o8[64 * j] = (unsigned long long)pk2(y.x, y.y) | ((unsigned long long)pk2(y.z, y.w) << 32); }
}
__device__ __forceinline__ void normmod_phase(const float* X, const float* gain, const float* modl  , int sh_off, int sc_off, bf16* H, int gw, int NGW, int lane) {
    for (int m = gw; m < NTOK; m += NGW) {
        const f32x4* xr = (const f32x4*)(X + (size_t)m * DM) + lane; f32x4 v[4];
#pragma unroll
        for (int j = 0; j < 4; ++j) v[j] = xr[64 * j];
        const float* mb = modl + (size_t)(m >> 12) * 6144;
        normmod_row(v, gain, mb + sh_off, mb + sc_off, H + (size_t)m * DM, lane);
    }
}
__device__ __forceinline__ void finalnorm_row(const f32x4 (&v)[4], const float* gain, float* orow, int lane) {
    float ss = 0.f;
#pragma unroll
    for (int j = 0; j < 4; ++j) ss += (v[j].x * v[j].x + v[j].y * v[j].y) + (v[j].z * v[j].z + v[j].w * v[j].w);
    const float r = 1.f / sqrtf(wave_sum(ss) * (1.f / DM) + EPS);
#pragma unroll
    for (int j = 0; j < 4; ++j) ((f32x4*)orow)[lane + 64 * j] = v[j] * r * ((const f32x4*)gain)[lane + 64 * j];
}

__device__ __forceinline__ void rope_phase(bf16* P, const float* tab, int gtid, int NGT) {
    for (int idx = gtid; idx < NTOK * 16; idx += NGT) {
        const int tok = idx >> 4, grp = idx & 15, t = tok & (NT_ - 1);
        bf16* p = P + (size_t)tok * P0W + (grp < 8 ? 2560 : 3072) + (grp & 7) * 64;
        const v4u a = *(const v4u*)p, b = *(const v4u*)(p + 8);
        float x1[8], x2[8], cs[8], sn[8], y1[8], y2[8];
        unpack8(a, x1); unpack8(b, x2);
        const f32x4* tp = (const f32x4*)(tab + (size_t)t * 16);
        const f32x4 c0 = tp[0], c1 = tp[1], s0 = tp[2], s1 = tp[3];
        cs[0] = c0.x; cs[1] = c0.y; cs[2] = c0.z; cs[3] = c0.w; cs[4] = c1.x; cs[5] = c1.y; cs[6] = c1.z; cs[7] = c1.w;
        sn[0] = s0.x; sn[1] = s0.y; sn[2] = s0.z; sn[3] = s0.w; sn[4] = s1.x; sn[5] = s1.y; sn[6] = s1.z; sn[7] = s1.w;
#pragma unroll
        for (int i = 0; i < 8; ++i) { y1[i] = x1[i] * cs[i] - x2[i] * sn[i]; y2[i] = x2[i] * cs[i] + x1[i] * sn[i]; }
        *(v4u*)p = pack8(y1); *(v4u*)(p + 8) = pack8(y2);
    }
}

template <int ACT  >
__device__ __forceinline__ void gateout_phase(const float* OF, const float* OB, const float* gain, const bf16* P, int pitch, int gcol, bf16* CAT, int gw, int NGW, int lane) {
    const int hh = lane >> 4, e0 = (lane & 15) * 8;
    const f32x4 g0 = *(const f32x4*)(gain + e0), g1 = *(const f32x4*)(gain + e0 + 4);
    for (int m = gw; m < NTOK; m += NGW) {
        const float* pf = OF + (size_t)m * GW + hh * 128 + e0; const float* pb = OB + (size_t)m * GW + hh * 128 + e0;
        const f32x4 a0 = *(const f32x4*)pf + *(const f32x4*)pb, a1 = *(const f32x4*)(pf + 4) + *(const f32x4*)(pb + 4);
        float ss = (a0.x * a0.x + a0.y * a0.y) + (a0.z * a0.z + a0.w * a0.w) + (a1.x * a1.x + a1.y * a1.y) + (a1.z * a1.z + a1.w * a1.w);
        ss += __shfl_xor(ss, 1); ss += __shfl_xor(ss, 2); ss += __shfl_xor(ss, 4); ss += __shfl_xor(ss, 8);
        const float r = 1.f / sqrtf(ss * (1.f / 128.f) + EPS);
        float gv[8]; unpack8(*(const v4u*)(P + (size_t)m * pitch + gcol + hh * 128 + e0), gv);
        float y[8];
        const f32x4 n0 = a0 * r * g0, n1 = a1 * r * g1;
        y[0] = n0.x; y[1] = n0.y; y[2] = n0.z; y[3] = n0.w; y[4] = n1.x; y[5] = n1.y; y[6] = n1.z; y[7] = n1.w;
#pragma unroll
        for (int i = 0; i < 8; ++i) y[i] *= (ACT == 0) ? silu(gv[i]) : sigm(gv[i]);
        *(v4u*)(CAT + (size_t)m * DM + hh * 128 + e0) = pack8(y);
    }
}

struct EpiStoreBf16 {
    static constexpr bool PERM = true;
    bf16* O; int ldc;
    __device__ __forceinline__ void operator()(const pg8::f32x4 (&acc)[2][2][4][2], const pg8::Unit& u, int wr, int wc, int fr, int fq) const {
        const int row0 = u.arow0 + wr * 64 + fr, col0 = u.pn * 256 + wc * 32 + 8 * fq;
#pragma unroll
        for (int ai = 0; ai < 2; ++ai)
#pragma unroll
            for (int m = 0; m < 4; ++m) { bf16* rowp = O + (size_t)(row0 + ai * 128 + m * 16) * ldc + col0;
#pragma unroll
                for (int bj = 0; bj < 2; ++bj) { const pg8::f32x4 v0 = acc[ai][bj][m][0], v1 = acc[ai][bj][m][1];
                    v4u w; w.x = pg8::cvt_pk_bf16(v0[0], v0[1]); w.y = pg8::cvt_pk_bf16(v0[2], v0[3]); w.z = pg8::cvt_pk_bf16(v1[0], v1[1]); w.w = pg8::cvt_pk_bf16(v1[2], v1[3]);
                    *(v4u*)(rowp + bj * 128) = w; } }
    }
};
struct EpiResid {
    static constexpr bool PERM = false;
    const float* xin; float* out; const float* gm;
    __device__ __forceinline__ void operator()(const pg8::f32x4 (&acc)[2][2][4][2], const pg8::Unit& u, int wr, int wc, int fr, int fq) const {
        const int row0 = u.arow0 + wr * 64 + fr, col0 = u.pn * 256 + wc * 32 + 4 * fq;
#pragma unroll
        for (int ai = 0; ai < 2; ++ai)
#pragma unroll
            for (int m = 0; m < 4; ++m) { const int row = row0 + ai * 128 + m * 16; const float* gp = gm + (size_t)(row >> 12) * 6144 + col0; const size_t ro = (size_t)row * DM + col0;
#pragma unroll
                for (int bj = 0; bj < 2; ++bj)
#pragma unroll
                    for (int n = 0; n < 2; ++n) { const int c = bj * 128 + n * 16;
                        const pg8::f32x4 x4 = *(const pg8::f32x4*)(xin + ro + c), g4 = *(const pg8::f32x4*)(gp + c);
                        *(pg8::f32x4*)(out + ro + c) = x4 + g4 * acc[ai][bj][m][n]; } }
    }
};
struct EpiF32 {
    static constexpr bool PERM = false;
    float* C; int ldc;
    __device__ __forceinline__ void operator()(const pg8::f32x4 (&acc)[2][2][4][2], const pg8::Unit& u, int wr, int wc, int fr, int fq) const {
        const int row0 = u.arow0 + wr * 64 + fr, col0 = u.pn * 256 + wc * 32 + 4 * fq;
#pragma unroll
        for (int ai = 0; ai < 2; ++ai)
#pragma unroll
            for (int m = 0; m < 4; ++m) { float* rowp = C + (size_t)(row0 + ai * 128 + m * 16) * ldc + col0;
#pragma unroll
                for (int bj = 0; bj < 2; ++bj)
#pragma unroll
                    for (int n = 0; n < 2; ++n) *(pg8::f32x4*)(rowp + bj * 128 + n * 16) = acc[ai][bj][m][n]; }
    }
};
struct EpiGateUp {
    static constexpr bool PERM = true;
    bf16* HB;
    __device__ __forceinline__ void operator()(const pg8::f32x4 (&acc)[2][2][4][2], const pg8::Unit& u, int wr, int wc, int fr, int fq) const {
        const int col0 = u.pn * 128 + wc * 32 + 8 * fq;
#pragma unroll
        for (int ai = 0; ai < 2; ++ai)
#pragma unroll
            for (int m = 0; m < 4; ++m) { const int rl = ai * 128 + wr * 64 + m * 16 + fr;
                float y[8];
#pragma unroll
                for (int n = 0; n < 2; ++n)
#pragma unroll
                    for (int j = 0; j < 4; ++j) y[4 * n + j] = silu(acc[ai][0][m][n][j]) * acc[ai][1][m][n][j];
                if (rl < u.nvalid) *(v4u*)(HB + (size_t)(u.arow0 + rl) * EFF + col0) = pack8(y); }
    }
};
struct EpiDown {
    static constexpr bool PERM = true;
    bf16* Y;
    __device__ __forceinline__ void operator()(const pg8::f32x4 (&acc)[2][2][4][2], const pg8::Unit& u, int wr, int wc, int fr, int fq) const {
        const int col0 = u.pn * 256 + wc * 32 + 8 * fq;
#pragma unroll
        for (int ai = 0; ai < 2; ++ai)
#pragma unroll
            for (int m = 0; m < 4; ++m) { const int rl = ai * 128 + wr * 64 + m * 16 + fr; bf16* rowp = Y + (size_t)(u.arow0 + rl) * DM + col0;
#pragma unroll
                for (int bj = 0; bj < 2; ++bj) { const pg8::f32x4 v0 = acc[ai][bj][m][0], v1 = acc[ai][bj][m][1];
                    v4u w; w.x = pg8::cvt_pk_bf16(v0[0], v0[1]); w.y = pg8::cvt_pk_bf16(v0[2], v0[3]); w.z = pg8::cvt_pk_bf16(v1[0], v1[1]); w.w = pg8::cvt_pk_bf16(v1[2], v1[3]);
                    if (rl < u.nvalid) *(v4u*)(rowp + bj * 128) = w; } }
    }
};

__device__ __forceinline__ void moe_tables(const unsigned* cntg, LAS int* tb, int tid) {
    LAS int* cnt = tb; LAS int* start = tb + 130; LAS int* tpre = tb + 260;
    __syncthreads();
    if (tid < NEXP) cnt[tid] = (int)__hip_atomic_load(cntg + tid, __ATOMIC_RELAXED, __HIP_MEMORY_SCOPE_AGENT);
    if (tid == NEXP) cnt[NEXP] = NTOK;
    __syncthreads();
    if (tid == 0) { int s = 0, t = 0; for (int e = 0; e < NEXP; ++e) { start[e] = s; tpre[e] = t; s += cnt[e]; t += (cnt[e] + 255) >> 8; }
        start[NEXP] = NSLOT; tpre[NEXP] = t; t += NTOK / 256; start[NEXP + 1] = NSLOT_ALL; tpre[NEXP + 1] = t; }
    __syncthreads();
}
struct GroupOrder {
    const LAS int* cnt; const LAS int* start; const LAS int* tpre; const int* list; int ntc, total, G, c;
    __device__ __forceinline__ void init(const LAS int* tb, const int* list_, int ntc_, int G_, int c_) { cnt = tb; start = tb + 130; tpre = tb + 260; list = list_; ntc = ntc_; total = tpre[NEXP + 1] * ntc_; G = G_; c = c_; }
    __device__ __forceinline__ bool next(int i, pg8::Unit& u) const {
        const int L = i * G + c; if (L >= total) return false;
        const int rt = L / ntc, pn = L - rt * ntc;
        int lo = 0, hi = NEXP + 1;
#pragma unroll 1
        while (hi - lo > 1) { const int mid = (lo + hi) >> 1; if (tpre[mid] <= rt) lo = mid; else hi = mid; }
        const int j = rt - tpre[lo], rem = cnt[lo] - 256 * j;
        u.pn = pn; u.arow0 = start[lo] + 256 * j; u.nvalid = rem < 256 ? rem : 256; u.bt = lo * ntc + pn; return true;
    }
    __device__ __forceinline__ int arow(const pg8::Unit& u, int r) const { const int idx = u.arow0 + (r < u.nvalid ? r : u.nvalid - 1); return list ? list[idx] : idx; }
};

__device__ __forceinline__ void topk_phase(const float* LOG, const float* rbias, int* TOPI, float* TOPW, int* RANK, unsigned* cntg, LAS unsigned char* lds, int bx, int G, int wave, int tid) {
    const int lane = tid & 63;
    LAS unsigned* hist = (LAS unsigned*)lds; LAS unsigned* base = hist + 128; LAS unsigned short* le = (LAS unsigned short*)(lds + 1024); LAS unsigned short* lr = le + 1024;
    const f32x2 bias = *(const f32x2*)(rbias + 2 * lane);
    for (int blk = bx; blk < NTOK / 128; blk += G) {
        __syncthreads();
        if (tid < 128) hist[tid] = 0u;
        __syncthreads();
#pragma unroll 1
        for (int ti = 0; ti < 16; ++ti) {
            const int tl = wave * 16 + ti, tok = blk * 128 + tl;
            const f32x2 lg = *(const f32x2*)(LOG + (size_t)tok * 256 + 2 * lane);
            const float s0 = sigm_div(lg.x), s1 = sigm_div(lg.y);
            float v0 = s0 + bias.x, v1 = s1 + bias.y;
            float m1 = fmaxf(v0, v1), m2 = fminf(v0, v1);
#pragma unroll
            for (int off = 1; off < 8; off <<= 1) { const float o1 = __shfl_xor(m1, off), o2 = __shfl_xor(m2, off); const float n1 = fmaxf(m1, o1), n2 = fmaxf(fminf(m1, o1), fmaxf(m2, o2)); m1 = n1; m2 = n2; }
            const float gs = m1 + m2; const int myg = lane >> 3; int better = 0;
#pragma unroll
            for (int g = 0; g < 8; ++g) { const float sg = __shfl(gs, g * 8); better += (sg > gs || (sg == gs && g < myg)) ? 1 : 0; }
            if (better >= 4) { v0 = -INFINITY; v1 = -INFINITY; }
            int my_e = 0; float my_s = 0.f, ssum = 0.f;
#pragma unroll
            for (int k = 0; k < 8; ++k) {
                float bv = (v0 >= v1) ? v0 : v1; int bi = (v0 >= v1) ? 2 * lane : 2 * lane + 1;
#pragma unroll
                for (int off = 32; off >= 1; off >>= 1) { const float ov = __shfl_xor(bv, off); const int oi = __shfl_xor(bi, off); if (ov > bv || (ov == bv && oi < bi)) { bv = ov; bi = oi; } }
                const float ws = __shfl((bi & 1) ? s1 : s0, bi >> 1);
                if (lane == (bi >> 1)) { if (bi & 1) v1 = -INFINITY; else v0 = -INFINITY; }
                if (lane == k) { my_e = bi; my_s = ws; }
                ssum += ws;
            }
            if (lane < 8) {
                const unsigned rk = __hip_atomic_fetch_add(hist + my_e, 1u, __ATOMIC_RELAXED, __HIP_MEMORY_SCOPE_WORKGROUP);
                TOPI[tok * 8 + lane] = my_e; TOPW[tok * 8 + lane] = my_s / ssum * 2.5f; le[tl * 8 + lane] = (unsigned short)my_e; lr[tl * 8 + lane] = (unsigned short)rk;
            }
        }
        __syncthreads();
        if (tid < 128) base[tid] = __hip_atomic_fetch_add(cntg + tid, hist[tid], __ATOMIC_RELAXED, __HIP_MEMORY_SCOPE_AGENT);
        __syncthreads();
        for (int i = tid; i < 1024; i += 512) RANK[blk * 1024 + i] = (int)(base[le[i]] + lr[i]);
    }
}
__device__ __forceinline__ void list_phase(const int* TOPI, const int* RANK, int* SLOT, int* LIST, const LAS int* tb, int gtid, int NGT) {
    const LAS int* start = tb + 130;
    for (int p = gtid; p < NSLOT; p += NGT) { const int s = start[TOPI[p]] + RANK[p]; SLOT[p] = s; LIST[s] = p >> 3; }
    for (int i = gtid; i < NTOK; i += NGT) LIST[NSLOT + i] = i;
}
__device__ __forceinline__ void combine_phase(float* X, const bf16* Y, const int* SLOT, const float* TOPW, const float* modl, int g_off,
                                              const float* ngain, const float* modn, int sh_off, int sc_off, bf16* H, const float* fgain, int gw, int NGW, int lane) {
    for (int m0 = gw; m0 < NTOK; m0 += 2 * NGW) {
        const int mm[2] = {m0, m0 + NGW}; const bool has2 = (m0 + NGW) < NTOK;
        int sl[2]; float wl[2];
#pragma unroll
        for (int q = 0; q < 2; ++q) { const int m = (q == 0 || has2) ? mm[q] : m0; sl[q] = (lane < 8) ? SLOT[m * 8 + lane] : NSLOT + m; wl[q] = (lane < 8) ? TOPW[m * 8 + lane] : 1.f; }
        f32x4 acc[2][4]; f32x4 xv[2][4];
#pragma unroll
        for (int q = 0; q < 2; ++q) { const int m = (q == 0 || has2) ? mm[q] : m0; const f32x4* xr = (const f32x4*)(X + (size_t)m * DM) + lane;
#pragma unroll
            for (int j = 0; j < 4; ++j) { acc[q][j] = (f32x4){0.f, 0.f, 0.f, 0.f}; xv[q][j] = xr[64 * j]; } }
#pragma unroll
        for (int k = 0; k < 9; ++k)
#pragma unroll
            for (int q = 0; q < 2; ++q) { const int s = __shfl(sl[q], k); const float w = __shfl(wl[q], k);
                const u32x2* yr = (const u32x2*)(Y + (size_t)s * DM) + lane;
#pragma unroll
                for (int j = 0; j < 4; ++j) { const u32x2 qv = yr[64 * j]; acc[q][j] += (f32x4){bflo(qv.x), bfhi(qv.x), bflo(qv.y), bfhi(qv.y)} * w; } }
#pragma unroll
        for (int q = 0; q < 2; ++q) { if (q == 1 && !has2) break; const int m = mm[q];
            f32x4* xr = (f32x4*)(X + (size_t)m * DM) + lane; const float* mb = modl + (size_t)(m >> 12) * 6144; f32x4 v[4];
#pragma unroll
            for (int j = 0; j < 4; ++j) v[j] = xv[q][j] + ((const f32x4*)(mb + g_off))[lane + 64 * j] * acc[q][j];
            if (fgain) finalnorm_row(v, fgain, X + (size_t)m * DM, lane);
            else {
#pragma unroll
                for (int j = 0; j < 4; ++j) xr[64 * j] = v[j];
                const float* mn = modn + (size_t)(m >> 12) * 6144;
                normmod_row(v, ngain, mn + sh_off, mn + sc_off, H + (size_t)m * DM, lane);
            } }
    }
}
__device__ __forceinline__ int q_pull(gu32* head, volatile LAS unsigned* slot, int tid) {
    __syncthreads();
    if (tid == 0) *slot = __hip_atomic_fetch_add(head, 1u, RLX_AGENT);
    __syncthreads();
    return (int)*slot;
}

__device__ __forceinline__ void convqk_phase(const bf16* P, const float* cw, const float* cb, bf16* QKC, int gtid, int NGT) {
    for (int idx = gtid; idx < NTOK * 128; idx += NGT) {
        const int tok = idx >> 7, c0 = (idx & 127) * 8, t = tok & (NT_ - 1);
        float acc[8];
#pragma unroll
        for (int i = 0; i < 8; ++i) acc[i] = cb[c0 + i];
#pragma unroll
        for (int j = 0; j < 5; ++j) { const int tj = t + j - 2;
            if (tj >= 0 && tj < NT_) { float x[8]; unpack8(*(const v4u*)(P + (size_t)(tok + j - 2) * P1W + c0), x);
#pragma unroll
                for (int i = 0; i < 8; ++i) acc[i] += cw[j * 1024 + c0 + i] * x[i]; } }
        const float sc = (c0 >= GW) ? 0.08838834764831845f : 1.f;
#pragma unroll
        for (int i = 0; i < 8; ++i) acc[i] = silu(acc[i]) * sc;
        *(v4u*)(QKC + (size_t)tok * DM + c0) = pack8(acc);
    }
}
namespace da {
using bf16x8 = __attribute__((ext_vector_type(8))) short;
using s16x4  = __attribute__((ext_vector_type(4))) short;
using f32x16 = __attribute__((ext_vector_type(16))) float;
constexpr float SCALE = 0.125f;
constexpr float THR = 8.f;
constexpr int KVBLK = 64, SHM_V = 16384, SHM_K = 16384;
#define DA_KSWZ(row, colB) ((row) * 256 + ((colB) ^ (((row) & 7) << 4)))
#define DA_SBAR() __builtin_amdgcn_sched_barrier(0)
__device__ __forceinline__ int crow(int r, int hi) { return (r & 3) + 8 * (r >> 2) + 4 * hi; }
__device__ __forceinline__ unsigned cvtpk(float lo, float hi) { unsigned r; asm volatile("v_cvt_pk_bf16_f32 %0, %1, %2" : "=v"(r) : "v"(lo), "v"(hi)); return r; }
__device__ __forceinline__ void partialSM(f32x16& p0, f32x16& p1, float& m_reg, float& mn, float& alpha) {
  constexpr float C = SCALE * 1.4426950408889634f;
  float pmax = p0[0];
#pragma unroll
  for (int r = 1; r < 16; ++r) pmax = fmaxf(pmax, p0[r]);
#pragma unroll
  for (int r = 0; r < 16; ++r) pmax = fmaxf(pmax, p1[r]);
  { auto rr = __builtin_amdgcn_permlane32_swap(__float_as_uint(pmax), __float_as_uint(pmax), false, false);
    pmax = fmaxf(__uint_as_float(rr[0]), __uint_as_float(rr[1])); }
  if (__builtin_expect(__all(pmax - m_reg <= THR / SCALE), 1)) { mn = m_reg; alpha = 1.f; }
  else { mn = fmaxf(m_reg, pmax); alpha = __builtin_amdgcn_exp2f((m_reg - mn) * C); m_reg = mn; }
  float mnC = -mn * C;
#pragma unroll
  for (int r = 0; r < 16; ++r) p0[r] = fmaf(p0[r], C, mnC);
#pragma unroll
  for (int r = 0; r < 16; ++r) p1[r] = fmaf(p1[r], C, mnC);
#pragma unroll
  for (int r = 0; r < 16; ++r) p0[r] = __builtin_amdgcn_exp2f(p0[r]);
}
__device__ __forceinline__ void finishSM(f32x16& p0, f32x16& p1, float alpha, float& l_reg, bf16x8& pa0, bf16x8& pa1, bf16x8& pa2, bf16x8& pa3) {
#pragma unroll
  for (int r = 0; r < 16; ++r) p1[r] = __builtin_amdgcn_exp2f(p1[r]);
  float ps = 0;
#pragma unroll
  for (int r = 0; r < 16; ++r) ps += p0[r];
#pragma unroll
  for (int r = 0; r < 16; ++r) ps += p1[r];
  { auto rr = __builtin_amdgcn_permlane32_swap(__float_as_uint(ps), __float_as_uint(ps), false, false);
    ps = __uint_as_float(rr[0]) + __uint_as_float(rr[1]); }
  l_reg = l_reg * alpha + ps;
#define DA_PK4(P, BASE, OUT) do { unsigned a0 = cvtpk(P[BASE + 0], P[BASE + 1]), a1 = cvtpk(P[BASE + 2], P[BASE + 3]);   \
    unsigned b0 = cvtpk(P[BASE + 4], P[BASE + 5]), b1 = cvtpk(P[BASE + 6], P[BASE + 7]);                              \
    auto r0 = __builtin_amdgcn_permlane32_swap(a0, b0, false, false); auto r1 = __builtin_amdgcn_permlane32_swap(a1, b1, false, false); \
    v4u w = {r0[0], r1[0], r0[1], r1[1]}; OUT = __builtin_bit_cast(bf16x8, w); } while (0)
  DA_PK4(p0, 0, pa0); DA_PK4(p0, 8, pa1); DA_PK4(p1, 0, pa2); DA_PK4(p1, 8, pa3);
#undef DA_PK4
}
__device__ __forceinline__ void qkt(f32x16& p0, f32x16& p1, const LAS char* Ks, const bf16x8 (&qr)[4], int r32, int hi, int mapB) {
  p0 = f32x16{}; p1 = f32x16{};
#pragma unroll
  for (int d0 = 0; d0 < 4; ++d0) { const int cb = mapB + (d0 * 16 + hi * 8) * 2;
    const bf16x8 b0 = *(const LAS bf16x8*)(Ks + DA_KSWZ(r32, cb));
    const bf16x8 b1 = *(const LAS bf16x8*)(Ks + DA_KSWZ(32 + r32, cb));
    p0 = __builtin_amdgcn_mfma_f32_32x32x16_bf16(b0, qr[d0], p0, 0, 0, 0);
    p1 = __builtin_amdgcn_mfma_f32_32x32x16_bf16(b1, qr[d0], p1, 0, 0, 0); }
}
__device__ __forceinline__ int v_st(int k, int c) { const int kk = (k & ~0xC) | ((k & 4) << 1) | ((k & 8) >> 1); return ((kk >> 3) * 4 + (c >> 5)) * 512 + ((kk & 7) * 32 + (c & 31)) * 2; }
__device__ __forceinline__ int v_rd_base(int lane) { return ((lane & 3) << 3) | (((lane >> 2) & 3) << 6) | (((lane >> 4) & 1) << 5) | (((lane >> 5) & 1) << 8); }
constexpr int v_rd_off(int d0, int ks, int half) { return d0 * 512 + ks * 4096 + half * 2048; }
template <int OFF> __device__ __forceinline__ s16x4 tr_read(int vb) {
  s16x4 r; asm volatile("ds_read_b64_tr_b16 %0, %1 offset:%2" : "=&v"(r) : "v"(vb), "i"(OFF) : "memory"); return r;
}
template <int D0> __device__ __forceinline__ void pv_one(f32x16& od, int vb, bf16x8 pa0, bf16x8 pa1, bf16x8 pa2, bf16x8 pa3) {
  const s16x4 l0 = tr_read<v_rd_off(D0, 0, 0)>(vb), h0 = tr_read<v_rd_off(D0, 0, 1)>(vb), l1 = tr_read<v_rd_off(D0, 1, 0)>(vb), h1 = tr_read<v_rd_off(D0, 1, 1)>(vb);
  const s16x4 l2 = tr_read<v_rd_off(D0, 2, 0)>(vb), h2 = tr_read<v_rd_off(D0, 2, 1)>(vb), l3 = tr_read<v_rd_off(D0, 3, 0)>(vb), h3 = tr_read<v_rd_off(D0, 3, 1)>(vb);
  asm volatile("s_waitcnt lgkmcnt(0)" ::: "memory"); DA_SBAR();
#define DA_PK(L, H) (bf16x8){L[0], L[1], L[2], L[3], H[0], H[1], H[2], H[3]}
  od = __builtin_amdgcn_mfma_f32_32x32x16_bf16(pa0, DA_PK(l0, h0), od, 0, 0, 0);
  od = __builtin_amdgcn_mfma_f32_32x32x16_bf16(pa1, DA_PK(l1, h1), od, 0, 0, 0);
  od = __builtin_amdgcn_mfma_f32_32x32x16_bf16(pa2, DA_PK(l2, h2), od, 0, 0, 0);
  od = __builtin_amdgcn_mfma_f32_32x32x16_bf16(pa3, DA_PK(l3, h3), od, 0, 0, 0);
#undef DA_PK
}
__device__ __forceinline__ void pv_d0(f32x16 (&o)[4], int vb, bf16x8 pa0, bf16x8 pa1, bf16x8 pa2, bf16x8 pa3) {
  pv_one<0>(o[0], vb, pa0, pa1, pa2, pa3); pv_one<1>(o[1], vb, pa0, pa1, pa2, pa3); pv_one<2>(o[2], vb, pa0, pa1, pa2, pa3); pv_one<3>(o[3], vb, pa0, pa1, pa2, pa3);
}
__device__ __forceinline__ void unit(int u, const bf16* P, float lam, const float* subln, bf16* CAT, LAS char* lds, int tid) {
  const int qb = u & 31, h = (u >> 5) & 3, b = u >> 7;
  const int wid = tid >> 6, lane = tid & 63, r32 = lane & 31, hi = lane >> 5, mp = wid >> 2, wq = wid & 3;
  LAS char* V_lds = lds; LAS char* K_lds = lds + 2 * SHM_V;
  LAS float* ws = (LAS float*)(lds + 2 * SHM_V + 2 * SHM_K) + wid * 64; LAS float* li_l = ws; LAS float* al_l = ws + 32;
  float m_reg = -1e30f, l_reg = 0; f32x16 o[4] = {}; bf16x8 qr[4];
  const size_t rowbase = (size_t)b * NT_;
  const bf16* Qw = P + (rowbase + qb * 128 + wq * 32 + r32) * P0W + 2560 + h * 128 + mp * 64 + hi * 8;
#pragma unroll
  for (int d0 = 0; d0 < 4; ++d0) qr[d0] = *(const bf16x8*)(Qw + d0 * 16);
  const bf16* Kh = P + rowbase * P0W + 3072 + h * 128; const bf16* Vh = P + rowbase * P0W + 3584 + h * 128;
  const int mapB = mp * 128;
  const int sr = tid >> 4, sc = (tid & 15) * 8, vst0 = v_st(sr, sc), vst1 = v_st(32 + sr, sc);
  const int vb0 = (int)(uintptr_t)V_lds + v_rd_base(lane);
  struct { bf16x8 vs0, vs1, ks0, ks1; } sr_[2];
#define DA_SLOAD(i, k0) do { sr_[i].vs0 = *(const bf16x8*)(&Vh[(size_t)((k0) + sr) * P0W + sc]); sr_[i].vs1 = *(const bf16x8*)(&Vh[(size_t)((k0) + 32 + sr) * P0W + sc]); \
    sr_[i].ks0 = *(const bf16x8*)(&Kh[(size_t)((k0) + sr) * P0W + sc]); sr_[i].ks1 = *(const bf16x8*)(&Kh[(size_t)((k0) + 32 + sr) * P0W + sc]); } while (0)
#define DA_SWRITE(bb, i) do { *(LAS bf16x8*)(V_lds + (bb) * SHM_V + vst0) = sr_[i].vs0;          \
    *(LAS bf16x8*)(V_lds + (bb) * SHM_V + vst1) = sr_[i].vs1; const int kc = sc * 2;               \
    *(LAS bf16x8*)(K_lds + (bb) * SHM_K + DA_KSWZ(sr, kc)) = sr_[i].ks0;                       \
    *(LAS bf16x8*)(K_lds + (bb) * SHM_K + DA_KSWZ(32 + sr, kc)) = sr_[i].ks1; } while (0)
#define DA_SWAIT() asm volatile("s_waitcnt vmcnt(4)" ::: "memory")
#define DA_RESC(a) do { if (__any((a) < 1.f)) { if (hi == 0) al_l[r32] = (a); asm volatile("s_waitcnt lgkmcnt(0)" ::: "memory"); \
    _Pragma("unroll") for (int d = 0; d < 4; ++d) _Pragma("unroll") for (int r = 0; r < 16; ++r) o[d][r] *= al_l[crow(r, hi)]; } } while (0)
  f32x16 pA0, pA1, pB0, pB1; float mnA, mnB, alA, alB; bf16x8 pa0, pa1, pa2, pa3; constexpr int NT = NT_ / KVBLK;
  DA_SLOAD(0, 0); asm volatile("s_waitcnt vmcnt(0)" ::: "memory"); DA_SWRITE(0, 0); __syncthreads();
  qkt(pA0, pA1, K_lds, qr, r32, hi, mapB); partialSM(pA0, pA1, m_reg, mnA, alA);
  DA_SLOAD(1, KVBLK); DA_SLOAD(0, 2 * KVBLK);
  DA_SWAIT(); DA_SWRITE(1, 1); __syncthreads();
  for (int j = 1; j + 1 < NT; j += 2) {
    DA_SBAR(); qkt(pB0, pB1, K_lds + SHM_K, qr, r32, hi, mapB);
    finishSM(pA0, pA1, alA, l_reg, pa0, pa1, pa2, pa3); DA_SBAR();
    DA_SLOAD(1, (j + 2) * KVBLK); DA_SBAR();
    pv_d0(o, vb0, pa0, pa1, pa2, pa3); partialSM(pB0, pB1, m_reg, mnB, alB);
    __syncthreads(); DA_SWAIT(); DA_SWRITE(0, 0);
    DA_RESC(alB); __syncthreads();
    DA_SBAR(); qkt(pA0, pA1, K_lds, qr, r32, hi, mapB);
    finishSM(pB0, pB1, alB, l_reg, pa0, pa1, pa2, pa3); DA_SBAR();
    if (j + 3 < NT) DA_SLOAD(0, (j + 3) * KVBLK); DA_SBAR();
    pv_d0(o, vb0 + SHM_V, pa0, pa1, pa2, pa3); partialSM(pA0, pA1, m_reg, mnA, alA);
    __syncthreads(); DA_SWAIT(); DA_SWRITE(1, 1);
    DA_RESC(alA); __syncthreads();
  }
  DA_SBAR(); qkt(pB0, pB1, K_lds + SHM_K, qr, r32, hi, mapB);
  finishSM(pA0, pA1, alA, l_reg, pa0, pa1, pa2, pa3); DA_SBAR();
  pv_d0(o, vb0, pa0, pa1, pa2, pa3); partialSM(pB0, pB1, m_reg, mnB, alB);
  __syncthreads(); DA_RESC(alB);
  finishSM(pB0, pB1, alB, l_reg, pa0, pa1, pa2, pa3); DA_SBAR();
  pv_d0(o, vb0 + SHM_V, pa0, pa1, pa2, pa3);
  if (hi == 0) li_l[r32] = l_reg; asm volatile("s_waitcnt lgkmcnt(0)" ::: "memory");
  float rli[16];
#pragma unroll
  for (int r = 0; r < 16; ++r) rli[r] = __builtin_amdgcn_rcpf(li_l[crow(r, hi)]);
  __syncthreads();
  LAS float* X = (LAS float*)lds;
  if (mp == 1) {
#pragma unroll
    for (int d0 = 0; d0 < 4; ++d0)
#pragma unroll
      for (int r = 0; r < 16; ++r) X[(wq * 32 + crow(r, hi)) * 128 + d0 * 32 + r32] = o[d0][r] * rli[r];
  }
  __syncthreads();
  if (mp == 0) {
#pragma unroll
    for (int d0 = 0; d0 < 4; ++d0)
#pragma unroll
      for (int r = 0; r < 16; ++r) { const int ix = (wq * 32 + crow(r, hi)) * 128 + d0 * 32 + r32; X[ix] = o[d0][r] * rli[r] - lam * X[ix]; }
  }
  __syncthreads();
  { const int row = tid >> 2, qtr = tid & 3; const LAS f32x4* xp = (const LAS f32x4*)(X + row * 128 + qtr * 32); f32x4 xv[8]; float ss = 0.f;
#pragma unroll
    for (int i = 0; i < 8; ++i) { xv[i] = xp[i]; ss += (xv[i].x * xv[i].x + xv[i].y * xv[i].y) + (xv[i].z * xv[i].z + xv[i].w * xv[i].w); }
    ss += __shfl_xor(ss, 1); ss += __shfl_xor(ss, 2);
    const float rr = 0.8f / sqrtf(ss * (1.f / 128.f) + EPS);
    bf16* op = CAT + (rowbase + qb * 128 + row) * DM + GW + h * 128 + qtr * 32;
#pragma unroll
    for (int i = 0; i < 4; ++i) { const f32x4 g0 = *(const f32x4*)(subln + qtr * 32 + i * 8), g1 = *(const f32x4*)(subln + qtr * 32 + i * 8 + 4);
      const f32x4 y0 = xv[2 * i] * rr * g0, y1 = xv[2 * i + 1] * rr * g1;
      v4u w; w.x = pk2(y0.x, y0.y); w.y = pk2(y0.z, y0.w); w.z = pk2(y1.x, y1.y); w.w = pk2(y1.z, y1.w);
      *(v4u*)(op + i * 8) = w; } }
  __syncthreads();
#undef DA_SLOAD
#undef DA_SWRITE
#undef DA_SWAIT
#undef DA_RESC
}
}
namespace na {
using da::bf16x8; using da::s16x4; using da::f32x16;
__device__ __forceinline__ int v_st2(int k, int c) { const int kk = (k & ~0xC) | ((k & 4) << 1) | ((k & 8) >> 1); return ((kk >> 3) * 2 + (c >> 5)) * 512 + ((kk & 7) * 32 + (c & 31)) * 2; }
constexpr int v_rd_off2(int d0, int ks, int half) { return d0 * 512 + ks * 2048 + half * 1024; }
template <int D0> __device__ __forceinline__ void pv_one2(f32x16& od, int vb, bf16x8 pa0, bf16x8 pa1, bf16x8 pa2, bf16x8 pa3) {
  const s16x4 l0 = da::tr_read<v_rd_off2(D0, 0, 0)>(vb), h0 = da::tr_read<v_rd_off2(D0, 0, 1)>(vb), l1 = da::tr_read<v_rd_off2(D0, 1, 0)>(vb), h1 = da::tr_read<v_rd_off2(D0, 1, 1)>(vb);
  const s16x4 l2 = da::tr_read<v_rd_off2(D0, 2, 0)>(vb), h2 = da::tr_read<v_rd_off2(D0, 2, 1)>(vb), l3 = da::tr_read<v_rd_off2(D0, 3, 0)>(vb), h3 = da::tr_read<v_rd_off2(D0, 3, 1)>(vb);
  asm volatile("s_waitcnt lgkmcnt(0)" ::: "memory"); DA_SBAR();
#define NA_PK(L, H) (bf16x8){L[0], L[1], L[2], L[3], H[0], H[1], H[2], H[3]}
  od = __builtin_amdgcn_mfma_f32_32x32x16_bf16(pa0, NA_PK(l0, h0), od, 0, 0, 0);
  od = __builtin_amdgcn_mfma_f32_32x32x16_bf16(pa1, NA_PK(l1, h1), od, 0, 0, 0);
  od = __builtin_amdgcn_mfma_f32_32x32x16_bf16(pa2, NA_PK(l2, h2), od, 0, 0, 0);
  od = __builtin_amdgcn_mfma_f32_32x32x16_bf16(pa3, NA_PK(l3, h3), od, 0, 0, 0);
#undef NA_PK
}
__device__ __forceinline__ void qtile(const bf16x8 (&kf)[2][4], const bf16x8 (&qr)[4], int col, const LAS float* brow, float& m_reg, float& l_reg, f32x16& o0, f32x16& o1,
                                      LAS float* al_l, int vb, int r32, int hi) {
  constexpr float C = 0.125f * 1.4426950408889634f, L2E = 1.4426950408889634f;
  f32x16 p0 = {}, p1 = {};
#pragma unroll
  for (int d0 = 0; d0 < 4; ++d0) { p0 = __builtin_amdgcn_mfma_f32_32x32x16_bf16(kf[0][d0], qr[d0], p0, 0, 0, 0); p1 = __builtin_amdgcn_mfma_f32_32x32x16_bf16(kf[1][d0], qr[d0], p1, 0, 0, 0); }
  int cs = col - 8; cs = cs < 0 ? 0 : (cs > 48 ? 48 : cs);
  float pmax = -INFINITY;
  const LAS float* ab = brow + (15 - col + 4 * hi); const int kofs = 4 * hi - cs;
#pragma unroll
  for (int r = 0; r < 16; ++r) { const int kr = (r & 3) + 8 * (r >> 2);
      const float s = fmaf(p0[r], C, ab[kr] * L2E); p0[r] = ((unsigned)(kr + kofs) < 16u) ? s : -INFINITY; pmax = fmaxf(pmax, p0[r]); }
#pragma unroll
  for (int r = 0; r < 16; ++r) { const int kr = 32 + (r & 3) + 8 * (r >> 2);
      const float s = fmaf(p1[r], C, ab[kr] * L2E); p1[r] = ((unsigned)(kr + kofs) < 16u) ? s : -INFINITY; pmax = fmaxf(pmax, p1[r]); }
  { auto rr = __builtin_amdgcn_permlane32_swap(__float_as_uint(pmax), __float_as_uint(pmax), false, false); pmax = fmaxf(__uint_as_float(rr[0]), __uint_as_float(rr[1])); }
  const float mn = fmaxf(m_reg, pmax), alpha = __builtin_amdgcn_exp2f(m_reg - mn); m_reg = mn;
  float ps = 0.f;
#pragma unroll
  for (int r = 0; r < 16; ++r) { p0[r] = __builtin_amdgcn_exp2f(p0[r] - mn); ps += p0[r]; }
#pragma unroll
  for (int r = 0; r < 16; ++r) { p1[r] = __builtin_amdgcn_exp2f(p1[r] - mn); ps += p1[r]; }
  { auto rr = __builtin_amdgcn_permlane32_swap(__float_as_uint(ps), __float_as_uint(ps), false, false); ps = __uint_as_float(rr[0]) + __uint_as_float(rr[1]); }
  l_reg = l_reg * alpha + ps;
  if (hi == 0) al_l[r32] = alpha; asm volatile("s_waitcnt lgkmcnt(0)" ::: "memory");
#pragma unroll
  for (int r = 0; r < 16; ++r) { const float a = al_l[da::crow(r, hi)]; o0[r] *= a; o1[r] *= a; }
  bf16x8 pa0, pa1, pa2, pa3;
#define NA_PK4(Pv, BASE, OUT) do { unsigned a0 = da::cvtpk(Pv[BASE + 0], Pv[BASE + 1]), a1 = da::cvtpk(Pv[BASE + 2], Pv[BASE + 3]);   \
    unsigned b0 = da::cvtpk(Pv[BASE + 4], Pv[BASE + 5]), b1 = da::cvtpk(Pv[BASE + 6], Pv[BASE + 7]);                              \
    auto r0 = __builtin_amdgcn_permlane32_swap(a0, b0, false, false); auto r1 = __builtin_amdgcn_permlane32_swap(a1, b1, false, false); \
    v4u w = {r0[0], r1[0], r0[1], r1[1]}; OUT = __builtin_bit_cast(bf16x8, w); } while (0)
  NA_PK4(p0, 0, pa0); NA_PK4(p0, 8, pa1); NA_PK4(p1, 0, pa2); NA_PK4(p1, 8, pa3);
#undef NA_PK4
  pv_one2<0>(o0, vb, pa0, pa1, pa2, pa3); pv_one2<1>(o1, vb, pa0, pa1, pa2, pa3);
}
__device__ __forceinline__ void item(int it, const bf16* P, const LAS float* BT, bf16* CAT, LAS char* vl, int lane) {
  const int head = it & 7, r = (it >> 3) & 63, b = it >> 9, r32 = lane & 31, hi = lane >> 5;
  const int tok0 = b * NT_ + r * 64; int rs = r - 4; rs = rs < 0 ? 0 : (rs > 56 ? 56 : rs);
  LAS float* li_l = (LAS float*)(vl + 8192); LAS float* al_l = li_l + 32;
  const int vb = (int)(uintptr_t)vl + da::v_rd_base(lane);
  bf16x8 q0[4], q1[4];
  { const bf16* qp = P + (size_t)(tok0 + r32) * P1W + 2048 + head * 64 + hi * 8;
#pragma unroll
    for (int d0 = 0; d0 < 4; ++d0) { q0[d0] = *(const bf16x8*)(qp + d0 * 16); q1[d0] = *(const bf16x8*)(qp + (size_t)32 * P1W + d0 * 16); } }
  f32x16 o00 = {}, o01 = {}, o10 = {}, o11 = {}; float m0 = -1e30f, m1 = -1e30f, l0 = 0.f, l1 = 0.f;
#pragma unroll 1
  for (int i = 0; i < 8; ++i) {
    const int krow0 = b * NT_ + (rs + i) * 64;
    bf16x8 kf[2][4], vv[8];
    { const bf16* kp = P + (size_t)(krow0 + r32) * P1W + 2560 + head * 64 + hi * 8;
#pragma unroll
      for (int d0 = 0; d0 < 4; ++d0) { kf[0][d0] = *(const bf16x8*)(kp + d0 * 16); kf[1][d0] = *(const bf16x8*)(kp + (size_t)32 * P1W + d0 * 16); }
      const bf16* vp = P + (size_t)(krow0 + lane) * P1W + 3072 + head * 64;
#pragma unroll
      for (int c8 = 0; c8 < 8; ++c8) vv[c8] = *(const bf16x8*)(vp + c8 * 8); }
#pragma unroll
    for (int c8 = 0; c8 < 8; ++c8) *(LAS bf16x8*)(vl + v_st2(lane, c8 * 8)) = vv[c8];
    asm volatile("s_waitcnt lgkmcnt(0)" ::: "memory");
    const LAS float* brow = BT + head * 465 + (rs + i - r + 7) * 31;
    int r32i = r32; asm volatile("" : "+v"(r32i));
    qtile(kf, q0, r32i, brow, m0, l0, o00, o01, al_l, vb, r32, hi);
    qtile(kf, q1, 32 + r32i, brow, m1, l1, o10, o11, al_l, vb, r32, hi);
  }
  bf16* op = CAT + (size_t)tok0 * DM + GW + head * 64 + r32;
  if (hi == 0) li_l[r32] = l0; asm volatile("s_waitcnt lgkmcnt(0)" ::: "memory");
#pragma unroll
  for (int rr = 0; rr < 16; ++rr) { const int qrow = da::crow(rr, hi); const float il = __builtin_amdgcn_rcpf(li_l[qrow]);
      op[(size_t)qrow * DM] = (bf16)f2bf(o00[rr] * il); op[(size_t)qrow * DM + 32] = (bf16)f2bf(o01[rr] * il); }
  asm volatile("s_waitcnt lgkmcnt(0)" ::: "memory");
  if (hi == 0) li_l[r32] = l1; asm volatile("s_waitcnt lgkmcnt(0)" ::: "memory");
#pragma unroll
  for (int rr = 0; rr < 16; ++rr) { const int qrow = 32 + da::crow(rr, hi); const float il = __builtin_amdgcn_rcpf(li_l[qrow - 32]);
      op[(size_t)qrow * DM] = (bf16)f2bf(o10[rr] * il); op[(size_t)qrow * DM + 32] = (bf16)f2bf(o11[rr] * il); }
  asm volatile("s_waitcnt lgkmcnt(0)" ::: "memory");
}
}
namespace sc {
#define LBAR() do { asm volatile("s_waitcnt lgkmcnt(0)" ::: "memory"); __builtin_amdgcn_s_barrier(); asm volatile("" ::: "memory"); } while (0)

using bf16x8 = __attribute__((ext_vector_type(8))) short;
using f32x16 = __attribute__((ext_vector_type(16))) float;
constexpr int RS = 272;
constexpr int TS = 144;
template <int NS> __device__ __forceinline__ void mm(f32x16& c, const LAS char* xb, int xs, const LAS char* yb, int ys, int kb0, int lane) {
    const int r = lane & 31, h = lane >> 5;
    const LAS char* xp = xb + r * xs + kb0 + h * 16; const LAS char* yp = yb + r * ys + kb0 + h * 16;
#pragma unroll
    for (int s = 0; s < NS; ++s) { const bf16x8 a = *(const LAS bf16x8*)(xp + s * 32), b = *(const LAS bf16x8*)(yp + s * 32); c = __builtin_amdgcn_mfma_f32_32x32x16_bf16(a, b, c, 0, 0, 0); }
}
__device__ __forceinline__ unsigned long long pk4(float a, float b, float c, float d) { return (unsigned long long)pk2(a, b) | ((unsigned long long)pk2(c, d) << 32); }

__device__ __forceinline__ void hgrn_unit(int u, const bf16* P, const float* lbl, float* OF, float* OB, LAS unsigned char* ldsu, int tid) {
    const int b = u >> 3, h = (u >> 1) & 3, dir = u & 1, wave = __builtin_amdgcn_readfirstlane(tid >> 6);
    LAS char* lds = (LAS char*)ldsu;
    LAS char* QM = lds; LAS char* KM = lds + 17408; LAS char* KMt = lds + 34816; LAS char* Vt = lds + 53248; LAS char* ST = lds + 71680; LAS char* AA = lds + 106496;
    LAS float* GT = (LAS float*)(lds + 115712); LAS float* CM = (LAS float*)(lds + 117760); LAS float* DL = (LAS float*)(lds + 118272); LAS float* FC = (LAS float*)(lds + 118784);
    float* OUT = dir ? OB : OF;
    float lb; { const int d = tid & 127; const float l0 = lbl[dir * GW + h * 128 + d], l1 = lbl[2 * GW + dir * GW + h * 128 + d]; lb = __builtin_amdgcn_rcpf(1.f + __expf(l1 - l0)); }
    const bf16* Pq = P + (size_t)b * NT_ * P0W + h * 128 + (tid & 127);
    const int fofs = dir ? 1536 : 1024;
    const int et = wave & 3, dt0 = 2 * (wave >> 2), tt = wave >> 2;
    const int tg = tid >> 7;
    f32x16 S0 = {}, S1 = {};
    unsigned rq[16], rf[16], rv[16];
#define HG_LOAD(c) do { _Pragma("unroll") for (int j = 0; j < 16; ++j) { const int tl = (c) * 64 + tg * 16 + j; const int tok = dir ? (NT_ - 1 - tl) : tl; \
        const bf16* p = Pq + (size_t)tok * P0W; rq[j] = p[0]; rv[j] = p[512]; rf[j] = p[fofs]; } } while (0)
    HG_LOAD(0);
#pragma unroll 1
    for (int c_ = 0; c_ < (NT_ / 64) * NREP(30); ++c_) { const int c = c_ & 63; if (c_ == 64) { S0 = f32x16{}; S1 = f32x16{}; }
        int tl_ = tid; asm volatile("" : "+v"(tl_)); const int d = tl_ & 127, lane = tl_ & 63;
#pragma unroll
        for (int j = 0; j < 16; ++j) { asm volatile("" : "+v"(rq[j])); asm volatile("" : "+v"(rf[j])); asm volatile("" : "+v"(rv[j])); }
        float qv[16], kv[16], cum[16]; float run = 0.f;
#pragma unroll
        for (int j = 0; j < 16; ++j) { const float fg = lb + (1.f - lb) * sigm(__builtin_bit_cast(float, rf[j] << 16)); run += __logf(fg); cum[j] = run; kv[j] = 1.f - fg; qv[j] = silu(__builtin_bit_cast(float, rq[j] << 16)); }
        GT[tg * 128 + d] = run;
        LBAR();
        const float g0 = GT[d], g1 = GT[128 + d], g2 = GT[256 + d], g3 = GT[384 + d];
        const float cmid = g0 + g1, cL = cmid + g2 + g3;
        const float off = (tg == 0 ? 0.f : tg == 1 ? g0 : tg == 2 ? cmid : cmid + g2) - cmid;
        if (tg == 0) { CM[d] = __expf(cmid); DL[d] = __expf(cL); FC[d] = __expf(cL - cmid); }
        { unsigned kmw[8];
#pragma unroll
          for (int j = 0; j < 16; j += 2) {
              float x0 = off + cum[j], x1 = off + cum[j + 1];
              x0 = fminf(fmaxf(x0, -80.f), 80.f); x1 = fminf(fmaxf(x1, -80.f), 80.f);
              const float qm0 = qv[j] * __expf(x0), qm1 = qv[j + 1] * __expf(x1), km0 = kv[j] * __expf(-x0), km1 = kv[j + 1] * __expf(-x1);
              const unsigned qmp = pk2(qm0, qm1), kmp = pk2(km0, km1);
              const int t0 = tg * 16 + j;
              *(LAS unsigned short*)(QM + t0 * RS + d * 2) = (unsigned short)qmp; *(LAS unsigned short*)(QM + (t0 + 1) * RS + d * 2) = (unsigned short)(qmp >> 16);
              *(LAS unsigned short*)(KM + t0 * RS + d * 2) = (unsigned short)kmp; *(LAS unsigned short*)(KM + (t0 + 1) * RS + d * 2) = (unsigned short)(kmp >> 16);
              kmw[j >> 1] = kmp; }
          *(LAS v4u*)(KMt + d * TS + tg * 32) = (v4u){kmw[0], kmw[1], kmw[2], kmw[3]}; *(LAS v4u*)(KMt + d * TS + tg * 32 + 16) = (v4u){kmw[4], kmw[5], kmw[6], kmw[7]};
          v4u v0, v1; v0.x = rv[0] | (rv[1] << 16); v0.y = rv[2] | (rv[3] << 16); v0.z = rv[4] | (rv[5] << 16); v0.w = rv[6] | (rv[7] << 16);
          v1.x = rv[8] | (rv[9] << 16); v1.y = rv[10] | (rv[11] << 16); v1.z = rv[12] | (rv[13] << 16); v1.w = rv[14] | (rv[15] << 16);
          *(LAS v4u*)(Vt + d * TS + tg * 32) = v0; *(LAS v4u*)(Vt + d * TS + tg * 32 + 16) = v1; }
        if (c_ + 1 < (NT_ / 64) * NREP(30)) HG_LOAD((c + 1) & 63);
        LBAR();
        { const int e = 32 * et + (lane & 31);
#pragma unroll
          for (int k = 0; k < 2; ++k)
#pragma unroll
              for (int i4 = 0; i4 < 4; ++i4) { const int d0 = 32 * (dt0 + k) + 8 * i4 + 4 * (lane >> 5); const f32x4 cm = *(const LAS f32x4*)(CM + d0);
                  const f32x16& S = k ? S1 : S0;
                  *(LAS unsigned long long*)(ST + e * RS + d0 * 2) = pk4(S[4 * i4] * cm.x, S[4 * i4 + 1] * cm.y, S[4 * i4 + 2] * cm.z, S[4 * i4 + 3] * cm.w); } }
        LBAR();
        f32x16 acc = {};
        mm<8>(acc, QM + 32 * tt * RS, RS, ST + 32 * et * RS, RS, 0, lane);
        if (wave < 3) { const int st = wave >> 1, t2 = (wave + 1) >> 1;
            f32x16 at = {};
            mm<8>(at, KM + 32 * st * RS, RS, QM + 32 * t2 * RS, RS, 0, lane);
            const int tg_ = 32 * t2 + (lane & 31);
#pragma unroll
            for (int i4 = 0; i4 < 4; ++i4) { const int s0 = 32 * st + 8 * i4 + 4 * (lane >> 5);
                *(LAS unsigned long long*)(AA + tg_ * TS + s0 * 2) = pk4(s0 <= tg_ ? at[4 * i4] : 0.f, s0 + 1 <= tg_ ? at[4 * i4 + 1] : 0.f, s0 + 2 <= tg_ ? at[4 * i4 + 2] : 0.f, s0 + 3 <= tg_ ? at[4 * i4 + 3] : 0.f); } }
#pragma unroll
        for (int k = 0; k < 2; ++k) { f32x16 p = {};
            mm<4>(p, KMt + 32 * (dt0 + k) * TS, TS, Vt + 32 * et * TS, TS, 0, lane);
            f32x16& S = k ? S1 : S0;
#pragma unroll
            for (int i4 = 0; i4 < 4; ++i4) { const int d0 = 32 * (dt0 + k) + 8 * i4 + 4 * (lane >> 5); const f32x4 dl = *(const LAS f32x4*)(DL + d0), fc = *(const LAS f32x4*)(FC + d0);
                S[4 * i4] = dl.x * S[4 * i4] + fc.x * p[4 * i4]; S[4 * i4 + 1] = dl.y * S[4 * i4 + 1] + fc.y * p[4 * i4 + 1];
                S[4 * i4 + 2] = dl.z * S[4 * i4 + 2] + fc.z * p[4 * i4 + 2]; S[4 * i4 + 3] = dl.w * S[4 * i4 + 3] + fc.w * p[4 * i4 + 3]; } }
        LBAR();
        if (tt == 0) mm<2>(acc, AA, TS, Vt + 32 * et * TS, TS, 0, lane); else mm<4>(acc, AA + 32 * TS, TS, Vt + 32 * et * TS, TS, 0, lane);
#pragma unroll
        for (int i = 0; i < 16; ++i) { const int tl = c * 64 + 32 * tt + 8 * (i >> 2) + 4 * (lane >> 5) + (i & 3); const int tok = dir ? (NT_ - 1 - tl) : tl;
            OUT[(size_t)(b * NT_ + tok) * GW + h * 128 + 32 * et + (lane & 31)] = acc[i]; }
    }
#undef HG_LOAD
    __syncthreads();
}

__device__ __forceinline__ void mlstm_unit(int u, const bf16* P, const bf16* QKC, const float* ibias, const float* fbias, float* HF, float* HBk, LAS unsigned char* ldsu, int tid) {
    const int b = u >> 3, h = (u >> 1) & 3, dir = u & 1, tg = tid >> 7, wave = __builtin_amdgcn_readfirstlane(tid >> 6);
    LAS char* lds = (LAS char*)ldsu;
    LAS char* Qs = lds; LAS char* Ks = lds + 17408; LAS char* KWt = lds + 34816; LAS char* Vt = lds + 53248; LAS char* ST = lds + 71680; LAS char* AA = lds + 106496;
    LAS float* GB = (LAS float*)(lds + 115712);
    LAS float* DENI = GB + 512; LAS float* DENA = DENI + 64; LAS float* NV = DENA + 128;
    float* OUT = dir ? HBk : HF;
    const float ib = ibias[dir * 4 + h], fb = fbias[dir * 4 + h];
    const bf16* Pv = P + (size_t)b * NT_ * P1W + 1024 + h * 128 + (tid & 127); const bf16* Pg = P + (size_t)b * NT_ * P1W + 3584 + dir * 8 + h;
    const bf16* Kg = QKC + (size_t)b * NT_ * DM + GW + h * 128 + (tid & 127);
    const bf16* Qw = QKC + (size_t)b * NT_ * DM + h * 128 + (tid & 7) * 16;
    const int et = wave & 3, dt0 = 2 * (wave >> 2), tt = wave >> 2;
    f32x16 S0 = {}, S1 = {};
    if (tid < 256) NV[tid] = 0.f;
    for (int i = tid; i < 128 * RS / 16; i += 512) *(LAS v4u*)(ST + i * 16) = (v4u){0u, 0u, 0u, 0u};
    unsigned rk[16], rv[16]; v4u wq0, wq1, wk0, wk1; unsigned rgi = 0, rgf = 0;
#define ML_LOAD(c) do { _Pragma("unroll") for (int j = 0; j < 16; ++j) { const int tl = (c) * 64 + tg * 16 + j; const int tok = dir ? (NT_ - 1 - tl) : tl; \
        rk[j] = Kg[(size_t)tok * DM]; rv[j] = Pv[(size_t)tok * P1W]; } \
        { const int tl = (c) * 64 + (tid >> 3); const int tok = dir ? (NT_ - 1 - tl) : tl; const bf16* qp = Qw + (size_t)tok * DM; \
          wq0 = *(const v4u*)qp; wq1 = *(const v4u*)(qp + 8); wk0 = *(const v4u*)(qp + GW); wk1 = *(const v4u*)(qp + GW + 8); } } while (0)
#define ML_GLOAD(c) do { if (tid < 64) { const int tl = (c) * 64 + tid; const int tok = dir ? (NT_ - 1 - tl) : tl; rgi = Pg[(size_t)tok * P1W]; rgf = Pg[(size_t)tok * P1W + 4]; } } while (0)
#define ML_GATES(buf) do { if (tid < 64) { const float ig = __builtin_bit_cast(float, rgi << 16) + ib, x = __builtin_bit_cast(float, rgf << 16) + fb; const float lf = -__logf(1.f + __expf(-x)); float cs = lf; \
            _Pragma("unroll") for (int o = 1; o < 64; o <<= 1) { const float t_ = __shfl_up(cs, o); if ((tid & 63) >= o) cs += t_; } \
            const float cL = __shfl(cs, 63); LAS float* g_ = GB + (buf) * 256; \
            g_[tid] = __expf(cs); g_[64 + tid] = __expf(ig - cs); g_[128 + tid] = __expf(cL - cs + ig); if (tid == 0) g_[192] = __expf(cL); } } while (0)
    ML_GLOAD(0); ML_GATES(0); ML_GLOAD(1); ML_LOAD(0);
    __syncthreads();
#pragma unroll 1
    for (int c = 0; c < NT_ / 64; ++c) {
        int tl_ = tid; asm volatile("" : "+v"(tl_)); const int d = tl_ & 127, lane = tl_ & 63;
#pragma unroll
        for (int j = 0; j < 16; ++j) { asm volatile("" : "+v"(rk[j])); asm volatile("" : "+v"(rv[j])); }
        asm volatile("" : "+v"(wq0)); asm volatile("" : "+v"(wq1)); asm volatile("" : "+v"(wk0)); asm volatile("" : "+v"(wk1)); asm volatile("" : "+v"(rgi)); asm volatile("" : "+v"(rgf));
        const LAS float* G = GB + (c & 1) * 256; const LAS float* NVc = NV + (c & 1) * 128; LAS float* NVn = NV + ((c + 1) & 1) * 128;
        { const int t = tl_ >> 3, part = tl_ & 7;
          *(LAS v4u*)(Qs + t * RS + part * 32) = wq0; *(LAS v4u*)(Qs + t * RS + part * 32 + 16) = wq1; *(LAS v4u*)(Ks + t * RS + part * 32) = wk0; *(LAS v4u*)(Ks + t * RS + part * 32 + 16) = wk1; }
        { unsigned kw[8];
#pragma unroll
          for (int j = 0; j < 16; j += 2) { const int t0 = tg * 16 + j; kw[j >> 1] = pk2(__builtin_bit_cast(float, rk[j] << 16) * G[128 + t0], __builtin_bit_cast(float, rk[j + 1] << 16) * G[128 + t0 + 1]); }
          *(LAS v4u*)(KWt + d * TS + tg * 32) = (v4u){kw[0], kw[1], kw[2], kw[3]}; *(LAS v4u*)(KWt + d * TS + tg * 32 + 16) = (v4u){kw[4], kw[5], kw[6], kw[7]};
          v4u v0, v1; v0.x = rv[0] | (rv[1] << 16); v0.y = rv[2] | (rv[3] << 16); v0.z = rv[4] | (rv[5] << 16); v0.w = rv[6] | (rv[7] << 16);
          v1.x = rv[8] | (rv[9] << 16); v1.y = rv[10] | (rv[11] << 16); v1.z = rv[12] | (rv[13] << 16); v1.w = rv[14] | (rv[15] << 16);
          *(LAS v4u*)(Vt + d * TS + tg * 32) = v0; *(LAS v4u*)(Vt + d * TS + tg * 32 + 16) = v1; }
        if (c + 1 < NT_ / 64) { ML_GATES((c + 1) & 1); ML_LOAD(c + 1); if (c + 2 < NT_ / 64) ML_GLOAD(c + 2); }
        LBAR();
        { const int t = tl_ >> 3, part = tl_ & 7; float qf[16]; unpack8(*(const LAS v4u*)(Qs + t * RS + part * 32), *(float(*)[8])&qf[0]); unpack8(*(const LAS v4u*)(Qs + t * RS + part * 32 + 16), *(float(*)[8])&qf[8]);
          float s = 0.f;
#pragma unroll
          for (int i = 0; i < 16; ++i) s += qf[i] * NVc[part * 16 + i];
          s += __shfl_xor(s, 1); s += __shfl_xor(s, 2); s += __shfl_xor(s, 4);
          if (part == 0) DENI[t] = s * G[t]; }
        f32x16 acc = {};
        mm<8>(acc, Qs + 32 * tt * RS, RS, ST + 32 * et * RS, RS, 0, lane);
#pragma unroll
        for (int i4 = 0; i4 < 4; ++i4) { const f32x4 rf = *(const LAS f32x4*)(G + 32 * tt + 8 * i4 + 4 * (lane >> 5));
            acc[4 * i4] *= rf.x; acc[4 * i4 + 1] *= rf.y; acc[4 * i4 + 2] *= rf.z; acc[4 * i4 + 3] *= rf.w; }
        if (wave < 3) { const int st = wave >> 1, t2 = (wave + 1) >> 1;
            f32x16 at = {};
            mm<8>(at, Ks + 32 * st * RS, RS, Qs + 32 * t2 * RS, RS, 0, lane);
            const int tg_ = 32 * t2 + (lane & 31); const float rowf = G[tg_]; float dsum = 0.f;
#pragma unroll
            for (int i4 = 0; i4 < 4; ++i4) { const int s0 = 32 * st + 8 * i4 + 4 * (lane >> 5); const f32x4 cf = *(const LAS f32x4*)(G + 64 + s0);
                const float a0 = s0 <= tg_ ? at[4 * i4] * cf.x * rowf : 0.f, a1 = s0 + 1 <= tg_ ? at[4 * i4 + 1] * cf.y * rowf : 0.f;
                const float a2 = s0 + 2 <= tg_ ? at[4 * i4 + 2] * cf.z * rowf : 0.f, a3 = s0 + 3 <= tg_ ? at[4 * i4 + 3] * cf.w * rowf : 0.f;
                dsum += (a0 + a1) + (a2 + a3);
                *(LAS unsigned long long*)(AA + tg_ * TS + s0 * 2) = pk4(a0, a1, a2, a3); }
            dsum += __shfl_xor(dsum, 32);
            if (lane < 32) DENA[st * 64 + tg_] = dsum;
            if (wave == 0 && lane < 32) DENA[64 + lane] = 0.f; }
        { const float dls = G[192];
#pragma unroll
          for (int k = 0; k < 2; ++k) { f32x16 p = {};
              mm<4>(p, KWt + 32 * (dt0 + k) * TS, TS, Vt + 32 * et * TS, TS, 0, lane);
              f32x16& S = k ? S1 : S0;
#pragma unroll
              for (int i = 0; i < 16; ++i) S[i] = dls * S[i] + p[i]; }
          if (tl_ < 128) { float s = 0.f;
#pragma unroll
              for (int q8 = 0; q8 < 8; ++q8) { float f8[8]; unpack8(*(const LAS v4u*)(KWt + tl_ * TS + q8 * 16), f8);
#pragma unroll
                  for (int i = 0; i < 8; ++i) s += f8[i]; }
              NVn[tl_] = dls * NVc[tl_] + s; } }
        LBAR();
        if (tt == 0) mm<2>(acc, AA, TS, Vt + 32 * et * TS, TS, 0, lane); else mm<4>(acc, AA + 32 * TS, TS, Vt + 32 * et * TS, TS, 0, lane);
#pragma unroll
        for (int i = 0; i < 16; ++i) { const int tc = 32 * tt + 8 * (i >> 2) + 4 * (lane >> 5) + (i & 3); const int tl = c * 64 + tc; const int tok = dir ? (NT_ - 1 - tl) : tl;
            const float den = DENI[tc] + DENA[tc] + DENA[64 + tc];
            OUT[(size_t)(b * NT_ + tok) * GW + h * 128 + 32 * et + (lane & 31)] = acc[i] / fmaxf(fabsf(den), 1.f); }
        { const int e = 32 * et + (lane & 31);
#pragma unroll
          for (int k = 0; k < 2; ++k)
#pragma unroll
              for (int i4 = 0; i4 < 4; ++i4) { const int d0 = 32 * (dt0 + k) + 8 * i4 + 4 * (lane >> 5); const f32x16& S = k ? S1 : S0;
                  *(LAS unsigned long long*)(ST + e * RS + d0 * 2) = pk4(S[4 * i4], S[4 * i4 + 1], S[4 * i4 + 2], S[4 * i4 + 3]); } }
        LBAR();
    }
#undef ML_LOAD
#undef ML_GLOAD
#undef ML_GATES
}
}
#ifndef STOP_AFTER
#define STOP_AFTER 25
#endif
constexpr int N_PHASES = 26;
struct Args { const float* in[44]; float* out; unsigned char* ws; int ph_lo, ph_hi, li, pad; };
__global__ void __launch_bounds__(NWAVES * 64, 2) fwd_kernel(Args args) {
    extern __shared__ __attribute__((aligned(16))) unsigned char lds_raw[];
    LAS unsigned char* lds = (LAS unsigned char*)lds_raw;
    volatile LAS unsigned* MISC = (volatile LAS unsigned*)(lds + MISC_OFF);
    LAS int* TB = (LAS int*)(lds + TBL_OFF);
    const int tid0 = threadIdx.x, wave = __builtin_amdgcn_readfirstlane(tid0 >> 6);
    const int G = gridDim.x, bx = blockIdx.x;
    const int gw = bx * NWAVES + wave, NGW = G * NWAVES, NGT = G * NWAVES * 64;
    unsigned char* ws = args.ws;
    gu32* ctl = (gu32*)(ws + WS_CTL);
    const float* x_in = args.in[0]; const float* c_in = args.in[1]; const float* lbl = args.in[2];
    const float* const* L0 = args.in + 3; const float* const* L1 = args.in + 23; const float* fnorm = args.in[43];
    float* xo = args.out;
    float* TAB = (float*)(ws + WS_TAB); float* MOD = (float*)(ws + WS_MOD);
    bf16* WIN0 = (bf16*)(ws + WS_WIN0); bf16* WIN1 = (bf16*)(ws + WS_WIN1); bf16* WOUT0 = (bf16*)(ws + WS_WOUT0); bf16* WOUT1 = (bf16*)(ws + WS_WOUT1);
    bf16* ROUT0 = (bf16*)(ws + WS_ROUT0); bf16* ROUT1 = (bf16*)(ws + WS_ROUT1); bf16* GU = (bf16*)(ws + WS_GU); bf16* DN = (bf16*)(ws + WS_DN);
    bf16* H2A = (bf16*)(ws + WS_H2A); bf16* H2B = (bf16*)(ws + WS_H2B); bf16* PROJ = (bf16*)(ws + WS_PROJ); bf16* CAT = (bf16*)(ws + WS_CAT);
    float* OF = (float*)(ws + WS_OF); float* OB = (float*)(ws + WS_OB); bf16* QKC = (bf16*)(ws + WS_QKC);
    bf16* YB = (bf16*)(ws + WS_Y); bf16* HB = (bf16*)(ws + WS_HB); float* LOG = (float*)(ws + WS_LOG);
    int* TOPI = (int*)(ws + WS_TOPI); float* TOPW = (float*)(ws + WS_TOPW); int* RANK = (int*)(ws + WS_RANK); int* SLOT = (int*)(ws + WS_SLOT); int* LIST = (int*)(ws + WS_LIST);

    for (int u = tid0; u < (LDS_BYTES - LDSCTL_OFF) / 4; u += NWAVES * 64) ((LAS unsigned*)(lds + LDSCTL_OFF))[u] = 0u;
    __syncthreads();
    XcdBarrier bar = xcd_barrier_post((unsigned*)(ctl + CW_BAR + args.li * 4096), MISC + 8);
#ifndef PREFIX_K
#define PREFIX_K -1
#endif
    const int pass = args.li;
    const int lo = args.ph_lo, hi = args.ph_hi;
    gu32* const qh = ctl + CW_Q0 + pass * 256; unsigned* const cnt0 = (unsigned*)(ctl + CW_CNT0 + pass * 512); unsigned* const cnt1 = (unsigned*)(ctl + CW_CNT1 + pass * 512);
#define IN(k) (lo <= (k) && (k) < hi)
#define FRESH() int tid = wave * 64 + pg8::fresh_lane(); asm volatile("" : "+v"(tid)); const int lane = tid & 63; const int gtid = bx * (NWAVES * 64) + tid; (void)lane; (void)gtid
#define SEAM(k) do { if (IN(k) && IN((k) + 1)) xcd_barrier(bar); } while (0)
    LAS float* scr = (LAS float*)(lds + wave * 8448);

    if (IN(0)) { FRESH();
        if (bx < 192) mod_unit(bx, c_in, L0[2], L0[3], L1[2], L1[3], MOD, lds, tid, wave, lane);
        int jbase = 0;
        TR_JOB(L0[4], 4096, 1024, 0, 4096, WIN0, 0);
        TR_JOB(L1[4], 3600, 1024, 0, 2048, WIN1, 0);
        TR_JOB(L1[4], 3600, 1024, 2064, 1536, WIN1, 2048);
        TR_JOB(L1[4], 3600, 1024, 2048, 16, WIN1, 3584);
        TR_JOB(L0[5], 1024, 1024, 0, 1024, WOUT0, 0);
        TR_JOB(L1[5], 1024, 1024, 0, 1024, WOUT1, 0);
        TR_JOB(L0[12], 128, 1024, 0, 128, ROUT0, 0);
        TR_JOB(L1[12], 128, 1024, 0, 128, ROUT1, 0);
        { const v4u z = {0u, 0u, 0u, 0u};
          for (int i = gtid; i < 224 * 128; i += NGT) *(v4u*)(WIN1 + (size_t)3616 * 1024 + (size_t)i * 8) = z;
          for (int i = gtid; i < 128 * 128; i += NGT) { *(v4u*)(ROUT0 + (size_t)128 * 1024 + (size_t)i * 8) = z; *(v4u*)(ROUT1 + (size_t)128 * 1024 + (size_t)i * 8) = z; } }
        for (int t = gtid; t < NT_; t += NGT) {
            const float invf[8] = {1.0f, 0.1939227432f, 0.0376060307f, 0.00729266461f, 0.00141421356f, 0.000274248188f, 5.31829573e-05f, 1.03133852e-05f};
#pragma unroll
            for (int i = 0; i < 8; ++i) { const float ang = (float)t * invf[i]; double rev = (double)ang * 0.15915494309189535; rev -= floor(rev); const float rv = (float)rev;
                TAB[t * 16 + i] = __builtin_amdgcn_cosf(rv); TAB[t * 16 + 8 + i] = __builtin_amdgcn_sinf(rv); }
        }
    }
    SEAM(0);
    if (IN(1)) { FRESH(); _Pragma("unroll 1") for (int rep_ = 0; rep_ < NREP(1); ++rep_) normmod_phase(x_in, L0[0], MOD, 0, 1024, H2A, gw, NGW, lane); }
    SEAM(1);
    if (IN(2)) { FRESH(); pg8::DenseOrder S; S.init(NTOK, P0W, G, bx); EpiStoreBf16 E{PROJ, P0W};
        _Pragma("unroll 1") for (int rep_ = 0; rep_ < NREP(2); ++rep_) pg8::gemm_phase<EpiStoreBf16, pg8::DenseOrder, true>(lds, H2A, WIN0, DM, S, E, wave); }
    SEAM(2);
    if (IN(3)) { FRESH(); rope_phase(PROJ, TAB, gtid, NGT); }
    SEAM(3);
    if (IN(4)) { FRESH();
        if (bx < 64) sc::hgrn_unit(bx, PROJ, lbl, OF, OB, lds, tid);
        float lam;
        { float a = L0[7][lane] * L0[8][lane], b2 = L0[9][lane] * L0[10][lane]; a = wave_sum(a); b2 = wave_sum(b2); lam = __expf(a) - __expf(b2) + 0.2f; }
        for (;;) { const int u = q_pull(qh, MISC + 0, tid); if (u >= 1024 * NREP(4)) break; da::unit(u & 1023, PROJ, lam, L0[11], CAT, (LAS char*)lds, tid); }
        for (;;) { const int u0 = q_pull(qh + 64, MISC + 1, tid); if (u0 >= 1032 * NREP(27)) break; const int u = u0 % 1032;
#pragma unroll 1
            for (int k = 0; k < 6; ++k) expert_item(L0[14], L0[15], L0[16], L0[17], L0[18], L0[19], GU, DN, u * 48 + wave * 6 + k, scr, lane); }
    }
    SEAM(4);
    if (IN(5)) { FRESH(); _Pragma("unroll 1") for (int rep_ = 0; rep_ < NREP(5); ++rep_) gateout_phase<0>(OF, OB, L0[6], PROJ, P0W, 2048, CAT, gw, NGW, lane); }
    SEAM(5);
    if (IN(6)) { FRESH(); pg8::DenseOrder S; S.init(NTOK, DM, G, bx); EpiResid E{x_in, xo, MOD + 2048};
        _Pragma("unroll 1") for (int rep_ = 0; rep_ < NREP(6); ++rep_) pg8::gemm_phase<EpiResid, pg8::DenseOrder, true>(lds, CAT, WOUT0, DM, S, E, wave); }
    SEAM(6);
    if (IN(7)) { FRESH(); _Pragma("unroll 1") for (int rep_ = 0; rep_ < NREP(7); ++rep_) normmod_phase(xo, L0[1], MOD, 3072, 4096, H2A, gw, NGW, lane); }
    SEAM(7);
    if (IN(8)) { FRESH(); pg8::DenseOrder S; S.init(NTOK, 256, G, bx); EpiF32 E{LOG, 256};
        _Pragma("unroll 1") for (int rep_ = 0; rep_ < NREP(8); ++rep_) pg8::gemm_phase<EpiF32, pg8::DenseOrder, true>(lds, H2A, ROUT0, DM, S, E, wave); }
    SEAM(8);
    if (IN(9)) { FRESH(); topk_phase(LOG, L0[13], TOPI, TOPW, RANK, cnt0, lds, bx, G, wave, tid); }
    SEAM(9);
    if (IN(10)) { FRESH(); moe_tables(cnt0, TB, tid); _Pragma("unroll 1") for (int rep_ = 0; rep_ < NREP(10); ++rep_) list_phase(TOPI, RANK, SLOT, LIST, TB, gtid, NGT); }
    SEAM(10);
    if (IN(11)) { FRESH(); moe_tables(cnt0, TB, tid); GroupOrder S; S.init(TB, LIST, 2, G, bx); EpiGateUp E{HB};
        _Pragma("unroll 1") for (int rep_ = 0; rep_ < NREP(11); ++rep_) pg8::gemm_phase<EpiGateUp, GroupOrder, true>(lds, H2A, GU, DM, S, E, wave); }
    SEAM(11);
    if (IN(12)) { FRESH(); moe_tables(cnt0, TB, tid); GroupOrder S; S.init(TB, nullptr, 4, G, bx); EpiDown E{YB};
        _Pragma("unroll 1") for (int rep_ = 0; rep_ < NREP(12); ++rep_) pg8::gemm_phase<EpiDown, GroupOrder, true>(lds, HB, DN, EFF, S, E, wave); }
    SEAM(12);
    if (IN(13)) { FRESH(); combine_phase(xo, YB, SLOT, TOPW, MOD, 5120, L1[0], MOD + 8 * 6144, 0, 1024, H2B, nullptr, gw, NGW, lane); }
    SEAM(13);
    if (IN(14)) { FRESH(); pg8::DenseOrder S; S.init(NTOK, P1W, G, bx); EpiStoreBf16 E{PROJ, P1W};
        _Pragma("unroll 1") for (int rep_ = 0; rep_ < NREP(14); ++rep_) pg8::gemm_phase<EpiStoreBf16, pg8::DenseOrder, true>(lds, H2B, WIN1, DM, S, E, wave); }
    SEAM(14);
    if (IN(15)) { FRESH(); _Pragma("unroll 1") for (int rep_ = 0; rep_ < NREP(15); ++rep_) convqk_phase(PROJ, L1[6], L1[7], QKC, gtid, NGT); }
    SEAM(15);
    if (IN(16)) { FRESH();
        if (bx < 64) sc::mlstm_unit(bx, PROJ, QKC, L1[8], L1[9], OF, OB, lds, tid);
        { LAS float* BT = (LAS float*)(lds + 69632); for (int i = tid; i < 3720; i += 512) BT[i] = L1[11][i];
          for (;;) { const int u = q_pull(qh + 128, MISC + 2, tid); if (u >= 512 * NREP(16)) break; na::item((u & 511) * 8 + wave, PROJ, BT, CAT, (LAS char*)lds + wave * 8448, lane); } }
        for (;;) { const int u0 = q_pull(qh + 192, MISC + 3, tid); if (u0 >= 1032 * NREP(28)) break; const int u = u0 % 1032;
#pragma unroll 1
            for (int k = 0; k < 6; ++k) expert_item(L1[14], L1[15], L1[16], L1[17], L1[18], L1[19], GU, DN, u * 48 + wave * 6 + k, scr, lane); }
    }
    SEAM(16);
    if (IN(17)) { FRESH(); _Pragma("unroll 1") for (int rep_ = 0; rep_ < NREP(17); ++rep_) gateout_phase<1>(OF, OB, L1[10], PROJ, P1W, 1536, CAT, gw, NGW, lane); }
    SEAM(17);
    if (IN(18)) { FRESH(); pg8::DenseOrder S; S.init(NTOK, DM, G, bx); EpiResid E{xo, xo, MOD + 8 * 6144 + 2048};
        pg8::gemm_phase<EpiResid, pg8::DenseOrder, true>(lds, CAT, WOUT1, DM, S, E, wave); }
    SEAM(18);
    if (IN(19)) { FRESH(); _Pragma("unroll 1") for (int rep_ = 0; rep_ < NREP(19); ++rep_) normmod_phase(xo, L1[1], MOD + 8 * 6144, 3072, 4096, H2A, gw, NGW, lane); }
    SEAM(19);
    if (IN(20)) { FRESH(); pg8::DenseOrder S; S.init(NTOK, 256, G, bx); EpiF32 E{LOG, 256};
        _Pragma("unroll 1") for (int rep_ = 0; rep_ < NREP(20); ++rep_) pg8::gemm_phase<EpiF32, pg8::DenseOrder, true>(lds, H2A, ROUT1, DM, S, E, wave); }
    SEAM(20);
    if (IN(21)) { FRESH(); topk_phase(LOG, L1[13], TOPI, TOPW, RANK, cnt1, lds, bx, G, wave, tid); }
    SEAM(21);
    if (IN(22)) { FRESH(); moe_tables(cnt1, TB, tid); _Pragma("unroll 1") for (int rep_ = 0; rep_ < NREP(22); ++rep_) list_phase(TOPI, RANK, SLOT, LIST, TB, gtid, NGT); }
    SEAM(22);
    if (IN(23)) { FRESH(); moe_tables(cnt1, TB, tid); GroupOrder S; S.init(TB, LIST, 2, G, bx); EpiGateUp E{HB};
        _Pragma("unroll 1") for (int rep_ = 0; rep_ < NREP(23); ++rep_) pg8::gemm_phase<EpiGateUp, GroupOrder, true>(lds, H2A, GU, DM, S, E, wave); }
    SEAM(23);
    if (IN(24)) { FRESH(); moe_tables(cnt1, TB, tid); GroupOrder S; S.init(TB, nullptr, 4, G, bx); EpiDown E{YB};
        _Pragma("unroll 1") for (int rep_ = 0; rep_ < NREP(24); ++rep_) pg8::gemm_phase<EpiDown, GroupOrder, true>(lds, HB, DN, EFF, S, E, wave); }
    SEAM(24);
    if (IN(25)) { FRESH(); combine_phase(xo, YB, SLOT, TOPW, MOD + 8 * 6144, 5120, nullptr, nullptr, 0, 0, nullptr, fnorm, gw, NGW, lane); }
    {
    if (pass == 1 && hi < N_PHASES && hi > 0 && IN(hi - 1)) { FRESH();
        xcd_barrier(bar);
        const float* src = (hi - 1 >= 6) ? (const float*)xo : x_in;
        for (int m = gw; m < NTOK; m += NGW) { const f32x4* xr = (const f32x4*)(src + (size_t)m * DM) + lane; f32x4 v[4];
#pragma unroll
            for (int j = 0; j < 4; ++j) v[j] = xr[64 * j];
            finalnorm_row(v, fnorm, xo + (size_t)m * DM, lane); }
    }
    }
#undef IN
#undef SEAM
}

extern "C" void kernel_launch(void* const* d_in, const int* in_sizes, int n_in, void* d_out, int out_size, void* d_ws, size_t ws_size, hipStream_t stream) {
    static int grid = 0;
    if (grid == 0) {
        if (n_in != 44 || in_sizes[0] != NTOK * DM || out_size != NTOK * DM || ws_size < WS_END) {
            fprintf(stderr, "kernel_launch: shape mismatch: n_in %d in0 %d out %d ws %zu (need %zu)\n", n_in, n_in > 0 ? in_sizes[0] : -1, out_size, ws_size, (size_t)WS_END); grid = -1; return; }
        int dev = 0, cus = 0, per_cu = 0;
        if (hipGetDevice(&dev) != hipSuccess || hipDeviceGetAttribute(&cus, hipDeviceAttributeMultiprocessorCount, dev) != hipSuccess) { grid = -1; return; }
        if (hipFuncSetAttribute((const void*)fwd_kernel, hipFuncAttributeMaxDynamicSharedMemorySize, LDS_BYTES) != hipSuccess) { fprintf(stderr, "kernel_launch: hipFuncSetAttribute failed\n"); grid = -1; return; }
        if (hipOccupancyMaxActiveBlocksPerMultiprocessor(&per_cu, (const void*)fwd_kernel, NWAVES * 64, LDS_BYTES) != hipSuccess || per_cu < 1) { fprintf(stderr, "kernel_launch: occupancy query reports %d\n", per_cu); }
        (void)hipGetLastError();
        grid = cus;
    }
    if (grid < 0) return;
    if (hipMemsetAsync((char*)d_ws + WS_CTL, 0, CTL_ZERO_BYTES, stream) != hipSuccess) return;
    Args a{};
    for (int i = 0; i < 44; ++i) a.in[i] = (const float*)d_in[i];
    a.out = (float*)d_out; a.ws = (unsigned char*)d_ws;
#if PREFIX_K >= 0
    a.ph_lo = 0; a.ph_hi = PREFIX_K + 1; a.li = 0;
    hipLaunchKernelGGL(fwd_kernel, dim3(grid), dim3(NWAVES * 64), LDS_BYTES, stream, a);
#endif
    a.ph_lo = 0; a.ph_hi = STOP_AFTER + 1; a.li = 1;
    hipLaunchKernelGGL(fwd_kernel, dim3(grid), dim3(NWAVES * 64), LDS_BYTES, stream, a);
    const hipError_t le = hipPeekAtLastError();
    if (le != hipSuccess) fprintf(stderr, "kernel_launch: launch failed: %s\n", hipGetErrorName(le));
}
```

```cpp
#include <hip/hip_runtime.h>
#include <cstdio>
#include <cstdint>

namespace pg8 {
#define PG8_LAS __attribute__((address_space(3)))
typedef unsigned short bf16_t;
typedef short bf16x8 __attribute__((ext_vector_type(8)));
typedef float f32x4 __attribute__((ext_vector_type(4)));
typedef unsigned u32x4 __attribute__((ext_vector_type(4)));
constexpr int BM = 256, BK = 64, HALF = 128, HTB = HALF * BK * 2  , STAGE_BYTES = 8 * HTB, NXCD = 8, WGM = 8;

__host__ __device__ __forceinline__ int lds_byte(int r, int c) { const int st = (r >> 4) * 2 + (c >> 5), rr = r & 15, cc = c & 31, ob = rr * 64 + cc * 2; return st * 1024 + (ob ^ (((ob >> 9) & 1) << 5)); }
__host__ __device__ __forceinline__ void stage_rc(int b, int& R, int& C) { const int st = b / 1024, sb = b % 1024, swz = sb ^ (((sb >> 9) & 1) << 5); R = (st >> 1) * 16 + swz / 64; C = (st & 1) * 32 + (swz % 64) / 2; }
__host__ __device__ __forceinline__ int perm32(int rho) { const int n = rho >> 4, i = rho & 15; return 8 * (i >> 2) + 4 * n + (i & 3); }

__device__ __forceinline__ int fresh_lane() { int l; asm volatile("v_mbcnt_lo_u32_b32 %0, -1, 0\n\tv_mbcnt_hi_u32_b32 %0, -1, %0" : "=v"(l)); return l; }

struct Unit { int pn, arow0, nvalid, bt; };

struct DenseOrder {
    int nM, nN, nwg, G, c;
    __device__ __forceinline__ void init(int M, int N, int G_, int c_) { nM = M / BM; nN = N / BM; nwg = nM * nN; G = G_; c = c_; }
    __device__ __forceinline__ bool next(int i, Unit& u) const {
        const long L = (long)i * G + c; if (L >= nwg) return false;
        int wgid = (int)L; { const int q = nwg / NXCD, r = nwg % NXCD, xcd = wgid % NXCD, off = wgid / NXCD; wgid = (xcd < r ? xcd * (q + 1) : r * (q + 1) + (xcd - r) * q) + off; }
        const int nig = WGM * nN, gid = wgid / nig, fm = gid * WGM, gsz = (nM - fm) < WGM ? (nM - fm) : WGM;
        const int pm = fm + ((wgid % nig) % gsz); u.pn = (wgid % nig) / gsz; u.arow0 = pm * BM; u.nvalid = BM; u.bt = u.pn; return true;
    }
    __device__ __forceinline__ int arow(const Unit& u, int r) const { return u.arow0 + r; }
};

__device__ __forceinline__ unsigned cvt_pk_bf16(float lo, float hi) { unsigned r; asm volatile("v_cvt_pk_bf16_f32 %0, %1, %2" : "=v"(r) : "v"(lo), "v"(hi)); return r; }

template <class Epi, class Sched, bool ALIGN_EPI>
__device__ __forceinline__ void gemm_phase(PG8_LAS unsigned char* lds, const bf16_t* A, const bf16_t* Bt, const int K, const Sched& S, const Epi& E, const int wid  ) {
    int tid = wid * 64 + pg8::fresh_lane(); asm volatile("" : "+v"(tid));
    const int lane = tid & 63, wr = wid >> 2, wc = wid & 3, fr = lane & 15, fq = lane >> 4;
    const int nt = K / BK;
    unsigned voffB[2];
#pragma unroll
    for (int i = 0; i < 2; ++i) { int R, C; stage_rc(tid * 16 + i * 8192, R, C); const int Rb = Epi::PERM ? ((R & ~31) + perm32(R & 31)) : R;
        voffB[i] = (unsigned)(Rb * K + C) * 2u; }
#define PG8_AOFF(U, o00, o01, o10, o11) do { int _t = wid * 64 + pg8::fresh_lane(); asm volatile("" : "+v"(_t)); int _R0, _C0, _R1, _C1; stage_rc(_t * 16, _R0, _C0); stage_rc(_t * 16 + 8192, _R1, _C1); \
        o00 = (unsigned)S.arow(U, _R0) * K2 + (unsigned)_C0 * 2u; o01 = (unsigned)S.arow(U, _R1) * K2 + (unsigned)_C1 * 2u; \
        o10 = (unsigned)S.arow(U, HALF + _R0) * K2 + (unsigned)_C0 * 2u; o11 = (unsigned)S.arow(U, HALF + _R1) * K2 + (unsigned)_C1 * 2u; } while (0)
    const unsigned K2 = (unsigned)K * 2u;
    const unsigned kstep = (unsigned)(BK * 2);
    const size_t hstep = (size_t)HALF * K * 2;
    const size_t tstep = 2 * hstep;
    const unsigned ldsw = (unsigned)wid * 1024u;
    const int aoff = lds_byte(wr * 64 + fr, fq * 8), boff = lds_byte(wc * 32 + fr, fq * 8);
    const char* Ab = (const char*)A; const char* Bb = (const char*)Bt;
#define PG8_SA(b, h) (((b) * 2 + (h)) * HTB)
#define PG8_SB(b, h) ((4 + (b) * 2 + (h)) * HTB)
#define PG8_STAGE_B(bufoff, gbase) do { _Pragma("unroll") for (int _i = 0; _i < 2; ++_i) \
        __builtin_amdgcn_global_load_lds((const unsigned*)((const char*)(gbase) + voffB[_i]), (PG8_LAS unsigned*)(lds + (bufoff) + ldsw + _i * 8192), 16, 0, 0); } while (0)
#define PG8_STAGE_A(bufoff, kbyte, o0, o1) do { \
        __builtin_amdgcn_global_load_lds((const unsigned*)(Ab + (size_t)((kbyte) + (o0))), (PG8_LAS unsigned*)(lds + (bufoff) + ldsw), 16, 0, 0); \
        __builtin_amdgcn_global_load_lds((const unsigned*)(Ab + (size_t)((kbyte) + (o1))), (PG8_LAS unsigned*)(lds + (bufoff) + ldsw + 8192), 16, 0, 0); } while (0)
#define PG8_LDA(dst, b, h) do { _Pragma("unroll") for (int m = 0; m < 4; ++m) _Pragma("unroll") for (int k = 0; k < 2; ++k) dst[m][k] = *(const PG8_LAS bf16x8*)(lds + PG8_SA(b, h) + aoff + m * 2048 + k * 1024); } while (0)
#define PG8_LDB(dst, b, h) do { _Pragma("unroll") for (int n = 0; n < 2; ++n) _Pragma("unroll") for (int k = 0; k < 2; ++k) dst[n][k] = *(const PG8_LAS bf16x8*)(lds + PG8_SB(b, h) + boff + n * 2048 + k * 1024); } while (0)
#define PG8_MMA(ai, bj, At, Bt_) do { __builtin_amdgcn_s_setprio(1); _Pragma("unroll") for (int m = 0; m < 4; ++m) _Pragma("unroll") for (int n = 0; n < 2; ++n) _Pragma("unroll") for (int k = 0; k < 2; ++k) \
        acc[ai][bj][m][n] = __builtin_amdgcn_mfma_f32_16x16x32_bf16(Bt_[n][k], At[m][k], acc[ai][bj][m][n], 0, 0, 0); __builtin_amdgcn_s_setprio(0); } while (0)
#define PG8_WAIT_V(n) asm volatile("s_waitcnt vmcnt(" #n ")" ::: "memory")
#define PG8_WAIT_L(n) asm volatile("s_waitcnt lgkmcnt(" #n ")" ::: "memory")
#define PG8_BAR __builtin_amdgcn_s_barrier()
#define PG8_SCHED __builtin_amdgcn_sched_barrier(0)
    Unit cur, nxt; int ui = 0;
    if (!S.next(0, cur)) return;
    f32x4 acc[2][2][4][2];
#pragma unroll
    for (int a = 0; a < 2; ++a)
#pragma unroll
        for (int b = 0; b < 2; ++b)
#pragma unroll
            for (int m = 0; m < 4; ++m)
#pragma unroll
                for (int n = 0; n < 2; ++n) acc[a][b][m][n] = (f32x4){0.f, 0.f, 0.f, 0.f};
    bf16x8 At[4][2], B0[2][2], B1[2][2];
    unsigned c00, c01, c10, c11, n00, n01, n10, n11;
    PG8_AOFF(cur, c00, c01, c10, c11);
    const char* cB = Bb + (size_t)cur.bt * tstep;
    PG8_STAGE_B(PG8_SB(0, 0), cB); PG8_STAGE_B(PG8_SB(0, 1), cB + hstep); PG8_STAGE_A(PG8_SA(0, 0), 0u, c00, c01); PG8_STAGE_A(PG8_SA(0, 1), 0u, c10, c11);
    if (wr == 1) PG8_BAR;
    PG8_WAIT_V(2); PG8_BAR;
    PG8_STAGE_B(PG8_SB(1, 0), cB + kstep); PG8_STAGE_A(PG8_SA(1, 0), kstep, c00, c01); PG8_STAGE_B(PG8_SB(1, 1), cB + hstep + kstep);
    PG8_WAIT_V(6); PG8_BAR;
    for (;;) {
        const bool has_next = S.next(ui + 1, nxt);
        if (has_next) { PG8_AOFF(nxt, n00, n01, n10, n11); } else { n00 = c00; n01 = c01; n10 = c10; n11 = c11; }
        const char* nB = has_next ? Bb + (size_t)nxt.bt * tstep : cB;
        for (int t = 0; t < nt; t += 2) {
            const bool last = (t == nt - 2);
            const unsigned kb1 = (unsigned)(t + 1) * kstep;
            const unsigned kb2 = last ? 0u : (unsigned)(t + 2) * kstep, kb3 = kb2 + kstep;
            const unsigned a00 = last ? n00 : c00, a01 = last ? n01 : c01, a10 = last ? n10 : c10, a11 = last ? n11 : c11;
            const char* b2 = last ? nB : cB + (size_t)(t + 2) * kstep; const char* b3 = b2 + kstep;
            PG8_LDB(B0, 0, 0); PG8_LDB(B1, 0, 1); PG8_SCHED; PG8_LDA(At, 0, 0); PG8_STAGE_A(PG8_SA(1, 1), kb1, c10, c11);
            PG8_WAIT_V(8); PG8_WAIT_L(0); PG8_BAR; PG8_MMA(0, 0, At, B0); PG8_MMA(0, 1, At, B1); PG8_BAR; PG8_SCHED;
            PG8_LDA(At, 0, 1); PG8_STAGE_B(PG8_SB(0, 0), b2); PG8_STAGE_B(PG8_SB(0, 1), b2 + hstep); PG8_STAGE_A(PG8_SA(0, 0), kb2, a00, a01);
            PG8_WAIT_V(8); PG8_WAIT_L(0); PG8_BAR; PG8_MMA(1, 0, At, B0); PG8_MMA(1, 1, At, B1); PG8_BAR; PG8_SCHED;
            PG8_LDB(B0, 1, 0); PG8_LDB(B1, 1, 1); PG8_SCHED; PG8_LDA(At, 1, 0); PG8_STAGE_A(PG8_SA(0, 1), kb2, a10, a11);
            PG8_WAIT_V(8); PG8_WAIT_L(0); PG8_BAR; PG8_MMA(0, 0, At, B0); PG8_MMA(0, 1, At, B1); PG8_BAR; PG8_SCHED;
            PG8_LDA(At, 1, 1); PG8_STAGE_B(PG8_SB(1, 0), b3); PG8_STAGE_B(PG8_SB(1, 1), b3 + hstep); PG8_STAGE_A(PG8_SA(1, 0), kb3, a00, a01);
            PG8_WAIT_V(8); PG8_WAIT_L(0); PG8_BAR; PG8_MMA(1, 0, At, B0); PG8_MMA(1, 1, At, B1); PG8_BAR; PG8_SCHED;
        }
        if constexpr (ALIGN_EPI) { if (wr == 0) PG8_BAR; }
        E(acc, cur, wr, wc, fr, fq);
        if (!has_next) break;
#pragma unroll
        for (int a = 0; a < 2; ++a)
#pragma unroll
            for (int b = 0; b < 2; ++b)
#pragma unroll
                for (int m = 0; m < 4; ++m)
#pragma unroll
                    for (int n = 0; n < 2; ++n) acc[a][b][m][n] = (f32x4){0.f, 0.f, 0.f, 0.f};
        cur = nxt; cB = nB; c00 = n00; c01 = n01; c10 = n10; c11 = n11; ++ui;
        if constexpr (ALIGN_EPI) { if (wr == 1) PG8_BAR; }
    }
    PG8_WAIT_V(0);
    if constexpr (!ALIGN_EPI) { if (wr == 0) PG8_BAR; }
    PG8_BAR;
#undef PG8_AOFF
#undef PG8_SA
#undef PG8_SB
#undef PG8_STAGE_A
#undef PG8_STAGE_B
#undef PG8_LDA
#undef PG8_LDB
#undef PG8_MMA
#undef PG8_WAIT_V
#undef PG8_WAIT_L
#undef PG8_BAR
#undef PG8_SCHED
}
}
#ifndef DUPMASK
#define DUPMASK 0u
#endif
#define NREP(k) (((DUPMASK >> (k)) & 1u) ? 2 : 1)
constexpr int NB = 8, NT_ = 4096, DM = 1024, NTOK = NB * NT_;
constexpr int GW = 512;
constexpr int P0W = 4096, P1W = 3840;
constexpr int NEXP = 128, EFF = 256, NSLOT = NTOK * 8, NSLOT_ALL = NSLOT + NTOK;
constexpr float EPS = 1e-6f;
constexpr int NWAVES = 8;

constexpr size_t MiB = 1u << 20;
constexpr size_t WS_CTL = 0, CTL_ZERO_BYTES = 1 * MiB;
constexpr size_t WS_TAB = 1 * MiB;
constexpr size_t WS_MOD = WS_TAB + 256 * 1024;
constexpr size_t WS_OML = WS_MOD + 2 * 8 * 6144 * 4;
constexpr size_t WS_WIN0 = 2 * MiB, WS_WIN1 = 10 * MiB, WS_WOUT0 = 18 * MiB, WS_WOUT1 = 20 * MiB, WS_ROUT0 = 22 * MiB, WS_ROUT1 = 23 * MiB;
constexpr size_t WS_GU = 24 * MiB;
constexpr size_t WS_DN = 153 * MiB;
constexpr size_t WS_H2A = 218 * MiB;
constexpr size_t WS_PROJ = 282 * MiB;
constexpr size_t WS_CAT = 538 * MiB;
constexpr size_t WS_OF = 602 * MiB, WS_OB = 666 * MiB;
constexpr size_t WS_QKC = 730 * MiB;
constexpr size_t WS_Y = 218 * MiB;
constexpr size_t WS_HB = 794 * MiB;
constexpr size_t WS_H2B = 794 * MiB;
constexpr size_t WS_LOG = 938 * MiB;
constexpr size_t WS_TOPI = 970 * MiB, WS_TOPW = 971 * MiB, WS_RANK = 972 * MiB, WS_SLOT = 973 * MiB, WS_LIST = 974 * MiB;
constexpr size_t WS_END = 976 * MiB;
constexpr int CW_TMO = 0, CW_BAR = 16384  , CW_Q0 = 8192  , CW_CNT0 = 9216  , CW_CNT1 = 9472;

constexpr int RING_BYTES = 131072;
constexpr int LDSCTL_OFF = RING_BYTES, MISC_OFF = LDSCTL_OFF + 320;
constexpr int LDS_BYTES = 147456;
constexpr int TBL_OFF = MISC_OFF + 128;

#define GAS __attribute__((address_space(1)))
#define LAS __attribute__((address_space(3)))
typedef unsigned short bf16;
typedef unsigned v4u __attribute__((ext_vector_type(4)));
typedef float f32x4 __attribute__((ext_vector_type(4)));
typedef short bf16x8 __attribute__((ext_vector_type(8)));
typedef GAS unsigned gu32;
typedef GAS unsigned long long gu64;
#define RLX_AGENT __ATOMIC_RELAXED, __HIP_MEMORY_SCOPE_AGENT
#define LDS_WAIT() asm volatile("s_waitcnt lgkmcnt(0)" ::: "memory")
#define VM_WAIT() asm volatile("s_waitcnt vmcnt(0)" ::: "memory")
__device__ __forceinline__ unsigned long long rt() { return __builtin_amdgcn_s_memrealtime(); }
__device__ __forceinline__ unsigned f2bf(float f) { unsigned u = __builtin_bit_cast(unsigned, f); return (u + 0x7fffu + ((u >> 16) & 1u)) >> 16; }
__device__ __forceinline__ unsigned pk2(float lo, float hi) { return f2bf(lo) | (f2bf(hi) << 16); }
#define XB_TMO      128
#define XB_XCNT(j)  (256  + 64 * (j))
#define XB_XSUB(j)  (1280 + 64 * (j))
#define XB_XGEN(j)  (2304 + 64 * (j))
#define XB_TOP      3328
#define XB_TOPGEN   3392
#define XCD_BAR_WORDS 3456
#define XB_SPIN_CAP (1u << 18)

__device__ __forceinline__ unsigned xb_ld(unsigned* p)              { return __hip_atomic_load(p, __ATOMIC_RELAXED, __HIP_MEMORY_SCOPE_AGENT); }
__device__ __forceinline__ unsigned xb_add(unsigned* p, unsigned v) { return __hip_atomic_fetch_add(p, v, __ATOMIC_RELAXED, __HIP_MEMORY_SCOPE_AGENT); }
__device__ __forceinline__ unsigned xb_xcc_id() { return (unsigned)__builtin_amdgcn_s_getreg((3 << 11) | 20) & 0xFu; }
#define XB_SPIN(cond, bar) do { unsigned _sp = 0; while (cond) { __builtin_amdgcn_s_sleep(1); \
    if ((++_sp & 255u) == 0u) { if (xb_ld(&(bar)[XB_TMO])) break; if (_sp > XB_SPIN_CAP) { atomicAdd(&(bar)[XB_TMO], 1u); break; } } } } while (0)

struct XcdBarrier {
    unsigned* bar; unsigned x;
    volatile LAS unsigned* st;
};

__device__ __forceinline__ XcdBarrier xcd_barrier_post(unsigned* bar, volatile LAS unsigned* st) {
    XcdBarrier b; b.bar = bar; b.x = xb_xcc_id(); b.st = st;
    if (threadIdx.x == 0) (void)xb_add(&bar[XB_XCNT(b.x)], 1u);
    return b;
}
__device__ __forceinline__ void xcd_barrier_complete(unsigned* bar, unsigned x, unsigned& nloc, unsigned& nx) {
    const unsigned G = gridDim.x * gridDim.y * gridDim.z;
    unsigned sum, cnt, mine, sp = 0u;
    for (;;) {
        sum = 0u; cnt = 0u; mine = 0u;
#pragma unroll
        for (unsigned j = 0; j < 16; ++j) { const unsigned c = xb_ld(&bar[XB_XCNT(j)]); sum += c; cnt += (c > 0u) ? 1u : 0u; mine = (j == x) ? c : mine; }
        if (sum == G) break;
        __builtin_amdgcn_s_sleep(1);
        if ((++sp & 255u) == 0u) { if (xb_ld(&bar[XB_TMO])) break; if (sp > XB_SPIN_CAP) { atomicAdd(&bar[XB_TMO], 1u); break; } }
    }
    nloc = mine > 0u ? mine : 1u; nx = cnt > 0u ? cnt : 1u;
}

__device__ __forceinline__ void xcd_barrier(const XcdBarrier& b) {
    asm volatile("s_waitcnt vmcnt(0)" ::: "memory");
    __syncthreads();
    if (threadIdx.x == 0) {
        unsigned* bar = b.bar;
        __builtin_amdgcn_s_waitcnt(0);
        unsigned nloc = b.st[0], nx = b.st[1];
        if (nloc == 0u) { xcd_barrier_complete(bar, b.x, nloc, nx); b.st[0] = nloc; b.st[1] = nx; }
        const unsigned old = xb_add(&bar[XB_XSUB(b.x)], 1u);
        const unsigned gen = old / nloc;
        if (old + 1u == (gen + 1u) * nloc) {
            __builtin_amdgcn_fence(__ATOMIC_RELEASE, "agent");
            asm volatile("s_waitcnt vmcnt(0)" ::: "memory");
            const unsigned og = xb_add(&bar[XB_TOP], 1u);
            const unsigned tg = og / nx;
            if (og + 1u == (tg + 1u) * nx) xb_add(&bar[XB_TOPGEN], 1u);
            else XB_SPIN(xb_ld(&bar[XB_TOPGEN]) == tg, bar);
            __builtin_amdgcn_fence(__ATOMIC_ACQUIRE, "agent");
            xb_add(&bar[XB_XGEN(b.x)], 1u);
            asm volatile("s_waitcnt vmcnt(0)" ::: "memory");
        } else {
            XB_SPIN(xb_ld(&bar[XB_XGEN(b.x)]) == gen, bar);
            __builtin_amdgcn_fence(__ATOMIC_ACQUIRE, "agent");
            asm volatile("s_waitcnt vmcnt(0)" ::: "memory");
        }
    }
    __syncthreads();
}
typedef float f32x2 __attribute__((ext_vector_type(2)));
typedef unsigned u32x2 __attribute__((ext_vector_type(2)));
__device__ __forceinline__ float bflo(unsigned w) { return __builtin_bit_cast(float, w << 16); }
__device__ __forceinline__ float bfhi(unsigned w) { return __builtin_bit_cast(float, w & 0xffff0000u); }
__device__ __forceinline__ float bf2f(bf16 b) { return __builtin_bit_cast(float, (unsigned)b << 16); }
__device__ __forceinline__ float wave_sum(float v) {
#pragma unroll
    for (int o = 1; o < 64; o <<= 1) v += __shfl_xor(v, o);
    return v;
}
__device__ __forceinline__ float sigm(float x) { return __builtin_amdgcn_rcpf(1.f + __expf(-x)); }
__device__ __forceinline__ float sigm_div(float x) { return 1.f / (1.f + __expf(-x)); }
__device__ __forceinline__ float silu(float x) { return x * __builtin_amdgcn_rcpf(1.f + __expf(-x)); }
__device__ __forceinline__ void unpack8(v4u w, float (&f)[8]) { f[0] = bflo(w.x); f[1] = bfhi(w.x); f[2] = bflo(w.y); f[3] = bfhi(w.y); f[4] = bflo(w.z); f[5] = bfhi(w.z); f[6] = bflo(w.w); f[7] = bfhi(w.w); }
__device__ __forceinline__ v4u pack8(const float (&f)[8]) { v4u w; w.x = pk2(f[0], f[1]); w.y = pk2(f[2], f[3]); w.z = pk2(f[4], f[5]); w.w = pk2(f[6], f[7]); return w; }

__device__ __forceinline__ void tr_item(const float* W, int ldw, int k0, int c0, int cvalid, bf16* WT, int ldt, int r0, LAS float* scr, int lane) {
    float wv[32];
#pragma unroll
    for (int i = 0; i < 32; ++i) { const int kk = 2 * i + (lane >> 5), n = lane & 31; wv[i] = (n < cvalid) ? W[(size_t)(k0 + kk) * ldw + c0 + n] : 0.f; }
#pragma unroll
    for (int i = 0; i < 32; ++i) { const int kk = 2 * i + (lane >> 5), n = lane & 31; scr[kk * 33 + n] = wv[i]; }
    LDS_WAIT(); asm volatile("" ::: "memory");
    const int c = lane & 7;
#pragma unroll
    for (int j = 0; j < 4; ++j) { const int n = (lane >> 3) + 8 * j; const LAS float* s = scr + (8 * c) * 33 + n;
        v4u o; o.x = pk2(s[0 * 33], s[1 * 33]); o.y = pk2(s[2 * 33], s[3 * 33]); o.z = pk2(s[4 * 33], s[5 * 33]); o.w = pk2(s[6 * 33], s[7 * 33]);
        *(v4u*)(WT + (size_t)(r0 + n) * ldt + k0 + 8 * c) = o; }
    LDS_WAIT(); asm volatile("" ::: "memory");
}
__device__ __forceinline__ void expert_item(const float* gate, const float* up, const float* down, const float* sgate, const float* sup, const float* sdown,
                                            bf16* GU, bf16* DN, int it, LAS float* scr, int lane) {
    const int e = it / 384, r = it - e * 384;
    const bool sh = (e == NEXP);
    if (r < 256) {
        const bool isup = r >= 128; const int rr = r & 127, sub = rr >> 6, q = rr & 63, kb = q >> 2, nb = q & 3;
        const float* W = sh ? (isup ? sup : sgate) : ((isup ? up : gate) + (size_t)e * (DM * EFF));
        tr_item(W, EFF, kb * 64, sub * 128 + nb * 32, 32, GU + (size_t)e * (512 * DM), DM, 256 * sub + (isup ? 128 : 0) + nb * 32, scr, lane);
    } else {
        const int rr = r - 256, kb = rr >> 5, nb = rr & 31;
        const float* W = sh ? sdown : down + (size_t)e * (EFF * DM);
        tr_item(W, DM, kb * 64, nb * 32, 32, DN + (size_t)e * (DM * EFF), EFF, nb * 32, scr, lane);
    }
}
#define TR_JOB(W_, ldw_, K_, c0_, ncols_, WT_, r0_) do { const int _nb = ((ncols_) + 31) / 32, _ni = ((K_) / 64) * _nb; \
        for (int _it = (gw + NGW - (jbase % NGW)) % NGW; _it < _ni; _it += NGW) { const int _kb = _it / _nb, _nk = _it % _nb; const int _cv = (ncols_) - _nk * 32; \
            tr_item(W_, ldw_, _kb * 64, (c0_) + _nk * 32, _cv < 32 ? _cv : 32, WT_, K_, (r0_) + _nk * 32, scr, lane); } jbase += _ni; } while (0)

__device__ __forceinline__ void mod_unit(int u, const float* c, const float* wm0, const float* bm0, const float* wm1, const float* bm1, float* MOD, LAS unsigned char* lds, int tid, int wave, int lane) {
    LAS float* sc = (LAS float*)(lds + 69632);
    LAS float* red = (LAS float*)(lds + 69632 + 32768);
    const int l = u / 96, cb = u % 96; const float* wm = l ? wm1 : wm0; const float* bm = l ? bm1 : bm0;
    for (int i = tid; i < NB * DM; i += 512) sc[i] = silu(c[i]);
    __syncthreads();
    float acc[8];
#pragma unroll
    for (int b = 0; b < 8; ++b) acc[b] = 0.f;
    const float* wp = wm + (size_t)(wave * 128) * 6144 + cb * 64 + lane;
    for (int k0 = 0; k0 < 128; k0 += 32) {
        float w[32];
#pragma unroll
        for (int j = 0; j < 32; ++j) w[j] = wp[(size_t)(k0 + j) * 6144];
#pragma unroll
        for (int j = 0; j < 32; ++j)
#pragma unroll
            for (int b = 0; b < 8; ++b) acc[b] += sc[b * DM + wave * 128 + k0 + j] * w[j];
    }
#pragma unroll
    for (int b = 0; b < 8; ++b) red[(wave * 8 + b) * 64 + lane] = acc[b];
    __syncthreads();
    { const int b = tid >> 6; float s = 0.f;
#pragma unroll
      for (int w = 0; w < 8; ++w) s += red[(w * 8 + b) * 64 + lane];
      MOD[(size_t)(l * 8 + b) * 6144 + cb * 64 + lane] = s + bm[cb * 64 + lane]; }
    __syncthreads();
}

__device__ __forceinline__ void normmod_row(const f32x4 (&v)[4], const float* gain, const float* shift, const float* scale, bf16* orow, int lane) {
    float ss = 0.f;
#pragma unroll
    for (int j = 0; j < 4; ++j) ss += (v[j].x * v[j].x + v[j].y * v[j].y) + (v[j].z * v[j].z + v[j].w * v[j].w);
    const float r = 1.f / sqrtf(wave_sum(ss) * (1.f / DM) + EPS);
    unsigned long long* o8 = (unsigned long long*)orow + lane;
#pragma unroll
    for (int j = 0; j < 4; ++j) { const f32x4 g = ((const f32x4*)gain)[lane + 64 * j], sh = ((const f32x4*)shift)[lane + 64 * j], sc = ((const f32x4*)scale)[lane + 64 * j];
        const f32x4 y = v[j] * r * g * (sc + 1.f) + sh;
        o8[64 * j] = (unsigned long long)pk2(y.x, y.y) | ((unsigned long long)pk2(y.z, y.w) << 32); }
}
__device__ __forceinline__ void normmod_phase(const float* X, const float* gain, const float* modl  , int sh_off, int sc_off, bf16* H, int gw, int NGW, int lane) {
    for (int m0 = gw; m0 < NTOK; m0 += 4 * NGW) {
        f32x4 v[4][4];
#pragma unroll
        for (int q = 0; q < 4; ++q) { const int m = m0 + q * NGW; const f32x4* xr = (const f32x4*)(X + (size_t)(m < NTOK ? m : m0) * DM) + lane;
#pragma unroll
            for (int j = 0; j < 4; ++j) v[q][j] = xr[64 * j]; }
#pragma unroll
        for (int q = 0; q < 4; ++q) { const int m = m0 + q * NGW; if (m >= NTOK) break;
            const float* mb = modl + (size_t)(m >> 12) * 6144;
            normmod_row(v[q], gain, mb + sh_off, mb + sc_off, H + (size_t)m * DM, lane); }
    }
}
__device__ __forceinline__ void finalnorm_row(const f32x4 (&v)[4], const float* gain, float* orow, int lane) {
    float ss = 0.f;
#pragma unroll
    for (int j = 0; j < 4; ++j) ss += (v[j].x * v[j].x + v[j].y * v[j].y) + (v[j].z * v[j].z + v[j].w * v[j].w);
    const float r = 1.f / sqrtf(wave_sum(ss) * (1.f / DM) + EPS);
#pragma unroll
    for (int j = 0; j < 4; ++j) ((f32x4*)orow)[lane + 64 * j] = v[j] * r * ((const f32x4*)gain)[lane + 64 * j];
}

__device__ __forceinline__ void rope_phase(bf16* P, const float* tab, int gtid, int NGT) {
    for (int idx = gtid; idx < NTOK * 16; idx += NGT) {
        const int tok = idx >> 4, grp = idx & 15, t = tok & (NT_ - 1);
        bf16* p = P + (size_t)tok * P0W + (grp < 8 ? 2560 : 3072) + (grp & 7) * 64;
        const v4u a = *(const v4u*)p, b = *(const v4u*)(p + 8);
        float x1[8], x2[8], cs[8], sn[8], y1[8], y2[8];
        unpack8(a, x1); unpack8(b, x2);
        const f32x4* tp = (const f32x4*)(tab + (size_t)t * 16);
        const f32x4 c0 = tp[0], c1 = tp[1], s0 = tp[2], s1 = tp[3];
        cs[0] = c0.x; cs[1] = c0.y; cs[2] = c0.z; cs[3] = c0.w; cs[4] = c1.x; cs[5] = c1.y; cs[6] = c1.z; cs[7] = c1.w;
        sn[0] = s0.x; sn[1] = s0.y; sn[2] = s0.z; sn[3] = s0.w; sn[4] = s1.x; sn[5] = s1.y; sn[6] = s1.z; sn[7] = s1.w;
#pragma unroll
        for (int i = 0; i < 8; ++i) { y1[i] = x1[i] * cs[i] - x2[i] * sn[i]; y2[i] = x2[i] * cs[i] + x1[i] * sn[i]; }
        *(v4u*)p = pack8(y1); *(v4u*)(p + 8) = pack8(y2);
    }
}

template <int ACT  >
__device__ __forceinline__ void gateout_phase(const float* OF, const float* OB, const float* gain, const bf16* P, int pitch, int gcol, bf16* CAT, int gw, int NGW, int lane) {
    const int hh = lane >> 4, e0 = (lane & 15) * 8;
    const f32x4 g0 = *(const f32x4*)(gain + e0), g1 = *(const f32x4*)(gain + e0 + 4);
    for (int m = gw; m < NTOK; m += NGW) {
        const float* pf = OF + (size_t)m * GW + hh * 128 + e0; const float* pb = OB + (size_t)m * GW + hh * 128 + e0;
        const f32x4 a0 = *(const f32x4*)pf + *(const f32x4*)pb, a1 = *(const f32x4*)(pf + 4) + *(const f32x4*)(pb + 4);
        float ss = (a0.x * a0.x + a0.y * a0.y) + (a0.z * a0.z + a0.w * a0.w) + (a1.x * a1.x + a1.y * a1.y) + (a1.z * a1.z + a1.w * a1.w);
        ss += __shfl_xor(ss, 1); ss += __shfl_xor(ss, 2); ss += __shfl_xor(ss, 4); ss += __shfl_xor(ss, 8);
        const float r = 1.f / sqrtf(ss * (1.f / 128.f) + EPS);
        float gv[8]; unpack8(*(const v4u*)(P + (size_t)m * pitch + gcol + hh * 128 + e0), gv);
        float y[8];
        const f32x4 n0 = a0 * r * g0, n1 = a1 * r * g1;
        y[0] = n0.x; y[1] = n0.y; y[2] = n0.z; y[3] = n0.w; y[4] = n1.x; y[5] = n1.y; y[6] = n1.z; y[7] = n1.w;
#pragma unroll
        for (int i = 0; i < 8; ++i) y[i] *= (ACT == 0) ? silu(gv[i]) : ((ACT == 1) ? sigm(gv[i]) : gv[i]);
        *(v4u*)(CAT + (size_t)m * DM + hh * 128 + e0) = pack8(y);
    }
}

struct EpiStoreBf16 {
    static constexpr bool PERM = true;
    bf16* O; int ldc;
    __device__ __forceinline__ void operator()(const pg8::f32x4 (&acc)[2][2][4][2], const pg8::Unit& u, int wr, int wc, int fr, int fq) const {
        const int row0 = u.arow0 + wr * 64 + fr, col0 = u.pn * 256 + wc * 32 + 8 * fq;
#pragma unroll
        for (int ai = 0; ai < 2; ++ai)
#pragma unroll
            for (int m = 0; m < 4; ++m) { bf16* rowp = O + (size_t)(row0 + ai * 128 + m * 16) * ldc + col0;
#pragma unroll
                for (int bj = 0; bj < 2; ++bj) { const pg8::f32x4 v0 = acc[ai][bj][m][0], v1 = acc[ai][bj][m][1];
                    v4u w; w.x = pg8::cvt_pk_bf16(v0[0], v0[1]); w.y = pg8::cvt_pk_bf16(v0[2], v0[3]); w.z = pg8::cvt_pk_bf16(v1[0], v1[1]); w.w = pg8::cvt_pk_bf16(v1[2], v1[3]);
                    *(v4u*)(rowp + bj * 128) = w; } }
    }
};
struct EpiProj0 {
    static constexpr bool PERM = true;
    bf16* O; const float* oml; const float* tab;
    __device__ __forceinline__ void operator()(const pg8::f32x4 (&acc)[2][2][4][2], const pg8::Unit& u, int wr, int wc, int fr, int fq) const {
        const int row0 = u.arow0 + wr * 64 + fr, colt = wc * 32 + 8 * fq, col0 = u.pn * 256 + colt;
        const int kind = (u.pn < 2 || u.pn == 8 || u.pn == 9) ? 1 : ((u.pn >= 4 && u.pn < 8) ? 2 : ((u.pn >= 10 && u.pn < 14) ? 3 : 0));
        const bool ropew = (kind == 3) && ((wc & 1) == 0);
#pragma unroll
        for (int ai = 0; ai < 2; ++ai)
#pragma unroll
            for (int m = 0; m < 4; ++m) { const int row = row0 + ai * 128 + m * 16; bf16* rowp = O + (size_t)row * P0W + col0;
                pg8::f32x4 cs0 = {0.f, 0.f, 0.f, 0.f}, cs1 = cs0, sn0 = cs0, sn1 = cs0;
                if (ropew) { const pg8::f32x4* tp = (const pg8::f32x4*)(tab + (size_t)(row & (NT_ - 1)) * 16); cs0 = tp[0]; cs1 = tp[1]; sn0 = tp[2]; sn1 = tp[3]; if (fq == 0) { sn0 = -sn0; sn1 = -sn1; } }
#pragma unroll
                for (int bj = 0; bj < 2; ++bj) { pg8::f32x4 v0 = acc[ai][bj][m][0], v1 = acc[ai][bj][m][1];
                    if (kind == 1) {
#pragma unroll
                        for (int j = 0; j < 4; ++j) { v0[j] = silu(v0[j]); v1[j] = silu(v1[j]); } }
                    else if (kind == 2) { const float* op = oml + (u.pn - 4) * 256 + bj * 128 + colt; const pg8::f32x4 o0 = *(const pg8::f32x4*)op, o1 = *(const pg8::f32x4*)(op + 4);
#pragma unroll
                        for (int j = 0; j < 4; ++j) { v0[j] = o0[j] * sigm(-v0[j]); v1[j] = o1[j] * sigm(-v1[j]); } }
                    else if (ropew) { pg8::f32x4 p0, p1;
#pragma unroll
                        for (int j = 0; j < 4; ++j) { p0[j] = __shfl_xor(v0[j], 16); p1[j] = __shfl_xor(v1[j], 16); }
                        if (fq < 2) { v0 = v0 * cs0 + p0 * sn0; v1 = v1 * cs1 + p1 * sn1; } }
                    v4u w; w.x = pg8::cvt_pk_bf16(v0[0], v0[1]); w.y = pg8::cvt_pk_bf16(v0[2], v0[3]); w.z = pg8::cvt_pk_bf16(v1[0], v1[1]); w.w = pg8::cvt_pk_bf16(v1[2], v1[3]);
                    *(v4u*)(rowp + bj * 128) = w; } }
    }
};
struct EpiResid {
    static constexpr bool PERM = false;
    const float* xin; float* out; const float* gm;
    __device__ __forceinline__ void operator()(const pg8::f32x4 (&acc)[2][2][4][2], const pg8::Unit& u, int wr, int wc, int fr, int fq) const {
        const int row0 = u.arow0 + wr * 64 + fr, col0 = u.pn * 256 + wc * 32 + 4 * fq;
#pragma unroll
        for (int ai = 0; ai < 2; ++ai)
#pragma unroll
            for (int m = 0; m < 4; ++m) { const int row = row0 + ai * 128 + m * 16; const float* gp = gm + (size_t)(row >> 12) * 6144 + col0; const size_t ro = (size_t)row * DM + col0;
#pragma unroll
                for (int bj = 0; bj < 2; ++bj)
#pragma unroll
                    for (int n = 0; n < 2; ++n) { const int c = bj * 128 + n * 16;
                        const pg8::f32x4 x4 = *(const pg8::f32x4*)(xin + ro + c), g4 = *(const pg8::f32x4*)(gp + c);
                        *(pg8::f32x4*)(out + ro + c) = x4 + g4 * acc[ai][bj][m][n]; } }
    }
};
struct EpiF32 {
    static constexpr bool PERM = false;
    float* C; int ldc;
    __device__ __forceinline__ void operator()(const pg8::f32x4 (&acc)[2][2][4][2], const pg8::Unit& u, int wr, int wc, int fr, int fq) const {
        const int row0 = u.arow0 + wr * 64 + fr, col0 = u.pn * 256 + wc * 32 + 4 * fq;
#pragma unroll
        for (int ai = 0; ai < 2; ++ai)
#pragma unroll
            for (int m = 0; m < 4; ++m) { float* rowp = C + (size_t)(row0 + ai * 128 + m * 16) * ldc + col0;
#pragma unroll
                for (int bj = 0; bj < 2; ++bj)
#pragma unroll
                    for (int n = 0; n < 2; ++n) *(pg8::f32x4*)(rowp + bj * 128 + n * 16) = acc[ai][bj][m][n]; }
    }
};
struct EpiGateUp {
    static constexpr bool PERM = true;
    bf16* HB;
    __device__ __forceinline__ void operator()(const pg8::f32x4 (&acc)[2][2][4][2], const pg8::Unit& u, int wr, int wc, int fr, int fq) const {
        const int col0 = u.pn * 128 + wc * 32 + 8 * fq;
#pragma unroll
        for (int ai = 0; ai < 2; ++ai)
#pragma unroll
            for (int m = 0; m < 4; ++m) { const int rl = ai * 128 + wr * 64 + m * 16 + fr;
                float y[8];
#pragma unroll
                for (int n = 0; n < 2; ++n)
#pragma unroll
                    for (int j = 0; j < 4; ++j) y[4 * n + j] = silu(acc[ai][0][m][n][j]) * acc[ai][1][m][n][j];
                if (rl < u.nvalid) *(v4u*)(HB + (size_t)(u.arow0 + rl) * EFF + col0) = pack8(y); }
    }
};
struct EpiDown {
    static constexpr bool PERM = true;
    unsigned char* Y;
    __device__ __forceinline__ void operator()(const pg8::f32x4 (&acc)[2][2][4][2], const pg8::Unit& u, int wr, int wc, int fr, int fq) const {
        const int col0 = u.pn * 256 + wc * 32 + 8 * fq;
#pragma unroll
        for (int ai = 0; ai < 2; ++ai)
#pragma unroll
            for (int m = 0; m < 4; ++m) { const int rl = ai * 128 + wr * 64 + m * 16 + fr; unsigned char* rowp = Y + (size_t)(u.arow0 + rl) * DM + col0;
#pragma unroll
                for (int bj = 0; bj < 2; ++bj) { const pg8::f32x4 v0 = acc[ai][bj][m][0] * 8.f, v1 = acc[ai][bj][m][1] * 8.f;
                    u32x2 w; w.x = 0u; w.y = 0u;
                    w.x = __builtin_amdgcn_cvt_pk_fp8_f32(v0[0], v0[1], w.x, false); w.x = __builtin_amdgcn_cvt_pk_fp8_f32(v0[2], v0[3], w.x, true);
                    w.y = __builtin_amdgcn_cvt_pk_fp8_f32(v1[0], v1[1], w.y, false); w.y = __builtin_amdgcn_cvt_pk_fp8_f32(v1[2], v1[3], w.y, true);
                    if (rl < u.nvalid) *(u32x2*)(rowp + bj * 128) = w; } }
    }
};

__device__ __forceinline__ void moe_tables(const unsigned* cntg, LAS int* tb, int tid) {
    LAS int* cnt = tb; LAS int* start = tb + 130; LAS int* tpre = tb + 260;
    __syncthreads();
    if (tid < NEXP) cnt[tid] = (int)__hip_atomic_load(cntg + tid, __ATOMIC_RELAXED, __HIP_MEMORY_SCOPE_AGENT);
    if (tid == NEXP) cnt[NEXP] = NTOK;
    __syncthreads();
    if (tid == 0) { int s = 0, t = 0; for (int e = 0; e < NEXP; ++e) { start[e] = s; tpre[e] = t; s += cnt[e]; t += (cnt[e] + 255) >> 8; }
        start[NEXP] = NSLOT; tpre[NEXP] = t; t += NTOK / 256; start[NEXP + 1] = NSLOT_ALL; tpre[NEXP + 1] = t; }
    __syncthreads();
}
struct GroupOrder {
    const LAS int* cnt; const LAS int* start; const LAS int* tpre; const int* list; int ntc, total, G, c;
    __device__ __forceinline__ void init(const LAS int* tb, const int* list_, int ntc_, int G_, int c_) { cnt = tb; start = tb + 130; tpre = tb + 260; list = list_; ntc = ntc_; total = tpre[NEXP + 1] * ntc_; G = G_; c = c_; }
    __device__ __forceinline__ bool next(int i, pg8::Unit& u) const {
        const int L = i * G + c; if (L >= total) return false;
        const int rt = L / ntc, pn = L - rt * ntc;
        int lo = 0, hi = NEXP + 1;
#pragma unroll 1
        while (hi - lo > 1) { const int mid = (lo + hi) >> 1; if (tpre[mid] <= rt) lo = mid; else hi = mid; }
        const int j = rt - tpre[lo], rem = cnt[lo] - 256 * j;
        u.pn = pn; u.arow0 = start[lo] + 256 * j; u.nvalid = rem < 256 ? rem : 256; u.bt = lo * ntc + pn; return true;
    }
    __device__ __forceinline__ int arow(const pg8::Unit& u, int r) const { const int idx = u.arow0 + (r < u.nvalid ? r : u.nvalid - 1); return list ? list[idx] : idx; }
};

__device__ __forceinline__ void topk_phase(const float* LOG, const float* rbias, int* TOPI, float* TOPW, int* RANK, unsigned* cntg, LAS unsigned char* lds, int bx, int G, int wave, int tid) {
    const int lane = tid & 63;
    LAS unsigned* hist = (LAS unsigned*)lds; LAS unsigned* base = hist + 128; LAS unsigned short* le = (LAS unsigned short*)(lds + 1024); LAS unsigned short* lr = le + 1024;
    const f32x2 bias = *(const f32x2*)(rbias + 2 * lane);
    for (int blk = bx; blk < NTOK / 128; blk += G) {
        __syncthreads();
        if (tid < 128) hist[tid] = 0u;
        __syncthreads();
#pragma unroll 1
        for (int ti = 0; ti < 16; ++ti) {
            const int tl = wave * 16 + ti, tok = blk * 128 + tl;
            const f32x2 lg = *(const f32x2*)(LOG + (size_t)tok * 256 + 2 * lane);
            const float s0 = sigm_div(lg.x), s1 = sigm_div(lg.y);
            float v0 = s0 + bias.x, v1 = s1 + bias.y;
            float m1 = fmaxf(v0, v1), m2 = fminf(v0, v1);
#pragma unroll
            for (int off = 1; off < 8; off <<= 1) { const float o1 = __shfl_xor(m1, off), o2 = __shfl_xor(m2, off); const float n1 = fmaxf(m1, o1), n2 = fmaxf(fminf(m1, o1), fmaxf(m2, o2)); m1 = n1; m2 = n2; }
            const float gs = m1 + m2; const int myg = lane >> 3; int better = 0;
#pragma unroll
            for (int g = 0; g < 8; ++g) { const float sg = __shfl(gs, g * 8); better += (sg > gs || (sg == gs && g < myg)) ? 1 : 0; }
            if (better >= 4) { v0 = -INFINITY; v1 = -INFINITY; }
            int my_e = 0; float my_s = 0.f, ssum = 0.f;
#pragma unroll
            for (int k = 0; k < 8; ++k) {
                float bv = (v0 >= v1) ? v0 : v1; int bi = (v0 >= v1) ? 2 * lane : 2 * lane + 1;
#pragma unroll
                for (int off = 32; off >= 1; off >>= 1) { const float ov = __shfl_xor(bv, off); const int oi = __shfl_xor(bi, off); if (ov > bv || (ov == bv && oi < bi)) { bv = ov; bi = oi; } }
                const float ws = __shfl((bi & 1) ? s1 : s0, bi >> 1);
                if (lane == (bi >> 1)) { if (bi & 1) v1 = -INFINITY; else v0 = -INFINITY; }
                if (lane == k) { my_e = bi; my_s = ws; }
                ssum += ws;
            }
            if (lane < 8) {
                const unsigned rk = __hip_atomic_fetch_add(hist + my_e, 1u, __ATOMIC_RELAXED, __HIP_MEMORY_SCOPE_WORKGROUP);
                TOPI[tok * 8 + lane] = my_e; TOPW[tok * 8 + lane] = my_s / ssum * 2.5f; le[tl * 8 + lane] = (unsigned short)my_e; lr[tl * 8 + lane] = (unsigned short)rk;
            }
        }
        __syncthreads();
        if (tid < 128) base[tid] = __hip_atomic_fetch_add(cntg + tid, hist[tid], __ATOMIC_RELAXED, __HIP_MEMORY_SCOPE_AGENT);
        __syncthreads();
        for (int i = tid; i < 1024; i += 512) RANK[blk * 1024 + i] = (int)(base[le[i]] + lr[i]);
    }
}
__device__ __forceinline__ void list_phase(const int* TOPI, const int* RANK, int* SLOT, int* LIST, const LAS int* tb, int gtid, int NGT) {
    const LAS int* start = tb + 130;
    for (int p = gtid; p < NSLOT; p += NGT) { const int s = start[TOPI[p]] + RANK[p]; SLOT[p] = s; LIST[s] = p >> 3; }
    for (int i = gtid; i < NTOK; i += NGT) LIST[NSLOT + i] = i;
}
__device__ __forceinline__ void combine_phase(float* X, const unsigned char* Y, const int* SLOT, const float* TOPW, const float* modl, int g_off,
                                              const float* ngain, const float* modn, int sh_off, int sc_off, bf16* H, const float* fgain, int gw, int NGW, int lane) {
    for (int m0 = gw; m0 < NTOK; m0 += 2 * NGW) {
        const int mm[2] = {m0, m0 + NGW}; const bool has2 = (m0 + NGW) < NTOK;
        int sl[2]; float wl[2];
#pragma unroll
        for (int q = 0; q < 2; ++q) { const int m = (q == 0 || has2) ? mm[q] : m0; sl[q] = (lane < 8) ? SLOT[m * 8 + lane] : NSLOT + m; wl[q] = (lane < 8) ? TOPW[m * 8 + lane] : 1.f; }
        f32x4 acc[2][4]; f32x4 xv[2][4];
#pragma unroll
        for (int q = 0; q < 2; ++q) { const int m = (q == 0 || has2) ? mm[q] : m0; const f32x4* xr = (const f32x4*)(X + (size_t)m * DM) + lane;
#pragma unroll
            for (int j = 0; j < 4; ++j) { acc[q][j] = (f32x4){0.f, 0.f, 0.f, 0.f}; xv[q][j] = xr[64 * j]; } }
#pragma unroll
        for (int k = 0; k < 9; ++k)
#pragma unroll
            for (int q = 0; q < 2; ++q) { const int s = __shfl(sl[q], k); const float w = __shfl(wl[q], k) * 0.125f;
                const unsigned* yr = (const unsigned*)(Y + (size_t)s * DM) + lane;
#pragma unroll
                for (int j = 0; j < 4; ++j) { const unsigned qv = yr[64 * j]; const f32x2 lo = __builtin_amdgcn_cvt_pk_f32_fp8(qv, false), hi = __builtin_amdgcn_cvt_pk_f32_fp8(qv, true);
                    acc[q][j] += (f32x4){lo.x, lo.y, hi.x, hi.y} * w; } }
#pragma unroll
        for (int q = 0; q < 2; ++q) { if (q == 1 && !has2) break; const int m = mm[q];
            f32x4* xr = (f32x4*)(X + (size_t)m * DM) + lane; const float* mb = modl + (size_t)(m >> 12) * 6144; f32x4 v[4];
#pragma unroll
            for (int j = 0; j < 4; ++j) v[j] = xv[q][j] + ((const f32x4*)(mb + g_off))[lane + 64 * j] * acc[q][j];
            if (fgain) finalnorm_row(v, fgain, X + (size_t)m * DM, lane);
            else {
#pragma unroll
                for (int j = 0; j < 4; ++j) xr[64 * j] = v[j];
                const float* mn = modn + (size_t)(m >> 12) * 6144;
                normmod_row(v, ngain, mn + sh_off, mn + sc_off, H + (size_t)m * DM, lane);
            } }
    }
}
__device__ __forceinline__ int q_pull(gu32* head, volatile LAS unsigned* slot, int tid) {
    __syncthreads();
    if (tid == 0) *slot = __hip_atomic_fetch_add(head, 1u, RLX_AGENT);
    __syncthreads();
    return (int)*slot;
}

__device__ __forceinline__ void convqk_phase(const bf16* P, const float* cw, const float* cb, bf16* QKC, int gtid, int NGT) {
    for (int idx = gtid; idx < NTOK * 128; idx += NGT) {
        const int tok = idx >> 7, c0 = (idx & 127) * 8, t = tok & (NT_ - 1);
        float acc[8];
#pragma unroll
        for (int i = 0; i < 8; ++i) acc[i] = cb[c0 + i];
#pragma unroll
        for (int j = 0; j < 5; ++j) { const int tj = t + j - 2;
            if (tj >= 0 && tj < NT_) { float x[8]; unpack8(*(const v4u*)(P + (size_t)(tok + j - 2) * P1W + c0), x);
#pragma unroll
                for (int i = 0; i < 8; ++i) acc[i] += cw[j * 1024 + c0 + i] * x[i]; } }
        const float sc = (c0 >= GW) ? 0.08838834764831845f : 1.f;
#pragma unroll
        for (int i = 0; i < 8; ++i) acc[i] = silu(acc[i]) * sc;
        *(v4u*)(QKC + (size_t)tok * DM + c0) = pack8(acc);
    }
}
namespace da {
using bf16x8 = __attribute__((ext_vector_type(8))) short;
using s16x4  = __attribute__((ext_vector_type(4))) short;
using f32x16 = __attribute__((ext_vector_type(16))) float;
constexpr float SCALE = 0.125f;
constexpr float THR = 8.f;
constexpr int KVBLK = 64, SHM_V = 16384, SHM_K = 16384;
#define DA_KSWZ(row, colB) ((row) * 256 + ((colB) ^ (((row) & 7) << 4)))
#define DA_SBAR() __builtin_amdgcn_sched_barrier(0)
#define DA_LBAR() do { asm volatile("s_waitcnt lgkmcnt(0)" ::: "memory"); __builtin_amdgcn_s_barrier(); asm volatile("" ::: "memory"); } while (0)
__device__ __forceinline__ int crow(int r, int hi) { return (r & 3) + 8 * (r >> 2) + 4 * hi; }
__device__ __forceinline__ unsigned cvtpk(float lo, float hi) { unsigned r; asm volatile("v_cvt_pk_bf16_f32 %0, %1, %2" : "=v"(r) : "v"(lo), "v"(hi)); return r; }
__device__ __forceinline__ void partialSM(f32x16& p0, f32x16& p1, float& m_reg, float& mn, float& alpha) {
  constexpr float C = SCALE * 1.4426950408889634f;
  float pmax = p0[0];
#pragma unroll
  for (int r = 1; r < 16; ++r) pmax = fmaxf(pmax, p0[r]);
#pragma unroll
  for (int r = 0; r < 16; ++r) pmax = fmaxf(pmax, p1[r]);
  { auto rr = __builtin_amdgcn_permlane32_swap(__float_as_uint(pmax), __float_as_uint(pmax), false, false);
    pmax = fmaxf(__uint_as_float(rr[0]), __uint_as_float(rr[1])); }
  if (__builtin_expect(__all(pmax - m_reg <= THR / SCALE), 1)) { mn = m_reg; alpha = 1.f; }
  else { mn = fmaxf(m_reg, pmax); alpha = __builtin_amdgcn_exp2f((m_reg - mn) * C); m_reg = mn; }
  float mnC = -mn * C;
#pragma unroll
  for (int r = 0; r < 16; ++r) p0[r] = fmaf(p0[r], C, mnC);
#pragma unroll
  for (int r = 0; r < 16; ++r) p1[r] = fmaf(p1[r], C, mnC);
#pragma unroll
  for (int r = 0; r < 16; ++r) p0[r] = __builtin_amdgcn_exp2f(p0[r]);
}
__device__ __forceinline__ void finishSM(f32x16& p0, f32x16& p1, float alpha, float& l_reg, bf16x8& pa0, bf16x8& pa1, bf16x8& pa2, bf16x8& pa3) {
#pragma unroll
  for (int r = 0; r < 16; ++r) p1[r] = __builtin_amdgcn_exp2f(p1[r]);
  float ps = 0;
#pragma unroll
  for (int r = 0; r < 16; ++r) ps += p0[r];
#pragma unroll
  for (int r = 0; r < 16; ++r) ps += p1[r];
  { auto rr = __builtin_amdgcn_permlane32_swap(__float_as_uint(ps), __float_as_uint(ps), false, false);
    ps = __uint_as_float(rr[0]) + __uint_as_float(rr[1]); }
  l_reg = l_reg * alpha + ps;
#define DA_PK4(P, BASE, OUT) do { unsigned a0 = cvtpk(P[BASE + 0], P[BASE + 1]), a1 = cvtpk(P[BASE + 2], P[BASE + 3]);   \
    unsigned b0 = cvtpk(P[BASE + 4], P[BASE + 5]), b1 = cvtpk(P[BASE + 6], P[BASE + 7]);                              \
    auto r0 = __builtin_amdgcn_permlane32_swap(a0, b0, false, false); auto r1 = __builtin_amdgcn_permlane32_swap(a1, b1, false, false); \
    v4u w = {r0[0], r1[0], r0[1], r1[1]}; OUT = __builtin_bit_cast(bf16x8, w); } while (0)
  DA_PK4(p0, 0, pa0); DA_PK4(p0, 8, pa1); DA_PK4(p1, 0, pa2); DA_PK4(p1, 8, pa3);
#undef DA_PK4
}
__device__ __forceinline__ void qkt(f32x16& p0, f32x16& p1, const LAS char* Ks, const bf16x8 (&qr)[4], int r32, int hi, int mapB) {
  p0 = f32x16{}; p1 = f32x16{};
#pragma unroll
  for (int d0 = 0; d0 < 4; ++d0) { const int cb = mapB + (d0 * 16 + hi * 8) * 2;
    const bf16x8 b0 = *(const LAS bf16x8*)(Ks + DA_KSWZ(r32, cb));
    const bf16x8 b1 = *(const LAS bf16x8*)(Ks + DA_KSWZ(32 + r32, cb));
    p0 = __builtin_amdgcn_mfma_f32_32x32x16_bf16(b0, qr[d0], p0, 0, 0, 0);
    p1 = __builtin_amdgcn_mfma_f32_32x32x16_bf16(b1, qr[d0], p1, 0, 0, 0); }
}
__device__ __forceinline__ int v_st(int k, int c) { const int kk = (k & ~0xC) | ((k & 4) << 1) | ((k & 8) >> 1); return ((kk >> 3) * 4 + (c >> 5)) * 512 + ((kk & 7) * 32 + (c & 31)) * 2; }
__device__ __forceinline__ int v_rd_base(int lane) { return ((lane & 3) << 3) | (((lane >> 2) & 3) << 6) | (((lane >> 4) & 1) << 5) | (((lane >> 5) & 1) << 8); }
constexpr int v_rd_off(int d0, int ks, int half) { return d0 * 512 + ks * 4096 + half * 2048; }
template <int OFF> __device__ __forceinline__ s16x4 tr_read(int vb) {
  s16x4 r; asm volatile("ds_read_b64_tr_b16 %0, %1 offset:%2" : "=&v"(r) : "v"(vb), "i"(OFF) : "memory"); return r;
}
template <int D0> __device__ __forceinline__ void pv_one(f32x16& od, int vb, bf16x8 pa0, bf16x8 pa1, bf16x8 pa2, bf16x8 pa3) {
  const s16x4 l0 = tr_read<v_rd_off(D0, 0, 0)>(vb), h0 = tr_read<v_rd_off(D0, 0, 1)>(vb), l1 = tr_read<v_rd_off(D0, 1, 0)>(vb), h1 = tr_read<v_rd_off(D0, 1, 1)>(vb);
  const s16x4 l2 = tr_read<v_rd_off(D0, 2, 0)>(vb), h2 = tr_read<v_rd_off(D0, 2, 1)>(vb), l3 = tr_read<v_rd_off(D0, 3, 0)>(vb), h3 = tr_read<v_rd_off(D0, 3, 1)>(vb);
  asm volatile("s_waitcnt lgkmcnt(0)" ::: "memory"); DA_SBAR();
#define DA_PK(L, H) (bf16x8){L[0], L[1], L[2], L[3], H[0], H[1], H[2], H[3]}
  od = __builtin_amdgcn_mfma_f32_32x32x16_bf16(pa0, DA_PK(l0, h0), od, 0, 0, 0);
  od = __builtin_amdgcn_mfma_f32_32x32x16_bf16(pa1, DA_PK(l1, h1), od, 0, 0, 0);
  od = __builtin_amdgcn_mfma_f32_32x32x16_bf16(pa2, DA_PK(l2, h2), od, 0, 0, 0);
  od = __builtin_amdgcn_mfma_f32_32x32x16_bf16(pa3, DA_PK(l3, h3), od, 0, 0, 0);
#undef DA_PK
}
__device__ __forceinline__ void pv_d0(f32x16 (&o)[4], int vb, bf16x8 pa0, bf16x8 pa1, bf16x8 pa2, bf16x8 pa3) {
  pv_one<0>(o[0], vb, pa0, pa1, pa2, pa3); pv_one<1>(o[1], vb, pa0, pa1, pa2, pa3); pv_one<2>(o[2], vb, pa0, pa1, pa2, pa3); pv_one<3>(o[3], vb, pa0, pa1, pa2, pa3);
}
__device__ __forceinline__ void unit(int u, const bf16* P, float lam, const float* subln, bf16* CAT, LAS char* lds, int tid) {
  const int qb = u & 31, h = (u >> 5) & 3, b = u >> 7;
  const int wid = tid >> 6, lane = tid & 63, r32 = lane & 31, hi = lane >> 5, mp = wid >> 2, wq = wid & 3;
  LAS char* V_lds = lds; LAS char* K_lds = lds + 2 * SHM_V;
  LAS float* ws = (LAS float*)(lds + 2 * SHM_V + 2 * SHM_K) + wid * 64; LAS float* li_l = ws; LAS float* al_l = ws + 32;
  float m_reg = -1e30f, l_reg = 0; f32x16 o[4] = {}; bf16x8 qr[4];
  const size_t rowbase = (size_t)b * NT_;
  const bf16* Qw = P + (rowbase + qb * 128 + wq * 32 + r32) * P0W + 2560 + h * 128 + mp * 64 + hi * 8;
#pragma unroll
  for (int d0 = 0; d0 < 4; ++d0) qr[d0] = *(const bf16x8*)(Qw + d0 * 16);
  const bf16* Kh = P + rowbase * P0W + 3072 + h * 128; const bf16* Vh = P + rowbase * P0W + 3584 + h * 128;
  const int mapB = mp * 128;
  const int sr = tid >> 4, sc = (tid & 15) * 8, vst0 = v_st(sr, sc), vst1 = v_st(32 + sr, sc);
  const int vb0 = (int)(uintptr_t)V_lds + v_rd_base(lane);
  struct { bf16x8 vs0, vs1, ks0, ks1; } sr_[2];
#define DA_SLOAD(i, k0) do { sr_[i].vs0 = *(const bf16x8*)(&Vh[(size_t)((k0) + sr) * P0W + sc]); sr_[i].vs1 = *(const bf16x8*)(&Vh[(size_t)((k0) + 32 + sr) * P0W + sc]); \
    sr_[i].ks0 = *(const bf16x8*)(&Kh[(size_t)((k0) + sr) * P0W + sc]); sr_[i].ks1 = *(const bf16x8*)(&Kh[(size_t)((k0) + 32 + sr) * P0W + sc]); } while (0)
#define DA_SWRITE(bb, i) do { *(LAS bf16x8*)(V_lds + (bb) * SHM_V + vst0) = sr_[i].vs0;          \
    *(LAS bf16x8*)(V_lds + (bb) * SHM_V + vst1) = sr_[i].vs1; const int kc = sc * 2;               \
    *(LAS bf16x8*)(K_lds + (bb) * SHM_K + DA_KSWZ(sr, kc)) = sr_[i].ks0;                       \
    *(LAS bf16x8*)(K_lds + (bb) * SHM_K + DA_KSWZ(32 + sr, kc)) = sr_[i].ks1; } while (0)
#define DA_SWAIT() asm volatile("s_waitcnt vmcnt(4)" ::: "memory")
#define DA_RESC(a) do { if (__any((a) < 1.f)) { if (hi == 0) al_l[r32] = (a); asm volatile("s_waitcnt lgkmcnt(0)" ::: "memory"); \
    _Pragma("unroll") for (int d = 0; d < 4; ++d) _Pragma("unroll") for (int r = 0; r < 16; ++r) o[d][r] *= al_l[crow(r, hi)]; } } while (0)
  f32x16 pA0, pA1, pB0, pB1; float mnA, mnB, alA, alB; bf16x8 pa0, pa1, pa2, pa3; constexpr int NT = NT_ / KVBLK;
  DA_SLOAD(0, 0); asm volatile("s_waitcnt vmcnt(0)" ::: "memory"); DA_SWRITE(0, 0); DA_LBAR();
  qkt(pA0, pA1, K_lds, qr, r32, hi, mapB); partialSM(pA0, pA1, m_reg, mnA, alA);
  DA_SLOAD(1, KVBLK); DA_SLOAD(0, 2 * KVBLK);
  DA_SWAIT(); DA_SWRITE(1, 1); DA_LBAR();
  for (int j = 1; j + 1 < NT; j += 2) {
    DA_SBAR(); qkt(pB0, pB1, K_lds + SHM_K, qr, r32, hi, mapB);
    finishSM(pA0, pA1, alA, l_reg, pa0, pa1, pa2, pa3); DA_SBAR();
    DA_SLOAD(1, (j + 2) * KVBLK); DA_SBAR();
    pv_d0(o, vb0, pa0, pa1, pa2, pa3); partialSM(pB0, pB1, m_reg, mnB, alB);
    DA_LBAR(); DA_SWAIT(); DA_SWRITE(0, 0);
    DA_RESC(alB); DA_LBAR();
    DA_SBAR(); qkt(pA0, pA1, K_lds, qr, r32, hi, mapB);
    finishSM(pB0, pB1, alB, l_reg, pa0, pa1, pa2, pa3); DA_SBAR();
    if (j + 3 < NT) DA_SLOAD(0, (j + 3) * KVBLK); DA_SBAR();
    pv_d0(o, vb0 + SHM_V, pa0, pa1, pa2, pa3); partialSM(pA0, pA1, m_reg, mnA, alA);
    DA_LBAR(); DA_SWAIT(); DA_SWRITE(1, 1);
    DA_RESC(alA); DA_LBAR();
  }
  DA_SBAR(); qkt(pB0, pB1, K_lds + SHM_K, qr, r32, hi, mapB);
  finishSM(pA0, pA1, alA, l_reg, pa0, pa1, pa2, pa3); DA_SBAR();
  pv_d0(o, vb0, pa0, pa1, pa2, pa3); partialSM(pB0, pB1, m_reg, mnB, alB);
  DA_LBAR(); DA_RESC(alB);
  finishSM(pB0, pB1, alB, l_reg, pa0, pa1, pa2, pa3); DA_SBAR();
  pv_d0(o, vb0 + SHM_V, pa0, pa1, pa2, pa3);
  if (hi == 0) li_l[r32] = l_reg; asm volatile("s_waitcnt lgkmcnt(0)" ::: "memory");
  float rli[16];
#pragma unroll
  for (int r = 0; r < 16; ++r) rli[r] = __builtin_amdgcn_rcpf(li_l[crow(r, hi)]);
  DA_LBAR();
  LAS float* X = (LAS float*)lds;
  if (mp == 1) {
#pragma unroll
    for (int d0 = 0; d0 < 4; ++d0)
#pragma unroll
      for (int r = 0; r < 16; ++r) X[(wq * 32 + crow(r, hi)) * 128 + d0 * 32 + r32] = o[d0][r] * rli[r];
  }
  DA_LBAR();
  if (mp == 0) {
#pragma unroll
    for (int d0 = 0; d0 < 4; ++d0)
#pragma unroll
      for (int r = 0; r < 16; ++r) { const int ix = (wq * 32 + crow(r, hi)) * 128 + d0 * 32 + r32; X[ix] = o[d0][r] * rli[r] - lam * X[ix]; }
  }
  DA_LBAR();
  { const int row = tid >> 2, qtr = tid & 3; const LAS f32x4* xp = (const LAS f32x4*)(X + row * 128 + qtr * 32); f32x4 xv[8]; float ss = 0.f;
#pragma unroll
    for (int i = 0; i < 8; ++i) { xv[i] = xp[i]; ss += (xv[i].x * xv[i].x + xv[i].y * xv[i].y) + (xv[i].z * xv[i].z + xv[i].w * xv[i].w); }
    ss += __shfl_xor(ss, 1); ss += __shfl_xor(ss, 2);
    const float rr = 0.8f / sqrtf(ss * (1.f / 128.f) + EPS);
    bf16* op = CAT + (rowbase + qb * 128 + row) * DM + GW + h * 128 + qtr * 32;
#pragma unroll
    for (int i = 0; i < 4; ++i) { const f32x4 g0 = *(const f32x4*)(subln + qtr * 32 + i * 8), g1 = *(const f32x4*)(subln + qtr * 32 + i * 8 + 4);
      const f32x4 y0 = xv[2 * i] * rr * g0, y1 = xv[2 * i + 1] * rr * g1;
      v4u w; w.x = pk2(y0.x, y0.y); w.y = pk2(y0.z, y0.w); w.z = pk2(y1.x, y1.y); w.w = pk2(y1.z, y1.w);
      *(v4u*)(op + i * 8) = w; } }
  DA_LBAR();
#undef DA_SLOAD
#undef DA_SWRITE
#undef DA_SWAIT
#undef DA_RESC
}
}
namespace na {
using da::bf16x8; using da::s16x4; using da::f32x16;
__device__ __forceinline__ int v_st2(int k, int c) { const int kk = (k & ~0xC) | ((k & 4) << 1) | ((k & 8) >> 1); return ((kk >> 3) * 2 + (c >> 5)) * 512 + ((kk & 7) * 32 + (c & 31)) * 2; }
constexpr int v_rd_off2(int d0, int ks, int half) { return d0 * 512 + ks * 2048 + half * 1024; }
template <int D0> __device__ __forceinline__ void pv_one2(f32x16& od, int vb, bf16x8 pa0, bf16x8 pa1, bf16x8 pa2, bf16x8 pa3) {
  const s16x4 l0 = da::tr_read<v_rd_off2(D0, 0, 0)>(vb), h0 = da::tr_read<v_rd_off2(D0, 0, 1)>(vb), l1 = da::tr_read<v_rd_off2(D0, 1, 0)>(vb), h1 = da::tr_read<v_rd_off2(D0, 1, 1)>(vb);
  const s16x4 l2 = da::tr_read<v_rd_off2(D0, 2, 0)>(vb), h2 = da::tr_read<v_rd_off2(D0, 2, 1)>(vb), l3 = da::tr_read<v_rd_off2(D0, 3, 0)>(vb), h3 = da::tr_read<v_rd_off2(D0, 3, 1)>(vb);
  asm volatile("s_waitcnt lgkmcnt(0)" ::: "memory"); DA_SBAR();
#define NA_PK(L, H) (bf16x8){L[0], L[1], L[2], L[3], H[0], H[1], H[2], H[3]}
  od = __builtin_amdgcn_mfma_f32_32x32x16_bf16(pa0, NA_PK(l0, h0), od, 0, 0, 0);
  od = __builtin_amdgcn_mfma_f32_32x32x16_bf16(pa1, NA_PK(l1, h1), od, 0, 0, 0);
  od = __builtin_amdgcn_mfma_f32_32x32x16_bf16(pa2, NA_PK(l2, h2), od, 0, 0, 0);
  od = __builtin_amdgcn_mfma_f32_32x32x16_bf16(pa3, NA_PK(l3, h3), od, 0, 0, 0);
#undef NA_PK
}
__device__ __forceinline__ void qtile(const bf16x8 (&kf)[2][4], const bf16x8 (&qr)[4], int col, const LAS float* brow, float& m_reg, float& l_reg, f32x16& o0, f32x16& o1,
                                      LAS float* al_l, int vb, int r32, int hi) {
  constexpr float C = 0.125f * 1.4426950408889634f, L2E = 1.4426950408889634f;
  f32x16 p0 = {}, p1 = {};
#pragma unroll
  for (int d0 = 0; d0 < 4; ++d0) { p0 = __builtin_amdgcn_mfma_f32_32x32x16_bf16(kf[0][d0], qr[d0], p0, 0, 0, 0); p1 = __builtin_amdgcn_mfma_f32_32x32x16_bf16(kf[1][d0], qr[d0], p1, 0, 0, 0); }
  int cs = col - 8; cs = cs < 0 ? 0 : (cs > 48 ? 48 : cs);
  float pmax = -INFINITY;
  const LAS float* ab = brow + (15 - col + 4 * hi); const int kofs = 4 * hi - cs;
#pragma unroll
  for (int r = 0; r < 16; ++r) { const int kr = (r & 3) + 8 * (r >> 2);
      const float s = fmaf(p0[r], C, ab[kr] * L2E); p0[r] = ((unsigned)(kr + kofs) < 16u) ? s : -INFINITY; pmax = fmaxf(pmax, p0[r]); }
#pragma unroll
  for (int r = 0; r < 16; ++r) { const int kr = 32 + (r & 3) + 8 * (r >> 2);
      const float s = fmaf(p1[r], C, ab[kr] * L2E); p1[r] = ((unsigned)(kr + kofs) < 16u) ? s : -INFINITY; pmax = fmaxf(pmax, p1[r]); }
  { auto rr = __builtin_amdgcn_permlane32_swap(__float_as_uint(pmax), __float_as_uint(pmax), false, false); pmax = fmaxf(__uint_as_float(rr[0]), __uint_as_float(rr[1])); }
  const float mn = fmaxf(m_reg, pmax), alpha = __builtin_amdgcn_exp2f(m_reg - mn); m_reg = mn;
  float ps = 0.f;
#pragma unroll
  for (int r = 0; r < 16; ++r) { p0[r] = __builtin_amdgcn_exp2f(p0[r] - mn); ps += p0[r]; }
#pragma unroll
  for (int r = 0; r < 16; ++r) { p1[r] = __builtin_amdgcn_exp2f(p1[r] - mn); ps += p1[r]; }
  { auto rr = __builtin_amdgcn_permlane32_swap(__float_as_uint(ps), __float_as_uint(ps), false, false); ps = __uint_as_float(rr[0]) + __uint_as_float(rr[1]); }
  l_reg = l_reg * alpha + ps;
  if (hi == 0) al_l[r32] = alpha; asm volatile("s_waitcnt lgkmcnt(0)" ::: "memory");
#pragma unroll
  for (int r = 0; r < 16; ++r) { const float a = al_l[da::crow(r, hi)]; o0[r] *= a; o1[r] *= a; }
  bf16x8 pa0, pa1, pa2, pa3;
#define NA_PK4(Pv, BASE, OUT) do { unsigned a0 = da::cvtpk(Pv[BASE + 0], Pv[BASE + 1]), a1 = da::cvtpk(Pv[BASE + 2], Pv[BASE + 3]);   \
    unsigned b0 = da::cvtpk(Pv[BASE + 4], Pv[BASE + 5]), b1 = da::cvtpk(Pv[BASE + 6], Pv[BASE + 7]);                              \
    auto r0 = __builtin_amdgcn_permlane32_swap(a0, b0, false, false); auto r1 = __builtin_amdgcn_permlane32_swap(a1, b1, false, false); \
    v4u w = {r0[0], r1[0], r0[1], r1[1]}; OUT = __builtin_bit_cast(bf16x8, w); } while (0)
  NA_PK4(p0, 0, pa0); NA_PK4(p0, 8, pa1); NA_PK4(p1, 0, pa2); NA_PK4(p1, 8, pa3);
#undef NA_PK4
  pv_one2<0>(o0, vb, pa0, pa1, pa2, pa3); pv_one2<1>(o1, vb, pa0, pa1, pa2, pa3);
}
__device__ __forceinline__ void item(int it, const bf16* P, const LAS float* BT, bf16* CAT, LAS char* vl, int lane) {
  const int head = it & 7, r = (it >> 3) & 63, b = it >> 9, r32 = lane & 31, hi = lane >> 5;
  const int tok0 = b * NT_ + r * 64; int rs = r - 4; rs = rs < 0 ? 0 : (rs > 56 ? 56 : rs);
  LAS float* li_l = (LAS float*)(vl + 8192); LAS float* al_l = li_l + 32;
  const int vb = (int)(uintptr_t)vl + da::v_rd_base(lane);
  bf16x8 q0[4], q1[4];
  { const bf16* qp = P + (size_t)(tok0 + r32) * P1W + 2048 + head * 64 + hi * 8;
#pragma unroll
    for (int d0 = 0; d0 < 4; ++d0) { q0[d0] = *(const bf16x8*)(qp + d0 * 16); q1[d0] = *(const bf16x8*)(qp + (size_t)32 * P1W + d0 * 16); } }
  f32x16 o00 = {}, o01 = {}, o10 = {}, o11 = {}; float m0 = -1e30f, m1 = -1e30f, l0 = 0.f, l1 = 0.f;
#pragma unroll 1
  for (int i = 0; i < 8; ++i) {
    const int krow0 = b * NT_ + (rs + i) * 64;
    bf16x8 kf[2][4], vv[8];
    { const bf16* kp = P + (size_t)(krow0 + r32) * P1W + 2560 + head * 64 + hi * 8;
#pragma unroll
      for (int d0 = 0; d0 < 4; ++d0) { kf[0][d0] = *(const bf16x8*)(kp + d0 * 16); kf[1][d0] = *(const bf16x8*)(kp + (size_t)32 * P1W + d0 * 16); }
      const bf16* vp = P + (size_t)(krow0 + lane) * P1W + 3072 + head * 64;
#pragma unroll
      for (int c8 = 0; c8 < 8; ++c8) vv[c8] = *(const bf16x8*)(vp + c8 * 8); }
#pragma unroll
    for (int c8 = 0; c8 < 8; ++c8) *(LAS bf16x8*)(vl + v_st2(lane, c8 * 8)) = vv[c8];
    asm volatile("s_waitcnt lgkmcnt(0)" ::: "memory");
    const LAS float* brow = BT + head * 465 + (rs + i - r + 7) * 31;
    int r32i = r32; asm volatile("" : "+v"(r32i));
    qtile(kf, q0, r32i, brow, m0, l0, o00, o01, al_l, vb, r32, hi);
    qtile(kf, q1, 32 + r32i, brow, m1, l1, o10, o11, al_l, vb, r32, hi);
  }
  bf16* op = CAT + (size_t)tok0 * DM + GW + head * 64 + r32;
  if (hi == 0) li_l[r32] = l0; asm volatile("s_waitcnt lgkmcnt(0)" ::: "memory");
#pragma unroll
  for (int rr = 0; rr < 16; ++rr) { const int qrow = da::crow(rr, hi); const float il = __builtin_amdgcn_rcpf(li_l[qrow]);
      op[(size_t)qrow * DM] = (bf16)f2bf(o00[rr] * il); op[(size_t)qrow * DM + 32] = (bf16)f2bf(o01[rr] * il); }
  asm volatile("s_waitcnt lgkmcnt(0)" ::: "memory");
  if (hi == 0) li_l[r32] = l1; asm volatile("s_waitcnt lgkmcnt(0)" ::: "memory");
#pragma unroll
  for (int rr = 0; rr < 16; ++rr) { const int qrow = 32 + da::crow(rr, hi); const float il = __builtin_amdgcn_rcpf(li_l[qrow - 32]);
      op[(size_t)qrow * DM] = (bf16)f2bf(o10[rr] * il); op[(size_t)qrow * DM + 32] = (bf16)f2bf(o11[rr] * il); }
  asm volatile("s_waitcnt lgkmcnt(0)" ::: "memory");
}
}
constexpr int MLP = 4;
namespace sc {
#define LBAR() do { asm volatile("s_waitcnt lgkmcnt(0)" ::: "memory"); __builtin_amdgcn_s_barrier(); asm volatile("" ::: "memory"); } while (0)

using bf16x8 = __attribute__((ext_vector_type(8))) short;
using f32x16 = __attribute__((ext_vector_type(16))) float;
constexpr int RS = 272;
constexpr int TS = 144;
template <int NS> __device__ __forceinline__ void mm(f32x16& c, const LAS char* xb, int xs, const LAS char* yb, int ys, int kb0, int lane) {
    const int r = lane & 31, h = lane >> 5;
    const LAS char* xp = xb + r * xs + kb0 + h * 16; const LAS char* yp = yb + r * ys + kb0 + h * 16;
#pragma unroll
    for (int s = 0; s < NS; ++s) { const bf16x8 a = *(const LAS bf16x8*)(xp + s * 32), b = *(const LAS bf16x8*)(yp + s * 32); c = __builtin_amdgcn_mfma_f32_32x32x16_bf16(a, b, c, 0, 0, 0); }
}
__device__ __forceinline__ unsigned long long pk4(float a, float b, float c, float d) { return (unsigned long long)pk2(a, b) | ((unsigned long long)pk2(c, d) << 32); }

__device__ __forceinline__ void hgrn_unit(int u, const bf16* P, float* OF, float* OB, LAS unsigned char* ldsu, int tid) {
    const int b = u >> 3, h = (u >> 1) & 3, dir = u & 1, wave = __builtin_amdgcn_readfirstlane(tid >> 6);
    LAS char* lds = (LAS char*)ldsu;
    LAS char* QM = lds; LAS char* KM = lds + 17408; LAS char* KMt = lds + 34816; LAS char* Vt = lds + 53248; LAS char* ST = lds + 71680; LAS char* AA = lds + 106496;
    LAS float* GT = (LAS float*)(lds + 115712); LAS float* CM = (LAS float*)(lds + 117760); LAS float* DL = (LAS float*)(lds + 118272); LAS float* FC = (LAS float*)(lds + 118784);
    const char* Pb = (const char*)(P + (size_t)b * NT_ * P0W); char* Ob = (char*)((dir ? OB : OF) + (size_t)b * NT_ * GW);
    const int sgn = dir ? -1 : 1, tz = dir ? NT_ - 1 : 0, sP = sgn * P0W * 2, fofs = (dir ? 1536 : 1024) * 2;
    int op = ((tz + sgn * ((tid >> 7) * 16)) * P0W + h * 128 + (tid & 127)) * 2;
    const int et = wave & 3, dt0 = 2 * (wave >> 2), tt = wave >> 2;
    const int tg = tid >> 7;
    f32x16 S0 = {}, S1 = {};
    unsigned rq[16], rf[16], rv[16];
#define HG_LOAD() do { _Pragma("unroll") for (int j = 0; j < 16; ++j) { const char* p = Pb + (unsigned)(op + j * sP); rq[j] = *(const unsigned short*)p; rv[j] = *(const unsigned short*)(p + 1024); rf[j] = *(const unsigned short*)(p + fofs); } \
        op += 64 * sP; } while (0)
    HG_LOAD();
#pragma unroll 1
    for (int c_ = 0; c_ < (NT_ / 64) * NREP(30); ++c_) { const int c = c_ & 63; if (c_ == 64) { S0 = f32x16{}; S1 = f32x16{}; }
        int tl_ = tid; asm volatile("" : "+v"(tl_)); const int d = tl_ & 127, lane = tl_ & 63;
#pragma unroll
        for (int j = 0; j < 16; ++j) { asm volatile("" : "+v"(rq[j])); asm volatile("" : "+v"(rf[j])); asm volatile("" : "+v"(rv[j])); }
        float qv[16], kv[16], cum[16]; float run = 0.f;
#pragma unroll
        for (int j = 0; j < 16; ++j) { kv[j] = __builtin_bit_cast(float, rf[j] << 16); run += __logf(1.f - kv[j]); cum[j] = run; qv[j] = __builtin_bit_cast(float, rq[j] << 16); }
        GT[tg * 128 + d] = run;
        LBAR();
        const float g0 = GT[d], g1 = GT[128 + d], g2 = GT[256 + d], g3 = GT[384 + d];
        const float cmid = g0 + g1, cL = cmid + g2 + g3;
        const float off = (tg == 0 ? 0.f : tg == 1 ? g0 : tg == 2 ? cmid : cmid + g2) - cmid;
        if (tg == 0) { CM[d] = __expf(cmid); DL[d] = __expf(cL); FC[d] = __expf(cL - cmid); }
        { unsigned kmw[8];
#pragma unroll
          for (int j = 0; j < 16; j += 2) {
              float x0 = off + cum[j], x1 = off + cum[j + 1];
              x0 = fminf(fmaxf(x0, -80.f), 80.f); x1 = fminf(fmaxf(x1, -80.f), 80.f);
              const float qm0 = qv[j] * __expf(x0), qm1 = qv[j + 1] * __expf(x1), km0 = kv[j] * __expf(-x0), km1 = kv[j + 1] * __expf(-x1);
              const unsigned qmp = pk2(qm0, qm1), kmp = pk2(km0, km1);
              const int t0 = tg * 16 + j;
              *(LAS unsigned short*)(QM + t0 * RS + d * 2) = (unsigned short)qmp; *(LAS unsigned short*)(QM + (t0 + 1) * RS + d * 2) = (unsigned short)(qmp >> 16);
              *(LAS unsigned short*)(KM + t0 * RS + d * 2) = (unsigned short)kmp; *(LAS unsigned short*)(KM + (t0 + 1) * RS + d * 2) = (unsigned short)(kmp >> 16);
              kmw[j >> 1] = kmp; }
          *(LAS v4u*)(KMt + d * TS + tg * 32) = (v4u){kmw[0], kmw[1], kmw[2], kmw[3]}; *(LAS v4u*)(KMt + d * TS + tg * 32 + 16) = (v4u){kmw[4], kmw[5], kmw[6], kmw[7]};
          v4u v0, v1; v0.x = rv[0] | (rv[1] << 16); v0.y = rv[2] | (rv[3] << 16); v0.z = rv[4] | (rv[5] << 16); v0.w = rv[6] | (rv[7] << 16);
          v1.x = rv[8] | (rv[9] << 16); v1.y = rv[10] | (rv[11] << 16); v1.z = rv[12] | (rv[13] << 16); v1.w = rv[14] | (rv[15] << 16);
          *(LAS v4u*)(Vt + d * TS + tg * 32) = v0; *(LAS v4u*)(Vt + d * TS + tg * 32 + 16) = v1; }
        if (c_ == 63 && NREP(30) == 2) op -= 64 * 64 * sP;
        if (c_ + 1 < (NT_ / 64) * NREP(30)) HG_LOAD();
        LBAR();
        { const int e = 32 * et + (lane & 31);
#pragma unroll
          for (int k = 0; k < 2; ++k)
#pragma unroll
              for (int i4 = 0; i4 < 4; ++i4) { const int d0 = 32 * (dt0 + k) + 8 * i4 + 4 * (lane >> 5); const f32x4 cm = *(const LAS f32x4*)(CM + d0);
                  const f32x16& S = k ? S1 : S0;
                  *(LAS unsigned long long*)(ST + e * RS + d0 * 2) = pk4(S[4 * i4] * cm.x, S[4 * i4 + 1] * cm.y, S[4 * i4 + 2] * cm.z, S[4 * i4 + 3] * cm.w); } }
        LBAR();
        f32x16 acc = {};
        mm<8>(acc, QM + 32 * tt * RS, RS, ST + 32 * et * RS, RS, 0, lane);
        if (wave < 3) { const int st = wave >> 1, t2 = (wave + 1) >> 1;
            f32x16 at = {};
            mm<8>(at, KM + 32 * st * RS, RS, QM + 32 * t2 * RS, RS, 0, lane);
            const int tg_ = 32 * t2 + (lane & 31);
#pragma unroll
            for (int i4 = 0; i4 < 4; ++i4) { const int s0 = 32 * st + 8 * i4 + 4 * (lane >> 5);
                *(LAS unsigned long long*)(AA + tg_ * TS + s0 * 2) = pk4(s0 <= tg_ ? at[4 * i4] : 0.f, s0 + 1 <= tg_ ? at[4 * i4 + 1] : 0.f, s0 + 2 <= tg_ ? at[4 * i4 + 2] : 0.f, s0 + 3 <= tg_ ? at[4 * i4 + 3] : 0.f); } }
#pragma unroll
        for (int k = 0; k < 2; ++k) { f32x16 p = {};
            mm<4>(p, KMt + 32 * (dt0 + k) * TS, TS, Vt + 32 * et * TS, TS, 0, lane);
            f32x16& S = k ? S1 : S0;
#pragma unroll
            for (int i4 = 0; i4 < 4; ++i4) { const int d0 = 32 * (dt0 + k) + 8 * i4 + 4 * (lane >> 5); const f32x4 dl = *(const LAS f32x4*)(DL + d0), fc = *(const LAS f32x4*)(FC + d0);
                S[4 * i4] = dl.x * S[4 * i4] + fc.x * p[4 * i4]; S[4 * i4 + 1] = dl.y * S[4 * i4 + 1] + fc.y * p[4 * i4 + 1];
                S[4 * i4 + 2] = dl.z * S[4 * i4 + 2] + fc.z * p[4 * i4 + 2]; S[4 * i4 + 3] = dl.w * S[4 * i4 + 3] + fc.w * p[4 * i4 + 3]; } }
        LBAR();
        if (tt == 0) mm<2>(acc, AA, TS, Vt + 32 * et * TS, TS, 0, lane); else mm<4>(acc, AA + 32 * TS, TS, Vt + 32 * et * TS, TS, 0, lane);
        { const int oo = ((tz + sgn * (c * 64 + 32 * tt + 4 * (lane >> 5))) * GW + h * 128 + 32 * et + (lane & 31)) * 4;
#pragma unroll
          for (int i = 0; i < 16; ++i) *(float*)(Ob + (unsigned)(oo + sgn * ((8 * (i >> 2) + (i & 3)) * GW * 4))) = acc[i]; }
    }
#undef HG_LOAD
    __syncthreads();
}

template <bool STATE_ONLY>
__device__ __forceinline__ void mlstm_unit(int u, int part, const bf16* P, const bf16* QKC, const float* ibias, const float* fbias, float* HF, float* HBk, float* CL, float* NL, float* FPL, LAS unsigned char* ldsu, int tid) {
    constexpr int MLC = (NT_ / 64) / MLP; const int cbase = part * MLC;
    const int b = u >> 3, h = (u >> 1) & 3, dir = u & 1, tg = tid >> 7, wave = __builtin_amdgcn_readfirstlane(tid >> 6);
    LAS char* lds = (LAS char*)ldsu;
    LAS char* Qs = lds; LAS char* Ks = lds + 17408; LAS char* KWt = lds + 34816; LAS char* Vt = lds + 53248; LAS char* ST = lds + 71680; LAS char* AA = lds + 106496;
    LAS float* GB = (LAS float*)(lds + 115712);
    LAS float* DENI = GB + 512; LAS float* DENA = DENI + 64; LAS float* NV = DENA + 128; LAS float* NP = NV + 256;
    const float ib = ibias[dir * 4 + h], fb = fbias[dir * 4 + h];
    const char* Pb = (const char*)(P + (size_t)b * NT_ * P1W); const char* Qb = (const char*)(QKC + (size_t)b * NT_ * DM); char* Ob = (char*)((dir ? HBk : HF) + (size_t)b * NT_ * GW);
    const int sgn = dir ? -1 : 1, tz = dir ? NT_ - 1 : 0;
    const int sK = sgn * DM * 2, sV = sgn * P1W * 2;
    int ok = ((tz + sgn * (cbase * 64 + tg * 16)) * DM + GW + h * 128 + (tid & 127)) * 2;
    int ov = ((tz + sgn * (cbase * 64 + tg * 16)) * P1W + 1024 + h * 128 + (tid & 127)) * 2;
    int oq = ((tz + sgn * (cbase * 64 + (tid >> 3))) * DM + h * 128 + (tid & 7) * 16) * 2;
    int og = ((tz + sgn * (cbase * 64 + (tid & 63))) * P1W + 3584 + dir * 8 + h) * 2;
    const int et = wave & 3, dt0 = 2 * (wave >> 2), tt = wave >> 2;
    f32x16 S0 = {}, S1 = {}; float facc = 0.f;
    float* const clw = CL + ((size_t)(u * MLP) * 16384) + (size_t)(wave * 2) * 1024 + (tid & 63);
    { float nv = 0.f;
      if (!STATE_ONLY) {
#pragma unroll 1
          for (int j = 0; j < part; ++j) { const float fj = __expf(FPL[u * MLP + j]); const float* cj = clw + (size_t)j * 16384;
#pragma unroll
              for (int i = 0; i < 16; ++i) { S0[i] = fj * S0[i] + cj[i * 64]; S1[i] = fj * S1[i] + cj[1024 + i * 64]; }
              if (tid < 128) nv = fj * nv + NL[(u * MLP + j) * 128 + tid]; } }
      if (tid < 128) { NV[tid] = nv; NV[128 + tid] = 0.f; } }
    if (!STATE_ONLY) { const int e = 32 * et + (tid & 31), hi_ = (tid >> 5) & 1;
#pragma unroll
        for (int k = 0; k < 2; ++k)
#pragma unroll
            for (int i4 = 0; i4 < 4; ++i4) { const int d0 = 32 * (dt0 + k) + 8 * i4 + 4 * hi_; const f32x16& S = k ? S1 : S0;
                *(LAS unsigned long long*)(ST + e * RS + d0 * 2) = pk4(S[4 * i4], S[4 * i4 + 1], S[4 * i4 + 2], S[4 * i4 + 3]); } }
    unsigned rk[16], rv[16]; v4u wq0 = {0u, 0u, 0u, 0u}, wq1 = wq0, wk0 = wq0, wk1 = wq0; unsigned rgi = 0, rgf = 0;
#define ML_LOAD() do { _Pragma("unroll") for (int j = 0; j < 16; ++j) { rk[j] = *(const unsigned short*)(Qb + (unsigned)(ok + j * sK)); rv[j] = *(const unsigned short*)(Pb + (unsigned)(ov + j * sV)); } \
        if (!STATE_ONLY) { const char* qp = Qb + (unsigned)oq; wq0 = *(const v4u*)qp; wq1 = *(const v4u*)(qp + 16); wk0 = *(const v4u*)(qp + GW * 2); wk1 = *(const v4u*)(qp + GW * 2 + 16); } \
        ok += 64 * sK; ov += 64 * sV; oq += 64 * sK; } while (0)
#define ML_GLOAD() do { if (tid < 64) { rgi = *(const unsigned short*)(Pb + (unsigned)og); rgf = *(const unsigned short*)(Pb + (unsigned)og + 8); } og += 64 * sV; } while (0)
#define ML_GATES(buf) do { if (tid < 64) { const float ig = __builtin_bit_cast(float, rgi << 16) + ib, x = __builtin_bit_cast(float, rgf << 16) + fb; const float lf = -__logf(1.f + __expf(-x)); float cs = lf; \
            _Pragma("unroll") for (int o = 1; o < 64; o <<= 1) { const float t_ = __shfl_up(cs, o); if ((tid & 63) >= o) cs += t_; } \
            const float cL = __shfl(cs, 63); facc += cL; LAS float* g_ = GB + (buf) * 256; \
            g_[tid] = __expf(cs); g_[64 + tid] = __expf(ig - cs); g_[128 + tid] = __expf(cL - cs + ig); if (tid == 0) g_[192] = __expf(cL); } } while (0)
    ML_GLOAD(); ML_GATES(0); ML_GLOAD(); ML_LOAD();
    __syncthreads();
#pragma unroll 1
    for (int c = 0; c < MLC; ++c) {
        int tl_ = tid; asm volatile("" : "+v"(tl_)); const int d = tl_ & 127, lane = tl_ & 63;
#pragma unroll
        for (int j = 0; j < 16; ++j) { asm volatile("" : "+v"(rk[j])); asm volatile("" : "+v"(rv[j])); }
        asm volatile("" : "+v"(wq0)); asm volatile("" : "+v"(wq1)); asm volatile("" : "+v"(wk0)); asm volatile("" : "+v"(wk1)); asm volatile("" : "+v"(rgi)); asm volatile("" : "+v"(rgf));
        const LAS float* G = GB + (c & 1) * 256; const LAS float* NVc = NV + (c & 1) * 128; LAS float* NVn = NV + ((c + 1) & 1) * 128;
        if (!STATE_ONLY) { const int t = tl_ >> 3, part = tl_ & 7;
          *(LAS v4u*)(Qs + t * RS + part * 32) = wq0; *(LAS v4u*)(Qs + t * RS + part * 32 + 16) = wq1; *(LAS v4u*)(Ks + t * RS + part * 32) = wk0; *(LAS v4u*)(Ks + t * RS + part * 32 + 16) = wk1; }
        { unsigned kw[8]; float ksum = 0.f;
#pragma unroll
          for (int j = 0; j < 16; j += 2) { const int t0 = tg * 16 + j; const float k0 = __builtin_bit_cast(float, rk[j] << 16) * G[128 + t0], k1 = __builtin_bit_cast(float, rk[j + 1] << 16) * G[128 + t0 + 1];
              ksum += k0 + k1; kw[j >> 1] = pk2(k0, k1); }
          NP[tg * 128 + d] = ksum;
          *(LAS v4u*)(KWt + d * TS + tg * 32) = (v4u){kw[0], kw[1], kw[2], kw[3]}; *(LAS v4u*)(KWt + d * TS + tg * 32 + 16) = (v4u){kw[4], kw[5], kw[6], kw[7]};
          v4u v0, v1; v0.x = rv[0] | (rv[1] << 16); v0.y = rv[2] | (rv[3] << 16); v0.z = rv[4] | (rv[5] << 16); v0.w = rv[6] | (rv[7] << 16);
          v1.x = rv[8] | (rv[9] << 16); v1.y = rv[10] | (rv[11] << 16); v1.z = rv[12] | (rv[13] << 16); v1.w = rv[14] | (rv[15] << 16);
          *(LAS v4u*)(Vt + d * TS + tg * 32) = v0; *(LAS v4u*)(Vt + d * TS + tg * 32 + 16) = v1; }
        if (c + 1 < MLC) { ML_GATES((c + 1) & 1); ML_LOAD(); if (c + 2 < MLC) ML_GLOAD(); }
        LBAR();
        f32x16 acc = {};
        if (!STATE_ONLY) {
        { const int t = tl_ >> 3, part = tl_ & 7; float qf[16]; unpack8(*(const LAS v4u*)(Qs + t * RS + part * 32), *(float(*)[8])&qf[0]); unpack8(*(const LAS v4u*)(Qs + t * RS + part * 32 + 16), *(float(*)[8])&qf[8]);
          float s = 0.f;
#pragma unroll
          for (int i = 0; i < 16; ++i) s += qf[i] * NVc[part * 16 + i];
          s += __shfl_xor(s, 1); s += __shfl_xor(s, 2); s += __shfl_xor(s, 4);
          if (part == 0) DENI[t] = s * G[t]; }
        mm<8>(acc, Qs + 32 * tt * RS, RS, ST + 32 * et * RS, RS, 0, lane);
#pragma unroll
        for (int i4 = 0; i4 < 4; ++i4) { const f32x4 rf = *(const LAS f32x4*)(G + 32 * tt + 8 * i4 + 4 * (lane >> 5));
            acc[4 * i4] *= rf.x; acc[4 * i4 + 1] *= rf.y; acc[4 * i4 + 2] *= rf.z; acc[4 * i4 + 3] *= rf.w; }
        if (wave < 3) { const int st = wave >> 1, t2 = (wave + 1) >> 1;
            f32x16 at = {};
            mm<8>(at, Ks + 32 * st * RS, RS, Qs + 32 * t2 * RS, RS, 0, lane);
            const int tg_ = 32 * t2 + (lane & 31); const float rowf = G[tg_]; float dsum = 0.f;
#pragma unroll
            for (int i4 = 0; i4 < 4; ++i4) { const int s0 = 32 * st + 8 * i4 + 4 * (lane >> 5); const f32x4 cf = *(const LAS f32x4*)(G + 64 + s0);
                const float a0 = s0 <= tg_ ? at[4 * i4] * cf.x * rowf : 0.f, a1 = s0 + 1 <= tg_ ? at[4 * i4 + 1] * cf.y * rowf : 0.f;
                const float a2 = s0 + 2 <= tg_ ? at[4 * i4 + 2] * cf.z * rowf : 0.f, a3 = s0 + 3 <= tg_ ? at[4 * i4 + 3] * cf.w * rowf : 0.f;
                dsum += (a0 + a1) + (a2 + a3);
                *(LAS unsigned long long*)(AA + tg_ * TS + s0 * 2) = pk4(a0, a1, a2, a3); }
            dsum += __shfl_xor(dsum, 32);
            if (lane < 32) DENA[st * 64 + tg_] = dsum;
            if (wave == 0 && lane < 32) DENA[64 + lane] = 0.f; }
        }
        { const float dls = G[192];
#pragma unroll
          for (int k = 0; k < 2; ++k) { f32x16 p = {};
              mm<4>(p, KWt + 32 * (dt0 + k) * TS, TS, Vt + 32 * et * TS, TS, 0, lane);
              f32x16& S = k ? S1 : S0;
#pragma unroll
              for (int i = 0; i < 16; ++i) S[i] = dls * S[i] + p[i]; }
          if (tl_ < 128) NVn[tl_] = dls * NVc[tl_] + ((NP[tl_] + NP[128 + tl_]) + (NP[256 + tl_] + NP[384 + tl_])); }
        if (!STATE_ONLY) {
        LBAR();
        if (tt == 0) mm<2>(acc, AA, TS, Vt + 32 * et * TS, TS, 0, lane); else mm<4>(acc, AA + 32 * TS, TS, Vt + 32 * et * TS, TS, 0, lane);
        { const int tc0 = 32 * tt + 4 * (lane >> 5); const int oo = ((tz + sgn * ((cbase + c) * 64 + tc0)) * GW + h * 128 + 32 * et + (lane & 31)) * 4;
#pragma unroll
          for (int i4 = 0; i4 < 4; ++i4) { const f32x4 di = *(const LAS f32x4*)(DENI + tc0 + 8 * i4), da = *(const LAS f32x4*)(DENA + tc0 + 8 * i4), db = *(const LAS f32x4*)(DENA + 64 + tc0 + 8 * i4);
              const f32x4 den = di + da + db;
#pragma unroll
              for (int j = 0; j < 4; ++j) *(float*)(Ob + (unsigned)(oo + sgn * ((8 * i4 + j) * GW * 4))) = acc[4 * i4 + j] * __builtin_amdgcn_rcpf(fmaxf(fabsf(den[j]), 1.f)); } }
        { const int e = 32 * et + (lane & 31);
#pragma unroll
          for (int k = 0; k < 2; ++k)
#pragma unroll
              for (int i4 = 0; i4 < 4; ++i4) { const int d0 = 32 * (dt0 + k) + 8 * i4 + 4 * (lane >> 5); const f32x16& S = k ? S1 : S0;
                  *(LAS unsigned long long*)(ST + e * RS + d0 * 2) = pk4(S[4 * i4], S[4 * i4 + 1], S[4 * i4 + 2], S[4 * i4 + 3]); } }
        }
        LBAR();
    }
    if (STATE_ONLY) {
        float* cw = clw + (size_t)part * 16384;
#pragma unroll
        for (int i = 0; i < 16; ++i) { cw[i * 64] = S0[i]; cw[1024 + i * 64] = S1[i]; }
        if (tid < 128) NL[(u * MLP + part) * 128 + tid] = NV[(MLC & 1) * 128 + tid];
        if (tid == 0) FPL[u * MLP + part] = facc;
    }
#undef ML_LOAD
#undef ML_GLOAD
#undef ML_GATES
}
}
#ifndef STOP_AFTER
#define STOP_AFTER 25
#endif
constexpr int N_PHASES = 26;
constexpr int N_CONV_HELPERS = 64;
struct Args { const float* in[44]; float* out; unsigned char* ws; int ph_lo, ph_hi, li, pad; };
__global__ void __launch_bounds__(NWAVES * 64, 2) fwd_kernel(Args args) {
    extern __shared__ __attribute__((aligned(16))) unsigned char lds_raw[];
    LAS unsigned char* lds = (LAS unsigned char*)lds_raw;
    volatile LAS unsigned* MISC = (volatile LAS unsigned*)(lds + MISC_OFF);
    LAS int* TB = (LAS int*)(lds + TBL_OFF);
    const int tid0 = threadIdx.x, wave = __builtin_amdgcn_readfirstlane(tid0 >> 6);
    const int G = gridDim.x, bx = blockIdx.x;
    const int gw = bx * NWAVES + wave, NGW = G * NWAVES, NGT = G * NWAVES * 64;
    unsigned char* ws = args.ws;
    gu32* ctl = (gu32*)(ws + WS_CTL);
    const float* x_in = args.in[0]; const float* c_in = args.in[1]; const float* lbl = args.in[2];
    const float* const* L0 = args.in + 3; const float* const* L1 = args.in + 23; const float* fnorm = args.in[43];
    float* xo = args.out;
    float* TAB = (float*)(ws + WS_TAB); float* MOD = (float*)(ws + WS_MOD); float* OML = (float*)(ws + WS_OML);
    bf16* WIN0 = (bf16*)(ws + WS_WIN0); bf16* WIN1 = (bf16*)(ws + WS_WIN1); bf16* WOUT0 = (bf16*)(ws + WS_WOUT0); bf16* WOUT1 = (bf16*)(ws + WS_WOUT1);
    bf16* ROUT0 = (bf16*)(ws + WS_ROUT0); bf16* ROUT1 = (bf16*)(ws + WS_ROUT1); bf16* GU = (bf16*)(ws + WS_GU); bf16* DN = (bf16*)(ws + WS_DN);
    bf16* H2A = (bf16*)(ws + WS_H2A); bf16* H2B = (bf16*)(ws + WS_H2B); bf16* PROJ = (bf16*)(ws + WS_PROJ); bf16* CAT = (bf16*)(ws + WS_CAT);
    float* OF = (float*)(ws + WS_OF); float* OB = (float*)(ws + WS_OB); bf16* QKC = (bf16*)(ws + WS_QKC);
    unsigned char* YB = (unsigned char*)(ws + WS_Y); bf16* HB = (bf16*)(ws + WS_HB); float* LOG = (float*)(ws + WS_LOG);
    int* TOPI = (int*)(ws + WS_TOPI); float* TOPW = (float*)(ws + WS_TOPW); int* RANK = (int*)(ws + WS_RANK); int* SLOT = (int*)(ws + WS_SLOT); int* LIST = (int*)(ws + WS_LIST);

    for (int u = tid0; u < (LDS_BYTES - LDSCTL_OFF) / 4; u += NWAVES * 64) ((LAS unsigned*)(lds + LDSCTL_OFF))[u] = 0u;
    __syncthreads();
    XcdBarrier bar = xcd_barrier_post((unsigned*)(ctl + CW_BAR + args.li * 4096), MISC + 8);
#ifndef PREFIX_K
#define PREFIX_K -1
#endif
    const int pass = args.li;
    const int lo = args.ph_lo, hi = args.ph_hi;
    gu32* const qh = ctl + CW_Q0 + pass * 256; unsigned* const cnt0 = (unsigned*)(ctl + CW_CNT0 + pass * 512); unsigned* const cnt1 = (unsigned*)(ctl + CW_CNT1 + pass * 512);
#define IN(k) (lo <= (k) && (k) < hi)
#define FRESH() int tid = wave * 64 + pg8::fresh_lane(); asm volatile("" : "+v"(tid)); const int lane = tid & 63; const int gtid = bx * (NWAVES * 64) + tid; (void)lane; (void)gtid
#define SEAM(k) do { if (IN(k) && IN((k) + 1)) xcd_barrier(bar); } while (0)
    LAS float* scr = (LAS float*)(lds + wave * 8448);

    if (IN(0)) { FRESH();
        if (bx < 192) mod_unit(bx, c_in, L0[2], L0[3], L1[2], L1[3], MOD, lds, tid, wave, lane);
        int jbase = 0;
        TR_JOB(L0[4], 4096, 1024, 0, 4096, WIN0, 0);
        TR_JOB(L1[4], 3600, 1024, 0, 2048, WIN1, 0);
        TR_JOB(L1[4], 3600, 1024, 2064, 1536, WIN1, 2048);
        TR_JOB(L1[4], 3600, 1024, 2048, 16, WIN1, 3584);
        TR_JOB(L0[5], 1024, 1024, 0, 1024, WOUT0, 0);
        TR_JOB(L1[5], 1024, 1024, 0, 1024, WOUT1, 0);
        TR_JOB(L0[12], 128, 1024, 0, 128, ROUT0, 0);
        TR_JOB(L1[12], 128, 1024, 0, 128, ROUT1, 0);
        { const v4u z = {0u, 0u, 0u, 0u};
          for (int i = gtid; i < 224 * 128; i += NGT) *(v4u*)(WIN1 + (size_t)3616 * 1024 + (size_t)i * 8) = z;
          for (int i = gtid; i < 128 * 128; i += NGT) { *(v4u*)(ROUT0 + (size_t)128 * 1024 + (size_t)i * 8) = z; *(v4u*)(ROUT1 + (size_t)128 * 1024 + (size_t)i * 8) = z; } }
        for (int i = gtid; i < 2 * GW; i += NGT) OML[i] = 1.f - 1.f / (1.f + __expf(lbl[2 * GW + i] - lbl[i]));
        for (int t = gtid; t < NT_; t += NGT) {
            const float invf[8] = {1.0f, 0.1939227432f, 0.0376060307f, 0.00729266461f, 0.00141421356f, 0.000274248188f, 5.31829573e-05f, 1.03133852e-05f};
#pragma unroll
            for (int i = 0; i < 8; ++i) { const float ang = (float)t * invf[i]; double rev = (double)ang * 0.15915494309189535; rev -= floor(rev); const float rv = (float)rev;
                TAB[t * 16 + i] = __builtin_amdgcn_cosf(rv); TAB[t * 16 + 8 + i] = __builtin_amdgcn_sinf(rv); }
        }
    }
    SEAM(0);
    if (IN(1)) { FRESH(); _Pragma("unroll 1") for (int rep_ = 0; rep_ < NREP(1); ++rep_) normmod_phase(x_in, L0[0], MOD, 0, 1024, H2A, gw, NGW, lane); }
    SEAM(1);
    if (IN(2)) { FRESH(); pg8::DenseOrder S; S.init(NTOK, P0W, G, bx); EpiProj0 E{PROJ, OML, TAB};
        _Pragma("unroll 1") for (int rep_ = 0; rep_ < NREP(2); ++rep_) pg8::gemm_phase<EpiProj0, pg8::DenseOrder, true>(lds, H2A, WIN0, DM, S, E, wave); }
    if (IN(2) && IN(4)) xcd_barrier(bar);
    if (IN(4)) { FRESH();
        if (bx < 64) sc::hgrn_unit(bx, PROJ, OF, OB, lds, tid);
        float lam;
        { float a = L0[7][lane] * L0[8][lane], b2 = L0[9][lane] * L0[10][lane]; a = wave_sum(a); b2 = wave_sum(b2); lam = __expf(a) - __expf(b2) + 0.2f; }
        const bool helper = (bx >= 64 && bx < 64 + N_CONV_HELPERS);
#pragma unroll 1
        for (int rnd = 0; rnd < 2; ++rnd) {
            if (rnd == 1 || helper)
                for (;;) { const int u0 = q_pull(qh + 64, MISC + 1, tid); if (u0 >= 1032 * NREP(27)) break; const int u = u0 % 1032;
#pragma unroll 1
                    for (int k = 0; k < 6; ++k) expert_item(L0[14], L0[15], L0[16], L0[17], L0[18], L0[19], GU, DN, u * 48 + wave * 6 + k, scr, lane); }
            if (rnd == 0)
                for (;;) { const int u = q_pull(qh, MISC + 0, tid); if (u >= 1024 * NREP(4)) break; da::unit(u & 1023, PROJ, lam, L0[11], CAT, (LAS char*)lds, tid); }
        }
    }
    SEAM(4);
    if (IN(5)) { FRESH(); _Pragma("unroll 1") for (int rep_ = 0; rep_ < NREP(5); ++rep_) gateout_phase<2>(OF, OB, L0[6], PROJ, P0W, 2048, CAT, gw, NGW, lane); }
    SEAM(5);
    if (IN(6)) { FRESH(); pg8::DenseOrder S; S.init(NTOK, DM, G, bx); EpiResid E{x_in, xo, MOD + 2048};
        _Pragma("unroll 1") for (int rep_ = 0; rep_ < NREP(6); ++rep_) pg8::gemm_phase<EpiResid, pg8::DenseOrder, true>(lds, CAT, WOUT0, DM, S, E, wave); }
    SEAM(6);
    if (IN(7)) { FRESH(); _Pragma("unroll 1") for (int rep_ = 0; rep_ < NREP(7); ++rep_) normmod_phase(xo, L0[1], MOD, 3072, 4096, H2A, gw, NGW, lane); }
    SEAM(7);
    if (IN(8)) { FRESH(); pg8::DenseOrder S; S.init(NTOK, 256, G, bx); EpiF32 E{LOG, 256};
        _Pragma("unroll 1") for (int rep_ = 0; rep_ < NREP(8); ++rep_) pg8::gemm_phase<EpiF32, pg8::DenseOrder, true>(lds, H2A, ROUT0, DM, S, E, wave); }
    SEAM(8);
    if (IN(9)) { FRESH(); topk_phase(LOG, L0[13], TOPI, TOPW, RANK, cnt0, lds, bx, G, wave, tid); }
    SEAM(9);
    if (IN(10)) { FRESH(); moe_tables(cnt0, TB, tid); _Pragma("unroll 1") for (int rep_ = 0; rep_ < NREP(10); ++rep_) list_phase(TOPI, RANK, SLOT, LIST, TB, gtid, NGT); }
    SEAM(10);
    if (IN(11)) { FRESH(); moe_tables(cnt0, TB, tid); GroupOrder S; S.init(TB, LIST, 2, G, bx); EpiGateUp E{HB};
        _Pragma("unroll 1") for (int rep_ = 0; rep_ < NREP(11); ++rep_) pg8::gemm_phase<EpiGateUp, GroupOrder, true>(lds, H2A, GU, DM, S, E, wave); }
    SEAM(11);
    if (IN(12)) { FRESH(); moe_tables(cnt0, TB, tid); GroupOrder S; S.init(TB, nullptr, 4, G, bx); EpiDown E{YB};
        _Pragma("unroll 1") for (int rep_ = 0; rep_ < NREP(12); ++rep_) pg8::gemm_phase<EpiDown, GroupOrder, true>(lds, HB, DN, EFF, S, E, wave); }
    SEAM(12);
    if (IN(13)) { FRESH(); combine_phase(xo, YB, SLOT, TOPW, MOD, 5120, L1[0], MOD + 8 * 6144, 0, 1024, H2B, nullptr, gw, NGW, lane); }
    SEAM(13);
    if (IN(14)) { FRESH(); pg8::DenseOrder S; S.init(NTOK, P1W, G, bx); EpiStoreBf16 E{PROJ, P1W};
        _Pragma("unroll 1") for (int rep_ = 0; rep_ < NREP(14); ++rep_) pg8::gemm_phase<EpiStoreBf16, pg8::DenseOrder, true>(lds, H2B, WIN1, DM, S, E, wave); }
    SEAM(14);
    if (IN(15)) { FRESH(); _Pragma("unroll 1") for (int rep_ = 0; rep_ < NREP(15); ++rep_) convqk_phase(PROJ, L1[6], L1[7], QKC, gtid, NGT); }
    SEAM(15);
    if (IN(16)) { FRESH();
        float* CLr = (float*)(ws + WS_LOG); float* NLr = CLr + (size_t)64 * MLP * 16384; float* FPr = NLr + 64 * MLP * 128;
#pragma unroll 1
        for (int w = bx; w < 64 * MLP; w += G) if ((w % MLP) != MLP - 1) sc::mlstm_unit<true>(w / MLP, w % MLP, PROJ, QKC, L1[8], L1[9], OF, OB, CLr, NLr, FPr, lds, tid);
        xcd_barrier(bar);
#pragma unroll 1
        for (int w = bx; w < 64 * MLP; w += G) sc::mlstm_unit<false>(w / MLP, w % MLP, PROJ, QKC, L1[8], L1[9], OF, OB, CLr, NLr, FPr, lds, tid);
        { LAS float* BT = (LAS float*)(lds + 69632); for (int i = tid; i < 3720; i += 512) BT[i] = L1[11][i];
          for (;;) { const int u = q_pull(qh + 128, MISC + 2, tid); if (u >= 512 * NREP(16)) break; na::item((u & 511) * 8 + wave, PROJ, BT, CAT, (LAS char*)lds + wave * 8448, lane); } }
        for (;;) { const int u0 = q_pull(qh + 192, MISC + 3, tid); if (u0 >= 1032 * NREP(28)) break; const int u = u0 % 1032;
#pragma unroll 1
            for (int k = 0; k < 6; ++k) expert_item(L1[14], L1[15], L1[16], L1[17], L1[18], L1[19], GU, DN, u * 48 + wave * 6 + k, scr, lane); }
    }
    SEAM(16);
    if (IN(17)) { FRESH(); _Pragma("unroll 1") for (int rep_ = 0; rep_ < NREP(17); ++rep_) gateout_phase<1>(OF, OB, L1[10], PROJ, P1W, 1536, CAT, gw, NGW, lane); }
    SEAM(17);
    if (IN(18)) { FRESH(); pg8::DenseOrder S; S.init(NTOK, DM, G, bx); EpiResid E{xo, xo, MOD + 8 * 6144 + 2048};
        pg8::gemm_phase<EpiResid, pg8::DenseOrder, true>(lds, CAT, WOUT1, DM, S, E, wave); }
    SEAM(18);
    if (IN(19)) { FRESH(); _Pragma("unroll 1") for (int rep_ = 0; rep_ < NREP(19); ++rep_) normmod_phase(xo, L1[1], MOD + 8 * 6144, 3072, 4096, H2A, gw, NGW, lane); }
    SEAM(19);
    if (IN(20)) { FRESH(); pg8::DenseOrder S; S.init(NTOK, 256, G, bx); EpiF32 E{LOG, 256};
        _Pragma("unroll 1") for (int rep_ = 0; rep_ < NREP(20); ++rep_) pg8::gemm_phase<EpiF32, pg8::DenseOrder, true>(lds, H2A, ROUT1, DM, S, E, wave); }
    SEAM(20);
    if (IN(21)) { FRESH(); topk_phase(LOG, L1[13], TOPI, TOPW, RANK, cnt1, lds, bx, G, wave, tid); }
    SEAM(21);
    if (IN(22)) { FRESH(); moe_tables(cnt1, TB, tid); _Pragma("unroll 1") for (int rep_ = 0; rep_ < NREP(22); ++rep_) list_phase(TOPI, RANK, SLOT, LIST, TB, gtid, NGT); }
    SEAM(22);
    if (IN(23)) { FRESH(); moe_tables(cnt1, TB, tid); GroupOrder S; S.init(TB, LIST, 2, G, bx); EpiGateUp E{HB};
        _Pragma("unroll 1") for (int rep_ = 0; rep_ < NREP(23); ++rep_) pg8::gemm_phase<EpiGateUp, GroupOrder, true>(lds, H2A, GU, DM, S, E, wave); }
    SEAM(23);
    if (IN(24)) { FRESH(); moe_tables(cnt1, TB, tid); GroupOrder S; S.init(TB, nullptr, 4, G, bx); EpiDown E{YB};
        _Pragma("unroll 1") for (int rep_ = 0; rep_ < NREP(24); ++rep_) pg8::gemm_phase<EpiDown, GroupOrder, true>(lds, HB, DN, EFF, S, E, wave); }
    SEAM(24);
    if (IN(25)) { FRESH(); combine_phase(xo, YB, SLOT, TOPW, MOD + 8 * 6144, 5120, nullptr, nullptr, 0, 0, nullptr, fnorm, gw, NGW, lane); }
    {
    if (pass == 1 && hi < N_PHASES && hi > 0 && IN(hi - 1)) { FRESH();
        xcd_barrier(bar);
        const float* src = (hi - 1 >= 6) ? (const float*)xo : x_in;
        for (int m = gw; m < NTOK; m += NGW) { const f32x4* xr = (const f32x4*)(src + (size_t)m * DM) + lane; f32x4 v[4];
#pragma unroll
            for (int j = 0; j < 4; ++j) v[j] = xr[64 * j];
            finalnorm_row(v, fnorm, xo + (size_t)m * DM, lane); }
    }
    }
#undef IN
#undef SEAM
}

extern "C" void kernel_launch(void* const* d_in, const int* in_sizes, int n_in, void* d_out, int out_size, void* d_ws, size_t ws_size, hipStream_t stream) {
    static int grid = 0;
    if (grid == 0) {
        if (n_in != 44 || in_sizes[0] != NTOK * DM || out_size != NTOK * DM || ws_size < WS_END) {
            fprintf(stderr, "kernel_launch: shape mismatch: n_in %d in0 %d out %d ws %zu (need %zu)\n", n_in, n_in > 0 ? in_sizes[0] : -1, out_size, ws_size, (size_t)WS_END); grid = -1; return; }
        int dev = 0, cus = 0, per_cu = 0;
        if (hipGetDevice(&dev) != hipSuccess || hipDeviceGetAttribute(&cus, hipDeviceAttributeMultiprocessorCount, dev) != hipSuccess) { grid = -1; return; }
        if (hipFuncSetAttribute((const void*)fwd_kernel, hipFuncAttributeMaxDynamicSharedMemorySize, LDS_BYTES) != hipSuccess) { fprintf(stderr, "kernel_launch: hipFuncSetAttribute failed\n"); grid = -1; return; }
        if (hipOccupancyMaxActiveBlocksPerMultiprocessor(&per_cu, (const void*)fwd_kernel, NWAVES * 64, LDS_BYTES) != hipSuccess || per_cu < 1) { fprintf(stderr, "kernel_launch: occupancy query reports %d\n", per_cu); }
        (void)hipGetLastError();
        grid = cus;
    }
    if (grid < 0) return;
    if (hipMemsetAsync((char*)d_ws + WS_CTL, 0, CTL_ZERO_BYTES, stream) != hipSuccess) return;
    Args a{};
    for (int i = 0; i < 44; ++i) a.in[i] = (const float*)d_in[i];
    a.out = (float*)d_out; a.ws = (unsigned char*)d_ws;
#if PREFIX_K >= 0
    a.ph_lo = 0; a.ph_hi = PREFIX_K + 1; a.li = 0;
    hipLaunchKernelGGL(fwd_kernel, dim3(grid), dim3(NWAVES * 64), LDS_BYTES, stream, a);
#endif
    a.ph_lo = 0; a.ph_hi = STOP_AFTER + 1; a.li = 1;
    hipLaunchKernelGGL(fwd_kernel, dim3(grid), dim3(NWAVES * 64), LDS_BYTES, stream, a);
    const hipError_t le = hipPeekAtLastError();
    if (le != hipSuccess) fprintf(stderr, "kernel_launch: launch failed: %s\n", hipGetErrorName(le));
}
```

```cpp
#include <hip/hip_runtime.h>
#include <cstdio>
#include <cstdint>

namespace pg8 {
#define PG8_LAS __attribute__((address_space(3)))
typedef unsigned short bf16_t;
typedef short bf16x8 __attribute__((ext_vector_type(8)));
typedef float f32x4 __attribute__((ext_vector_type(4)));
typedef unsigned u32x4 __attribute__((ext_vector_type(4)));
constexpr int BM = 256, BK = 64, HALF = 128, HTB = HALF * BK * 2  , STAGE_BYTES = 8 * HTB, NXCD = 8, WGM = 8;

__host__ __device__ __forceinline__ int lds_byte(int r, int c) { const int st = (r >> 4) * 2 + (c >> 5), rr = r & 15, cc = c & 31, ob = rr * 64 + cc * 2; return st * 1024 + (ob ^ (((ob >> 9) & 1) << 5)); }
__host__ __device__ __forceinline__ void stage_rc(int b, int& R, int& C) { const int st = b / 1024, sb = b % 1024, swz = sb ^ (((sb >> 9) & 1) << 5); R = (st >> 1) * 16 + swz / 64; C = (st & 1) * 32 + (swz % 64) / 2; }
__host__ __device__ __forceinline__ int perm32(int rho) { const int n = rho >> 4, i = rho & 15; return 8 * (i >> 2) + 4 * n + (i & 3); }

__device__ __forceinline__ int fresh_lane() { int l; asm volatile("v_mbcnt_lo_u32_b32 %0, -1, 0\n\tv_mbcnt_hi_u32_b32 %0, -1, %0" : "=v"(l)); return l; }

struct Unit { int pn, arow0, nvalid, bt; };

struct DenseOrder {
    int nM, nN, nwg, G, c;
    __device__ __forceinline__ void init(int M, int N, int G_, int c_) { nM = M / BM; nN = N / BM; nwg = nM * nN; G = G_; c = c_; }
    __device__ __forceinline__ bool next(int i, Unit& u) const {
        const long L = (long)i * G + c; if (L >= nwg) return false;
        int wgid = (int)L; { const int q = nwg / NXCD, r = nwg % NXCD, xcd = wgid % NXCD, off = wgid / NXCD; wgid = (xcd < r ? xcd * (q + 1) : r * (q + 1) + (xcd - r) * q) + off; }
        const int nig = WGM * nN, gid = wgid / nig, fm = gid * WGM, gsz = (nM - fm) < WGM ? (nM - fm) : WGM;
        const int pm = fm + ((wgid % nig) % gsz); u.pn = (wgid % nig) / gsz; u.arow0 = pm * BM; u.nvalid = BM; u.bt = u.pn; return true;
    }
    __device__ __forceinline__ int arow(const Unit& u, int r) const { return u.arow0 + r; }
};

__device__ __forceinline__ unsigned cvt_pk_bf16(float lo, float hi) { unsigned r; asm volatile("v_cvt_pk_bf16_f32 %0, %1, %2" : "=v"(r) : "v"(lo), "v"(hi)); return r; }

template <class Epi, class Sched, bool ALIGN_EPI>
__device__ __forceinline__ void gemm_phase(PG8_LAS unsigned char* lds, const bf16_t* A, const bf16_t* Bt, const int K, const Sched& S, const Epi& E, const int wid  ) {
    int tid = wid * 64 + pg8::fresh_lane(); asm volatile("" : "+v"(tid));
    const int lane = tid & 63, wr = wid >> 2, wc = wid & 3, fr = lane & 15, fq = lane >> 4;
    const int nt = K / BK;
    unsigned voffB[2];
#pragma unroll
    for (int i = 0; i < 2; ++i) { int R, C; stage_rc(tid * 16 + i * 8192, R, C); const int Rb = Epi::PERM ? ((R & ~31) + perm32(R & 31)) : R;
        voffB[i] = (unsigned)(Rb * K + C) * 2u; }
#define PG8_AOFF(U, o00, o01, o10, o11) do { int _t = wid * 64 + pg8::fresh_lane(); asm volatile("" : "+v"(_t)); int _R0, _C0, _R1, _C1; stage_rc(_t * 16, _R0, _C0); stage_rc(_t * 16 + 8192, _R1, _C1); \
        o00 = (unsigned)S.arow(U, _R0) * K2 + (unsigned)_C0 * 2u; o01 = (unsigned)S.arow(U, _R1) * K2 + (unsigned)_C1 * 2u; \
        o10 = (unsigned)S.arow(U, HALF + _R0) * K2 + (unsigned)_C0 * 2u; o11 = (unsigned)S.arow(U, HALF + _R1) * K2 + (unsigned)_C1 * 2u; } while (0)
    const unsigned K2 = (unsigned)K * 2u;
    const unsigned kstep = (unsigned)(BK * 2);
    const size_t hstep = (size_t)HALF * K * 2;
    const size_t tstep = 2 * hstep;
    const unsigned ldsw = (unsigned)wid * 1024u;
    const int aoff = lds_byte(wr * 64 + fr, fq * 8), boff = lds_byte(wc * 32 + fr, fq * 8);
    const char* Ab = (const char*)A; const char* Bb = (const char*)Bt;
#define PG8_SA(b, h) (((b) * 2 + (h)) * HTB)
#define PG8_SB(b, h) ((4 + (b) * 2 + (h)) * HTB)
#define PG8_STAGE_B(bufoff, gbase) do { _Pragma("unroll") for (int _i = 0; _i < 2; ++_i) \
        __builtin_amdgcn_global_load_lds((const unsigned*)((const char*)(gbase) + voffB[_i]), (PG8_LAS unsigned*)(lds + (bufoff) + ldsw + _i * 8192), 16, 0, 0); } while (0)
#define PG8_STAGE_A(bufoff, kbyte, o0, o1) do { \
        __builtin_amdgcn_global_load_lds((const unsigned*)(Ab + (size_t)((kbyte) + (o0))), (PG8_LAS unsigned*)(lds + (bufoff) + ldsw), 16, 0, 0); \
        __builtin_amdgcn_global_load_lds((const unsigned*)(Ab + (size_t)((kbyte) + (o1))), (PG8_LAS unsigned*)(lds + (bufoff) + ldsw + 8192), 16, 0, 0); } while (0)
#define PG8_LDA(dst, b, h) do { _Pragma("unroll") for (int m = 0; m < 4; ++m) _Pragma("unroll") for (int k = 0; k < 2; ++k) dst[m][k] = *(const PG8_LAS bf16x8*)(lds + PG8_SA(b, h) + aoff + m * 2048 + k * 1024); } while (0)
#define PG8_LDB(dst, b, h) do { _Pragma("unroll") for (int n = 0; n < 2; ++n) _Pragma("unroll") for (int k = 0; k < 2; ++k) dst[n][k] = *(const PG8_LAS bf16x8*)(lds + PG8_SB(b, h) + boff + n * 2048 + k * 1024); } while (0)
#define PG8_MMA(ai, bj, At, Bt_) do { __builtin_amdgcn_s_setprio(1); _Pragma("unroll") for (int m = 0; m < 4; ++m) _Pragma("unroll") for (int n = 0; n < 2; ++n) _Pragma("unroll") for (int k = 0; k < 2; ++k) \
        acc[ai][bj][m][n] = __builtin_amdgcn_mfma_f32_16x16x32_bf16(Bt_[n][k], At[m][k], acc[ai][bj][m][n], 0, 0, 0); __builtin_amdgcn_s_setprio(0); } while (0)
#define PG8_WAIT_V(n) asm volatile("s_waitcnt vmcnt(" #n ")" ::: "memory")
#define PG8_WAIT_L(n) asm volatile("s_waitcnt lgkmcnt(" #n ")" ::: "memory")
#define PG8_BAR __builtin_amdgcn_s_barrier()
#define PG8_SCHED __builtin_amdgcn_sched_barrier(0)
    Unit cur, nxt; int ui = 0;
    if (!S.next(0, cur)) return;
    f32x4 acc[2][2][4][2];
#pragma unroll
    for (int a = 0; a < 2; ++a)
#pragma unroll
        for (int b = 0; b < 2; ++b)
#pragma unroll
            for (int m = 0; m < 4; ++m)
#pragma unroll
                for (int n = 0; n < 2; ++n) acc[a][b][m][n] = (f32x4){0.f, 0.f, 0.f, 0.f};
    bf16x8 At[4][2], B0[2][2], B1[2][2];
    unsigned c00, c01, c10, c11, n00, n01, n10, n11;
    PG8_AOFF(cur, c00, c01, c10, c11);
    const char* cB = Bb + (size_t)cur.bt * tstep;
    PG8_STAGE_B(PG8_SB(0, 0), cB); PG8_STAGE_B(PG8_SB(0, 1), cB + hstep); PG8_STAGE_A(PG8_SA(0, 0), 0u, c00, c01); PG8_STAGE_A(PG8_SA(0, 1), 0u, c10, c11);
    if (wr == 1) PG8_BAR;
    PG8_WAIT_V(2); PG8_BAR;
    PG8_STAGE_B(PG8_SB(1, 0), cB + kstep); PG8_STAGE_A(PG8_SA(1, 0), kstep, c00, c01); PG8_STAGE_B(PG8_SB(1, 1), cB + hstep + kstep);
    PG8_WAIT_V(6); PG8_BAR;
    for (;;) {
        const bool has_next = S.next(ui + 1, nxt);
        if (has_next) { PG8_AOFF(nxt, n00, n01, n10, n11); } else { n00 = c00; n01 = c01; n10 = c10; n11 = c11; }
        const char* nB = has_next ? Bb + (size_t)nxt.bt * tstep : cB;
        for (int t = 0; t < nt; t += 2) {
            const bool last = (t == nt - 2);
            const unsigned kb1 = (unsigned)(t + 1) * kstep;
            const unsigned kb2 = last ? 0u : (unsigned)(t + 2) * kstep, kb3 = kb2 + kstep;
            const unsigned a00 = last ? n00 : c00, a01 = last ? n01 : c01, a10 = last ? n10 : c10, a11 = last ? n11 : c11;
            const char* b2 = last ? nB : cB + (size_t)(t + 2) * kstep; const char* b3 = b2 + kstep;
            PG8_LDB(B0, 0, 0); PG8_LDB(B1, 0, 1); PG8_SCHED; PG8_LDA(At, 0, 0); PG8_STAGE_A(PG8_SA(1, 1), kb1, c10, c11);
            PG8_WAIT_V(8); PG8_WAIT_L(0); PG8_BAR; PG8_MMA(0, 0, At, B0); PG8_MMA(0, 1, At, B1); PG8_BAR; PG8_SCHED;
            PG8_LDA(At, 0, 1); PG8_STAGE_B(PG8_SB(0, 0), b2); PG8_STAGE_B(PG8_SB(0, 1), b2 + hstep); PG8_STAGE_A(PG8_SA(0, 0), kb2, a00, a01);
            PG8_WAIT_V(8); PG8_WAIT_L(0); PG8_BAR; PG8_MMA(1, 0, At, B0); PG8_MMA(1, 1, At, B1); PG8_BAR; PG8_SCHED;
            PG8_LDB(B0, 1, 0); PG8_LDB(B1, 1, 1); PG8_SCHED; PG8_LDA(At, 1, 0); PG8_STAGE_A(PG8_SA(0, 1), kb2, a10, a11);
            PG8_WAIT_V(8); PG8_WAIT_L(0); PG8_BAR; PG8_MMA(0, 0, At, B0); PG8_MMA(0, 1, At, B1); PG8_BAR; PG8_SCHED;
            PG8_LDA(At, 1, 1); PG8_STAGE_B(PG8_SB(1, 0), b3); PG8_STAGE_B(PG8_SB(1, 1), b3 + hstep); PG8_STAGE_A(PG8_SA(1, 0), kb3, a00, a01);
            PG8_WAIT_V(8); PG8_WAIT_L(0); PG8_BAR; PG8_MMA(1, 0, At, B0); PG8_MMA(1, 1, At, B1); PG8_BAR; PG8_SCHED;
        }
        if constexpr (ALIGN_EPI) { if (wr == 0) PG8_BAR; }
        E(acc, cur, wr, wc, fr, fq);
        if (!has_next) break;
#pragma unroll
        for (int a = 0; a < 2; ++a)
#pragma unroll
            for (int b = 0; b < 2; ++b)
#pragma unroll
                for (int m = 0; m < 4; ++m)
#pragma unroll
                    for (int n = 0; n < 2; ++n) acc[a][b][m][n] = (f32x4){0.f, 0.f, 0.f, 0.f};
        cur = nxt; cB = nB; c00 = n00; c01 = n01; c10 = n10; c11 = n11; ++ui;
        if constexpr (ALIGN_EPI) { if (wr == 1) PG8_BAR; }
    }
    PG8_WAIT_V(0);
    if constexpr (!ALIGN_EPI) { if (wr == 0) PG8_BAR; }
    PG8_BAR;
#undef PG8_AOFF
#undef PG8_SA
#undef PG8_SB
#undef PG8_STAGE_A
#undef PG8_STAGE_B
#undef PG8_LDA
#undef PG8_LDB
#undef PG8_MMA
#undef PG8_WAIT_V
#undef PG8_WAIT_L
#undef PG8_BAR
#undef PG8_SCHED
}
}
#ifndef DUPMASK
#define DUPMASK 0u
#endif
#define NREP(k) (((DUPMASK >> (k)) & 1u) ? 2 : 1)
constexpr int NB = 8, NT_ = 4096, DM = 1024, NTOK = NB * NT_;
constexpr int GW = 512;
constexpr int P0W = 4096, P1W = 3840;
constexpr int NEXP = 128, EFF = 256, NSLOT = NTOK * 8, NSLOT_ALL = NSLOT + NTOK;
constexpr float EPS = 1e-6f;
constexpr int NWAVES = 8;

constexpr size_t MiB = 1u << 20;
constexpr size_t WS_CTL = 0, CTL_ZERO_BYTES = 1 * MiB;
constexpr size_t WS_TAB = 1 * MiB;
constexpr size_t WS_MOD = WS_TAB + 256 * 1024;
constexpr size_t WS_OML = WS_MOD + 2 * 8 * 6144 * 4;
constexpr size_t WS_WIN0 = 2 * MiB, WS_WIN1 = 10 * MiB, WS_WOUT0 = 18 * MiB, WS_WOUT1 = 20 * MiB, WS_ROUT0 = 22 * MiB, WS_ROUT1 = 23 * MiB;
constexpr size_t WS_GU = 24 * MiB;
constexpr size_t WS_DN = 153 * MiB;
constexpr size_t WS_H2A = 218 * MiB;
constexpr size_t WS_PROJ = 282 * MiB;
constexpr size_t WS_CAT = 538 * MiB;
constexpr size_t WS_OF = 602 * MiB, WS_OB = 666 * MiB;
constexpr size_t WS_QKC = 730 * MiB;
constexpr size_t WS_Y = 218 * MiB;
constexpr size_t WS_HB = 794 * MiB;
constexpr size_t WS_H2B = 794 * MiB;
constexpr size_t WS_LOG = 938 * MiB;
constexpr size_t WS_TOPI = 970 * MiB, WS_TOPW = 971 * MiB, WS_RANK = 972 * MiB, WS_SLOT = 973 * MiB, WS_LIST = 974 * MiB;
constexpr size_t WS_END = 976 * MiB;
constexpr int CW_TMO = 0, CW_BAR = 16384  , CW_Q0 = 8192  , CW_CNT0 = 9216  , CW_CNT1 = 9472;

constexpr int RING_BYTES = 131072;
constexpr int LDSCTL_OFF = RING_BYTES, MISC_OFF = LDSCTL_OFF + 320;
constexpr int LDS_BYTES = 147456;
constexpr int TBL_OFF = MISC_OFF + 128;

#define GAS __attribute__((address_space(1)))
#define LAS __attribute__((address_space(3)))
typedef unsigned short bf16;
typedef unsigned v4u __attribute__((ext_vector_type(4)));
typedef float f32x4 __attribute__((ext_vector_type(4)));
typedef short bf16x8 __attribute__((ext_vector_type(8)));
typedef GAS unsigned gu32;
typedef GAS unsigned long long gu64;
#define RLX_AGENT __ATOMIC_RELAXED, __HIP_MEMORY_SCOPE_AGENT
#define LDS_WAIT() asm volatile("s_waitcnt lgkmcnt(0)" ::: "memory")
#define VM_WAIT() asm volatile("s_waitcnt vmcnt(0)" ::: "memory")
__device__ __forceinline__ unsigned long long rt() { return __builtin_amdgcn_s_memrealtime(); }
__device__ __forceinline__ unsigned f2bf(float f) { unsigned u = __builtin_bit_cast(unsigned, f); return (u + 0x7fffu + ((u >> 16) & 1u)) >> 16; }
__device__ __forceinline__ unsigned pk2(float lo, float hi) { return f2bf(lo) | (f2bf(hi) << 16); }
#define XB_TMO      128
#define XB_XCNT(j)  (256  + 64 * (j))
#define XB_XSUB(j)  (1280 + 64 * (j))
#define XB_XGEN(j)  (2304 + 64 * (j))
#define XB_TOP      3328
#define XB_TOPGEN   3392
#define XCD_BAR_WORDS 3456
#define XB_SPIN_CAP (1u << 18)

__device__ __forceinline__ unsigned xb_ld(unsigned* p)              { return __hip_atomic_load(p, __ATOMIC_RELAXED, __HIP_MEMORY_SCOPE_AGENT); }
__device__ __forceinline__ unsigned xb_add(unsigned* p, unsigned v) { return __hip_atomic_fetch_add(p, v, __ATOMIC_RELAXED, __HIP_MEMORY_SCOPE_AGENT); }
__device__ __forceinline__ unsigned xb_xcc_id() { return (unsigned)__builtin_amdgcn_s_getreg((3 << 11) | 20) & 0xFu; }
#define XB_SPIN(cond, bar) do { unsigned _sp = 0; while (cond) { __builtin_amdgcn_s_sleep(1); \
    if ((++_sp & 255u) == 0u) { if (xb_ld(&(bar)[XB_TMO])) break; if (_sp > XB_SPIN_CAP) { atomicAdd(&(bar)[XB_TMO], 1u); break; } } } } while (0)

struct XcdBarrier {
    unsigned* bar; unsigned x;
    volatile LAS unsigned* st;
};

__device__ __forceinline__ XcdBarrier xcd_barrier_post(unsigned* bar, volatile LAS unsigned* st) {
    XcdBarrier b; b.bar = bar; b.x = xb_xcc_id(); b.st = st;
    if (threadIdx.x == 0) (void)xb_add(&bar[XB_XCNT(b.x)], 1u);
    return b;
}
__device__ __forceinline__ void xcd_barrier_complete(unsigned* bar, unsigned x, unsigned& nloc, unsigned& nx) {
    const unsigned G = gridDim.x * gridDim.y * gridDim.z;
    unsigned sum, cnt, mine, sp = 0u;
    for (;;) {
        sum = 0u; cnt = 0u; mine = 0u;
#pragma unroll
        for (unsigned j = 0; j < 16; ++j) { const unsigned c = xb_ld(&bar[XB_XCNT(j)]); sum += c; cnt += (c > 0u) ? 1u : 0u; mine = (j == x) ? c : mine; }
        if (sum == G) break;
        __builtin_amdgcn_s_sleep(1);
        if ((++sp & 255u) == 0u) { if (xb_ld(&bar[XB_TMO])) break; if (sp > XB_SPIN_CAP) { atomicAdd(&bar[XB_TMO], 1u); break; } }
    }
    nloc = mine > 0u ? mine : 1u; nx = cnt > 0u ? cnt : 1u;
}

__device__ __forceinline__ void xcd_barrier(const XcdBarrier& b) {
    asm volatile("s_waitcnt vmcnt(0)" ::: "memory");
    __syncthreads();
    if (threadIdx.x == 0) {
        unsigned* bar = b.bar;
        __builtin_amdgcn_s_waitcnt(0);
        unsigned nloc = b.st[0], nx = b.st[1];
        if (nloc == 0u) { xcd_barrier_complete(bar, b.x, nloc, nx); b.st[0] = nloc; b.st[1] = nx; }
        const unsigned old = xb_add(&bar[XB_XSUB(b.x)], 1u);
        const unsigned gen = old / nloc;
        if (old + 1u == (gen + 1u) * nloc) {
            __builtin_amdgcn_fence(__ATOMIC_RELEASE, "agent");
            asm volatile("s_waitcnt vmcnt(0)" ::: "memory");
            const unsigned og = xb_add(&bar[XB_TOP], 1u);
            const unsigned tg = og / nx;
            if (og + 1u == (tg + 1u) * nx) xb_add(&bar[XB_TOPGEN], 1u);
            else XB_SPIN(xb_ld(&bar[XB_TOPGEN]) == tg, bar);
            __builtin_amdgcn_fence(__ATOMIC_ACQUIRE, "agent");
            xb_add(&bar[XB_XGEN(b.x)], 1u);
            asm volatile("s_waitcnt vmcnt(0)" ::: "memory");
        } else {
            XB_SPIN(xb_ld(&bar[XB_XGEN(b.x)]) == gen, bar);
            __builtin_amdgcn_fence(__ATOMIC_ACQUIRE, "agent");
            asm volatile("s_waitcnt vmcnt(0)" ::: "memory");
        }
    }
    __syncthreads();
}
typedef float f32x2 __attribute__((ext_vector_type(2)));
typedef unsigned u32x2 __attribute__((ext_vector_type(2)));
__device__ __forceinline__ float bflo(unsigned w) { return __builtin_bit_cast(float, w << 16); }
__device__ __forceinline__ float bfhi(unsigned w) { return __builtin_bit_cast(float, w & 0xffff0000u); }
__device__ __forceinline__ float bf2f(bf16 b) { return __builtin_bit_cast(float, (unsigned)b << 16); }
__device__ __forceinline__ float wave_sum(float v) {
#pragma unroll
    for (int o = 1; o < 64; o <<= 1) v += __shfl_xor(v, o);
    return v;
}
__device__ __forceinline__ float sigm(float x) { return __builtin_amdgcn_rcpf(1.f + __expf(-x)); }
__device__ __forceinline__ float sigm_div(float x) { return 1.f / (1.f + __expf(-x)); }
__device__ __forceinline__ float silu(float x) { return x * __builtin_amdgcn_rcpf(1.f + __expf(-x)); }
__device__ __forceinline__ void unpack8(v4u w, float (&f)[8]) { f[0] = bflo(w.x); f[1] = bfhi(w.x); f[2] = bflo(w.y); f[3] = bfhi(w.y); f[4] = bflo(w.z); f[5] = bfhi(w.z); f[6] = bflo(w.w); f[7] = bfhi(w.w); }
__device__ __forceinline__ v4u pack8(const float (&f)[8]) { v4u w; w.x = pk2(f[0], f[1]); w.y = pk2(f[2], f[3]); w.z = pk2(f[4], f[5]); w.w = pk2(f[6], f[7]); return w; }

__device__ __forceinline__ void tr_item(const float* W, int ldw, int k0, int c0, int cvalid, bf16* WT, int ldt, int r0, LAS float* scr, int lane) {
    float wv[32];
#pragma unroll
    for (int i = 0; i < 32; ++i) { const int kk = 2 * i + (lane >> 5), n = lane & 31; wv[i] = (n < cvalid) ? W[(size_t)(k0 + kk) * ldw + c0 + n] : 0.f; }
#pragma unroll
    for (int i = 0; i < 32; ++i) { const int kk = 2 * i + (lane >> 5), n = lane & 31; scr[kk * 33 + n] = wv[i]; }
    LDS_WAIT(); asm volatile("" ::: "memory");
    const int c = lane & 7;
#pragma unroll
    for (int j = 0; j < 4; ++j) { const int n = (lane >> 3) + 8 * j; const LAS float* s = scr + (8 * c) * 33 + n;
        v4u o; o.x = pk2(s[0 * 33], s[1 * 33]); o.y = pk2(s[2 * 33], s[3 * 33]); o.z = pk2(s[4 * 33], s[5 * 33]); o.w = pk2(s[6 * 33], s[7 * 33]);
        *(v4u*)(WT + (size_t)(r0 + n) * ldt + k0 + 8 * c) = o; }
    LDS_WAIT(); asm volatile("" ::: "memory");
}
__device__ __forceinline__ void expert_item(const float* gate, const float* up, const float* down, const float* sgate, const float* sup, const float* sdown,
                                            bf16* GU, bf16* DN, int it, LAS float* scr, int lane) {
    const int e = it / 384, r = it - e * 384;
    const bool sh = (e == NEXP);
    if (r < 256) {
        const bool isup = r >= 128; const int rr = r & 127, sub = rr >> 6, q = rr & 63, kb = q >> 2, nb = q & 3;
        const float* W = sh ? (isup ? sup : sgate) : ((isup ? up : gate) + (size_t)e * (DM * EFF));
        tr_item(W, EFF, kb * 64, sub * 128 + nb * 32, 32, GU + (size_t)e * (512 * DM), DM, 256 * sub + (isup ? 128 : 0) + nb * 32, scr, lane);
    } else {
        const int rr = r - 256, kb = rr >> 5, nb = rr & 31;
        const float* W = sh ? sdown : down + (size_t)e * (EFF * DM);
        tr_item(W, DM, kb * 64, nb * 32, 32, DN + (size_t)e * (DM * EFF), EFF, nb * 32, scr, lane);
    }
}
#define TR_JOB(W_, ldw_, K_, c0_, ncols_, WT_, r0_) do { const int _nb = ((ncols_) + 31) / 32, _ni = ((K_) / 64) * _nb; \
        for (int _it = (gw + NGW - (jbase % NGW)) % NGW; _it < _ni; _it += NGW) { const int _kb = _it / _nb, _nk = _it % _nb; const int _cv = (ncols_) - _nk * 32; \
            tr_item(W_, ldw_, _kb * 64, (c0_) + _nk * 32, _cv < 32 ? _cv : 32, WT_, K_, (r0_) + _nk * 32, scr, lane); } jbase += _ni; } while (0)

__device__ __forceinline__ void mod_unit(int u, const float* c, const float* wm0, const float* bm0, const float* wm1, const float* bm1, float* MOD, LAS unsigned char* lds, int tid, int wave, int lane) {
    LAS float* sc = (LAS float*)(lds + 69632);
    LAS float* red = (LAS float*)(lds + 69632 + 32768);
    const int l = u / 96, cb = u % 96; const float* wm = l ? wm1 : wm0; const float* bm = l ? bm1 : bm0;
    for (int i = tid; i < NB * DM; i += 512) sc[i] = silu(c[i]);
    __syncthreads();
    float acc[8];
#pragma unroll
    for (int b = 0; b < 8; ++b) acc[b] = 0.f;
    const float* wp = wm + (size_t)(wave * 128) * 6144 + cb * 64 + lane;
    for (int k0 = 0; k0 < 128; k0 += 8) {
        float w[8];
#pragma unroll
        for (int j = 0; j < 8; ++j) w[j] = wp[(size_t)(k0 + j) * 6144];
#pragma unroll
        for (int j = 0; j < 8; ++j)
#pragma unroll
            for (int b = 0; b < 8; ++b) acc[b] += sc[b * DM + wave * 128 + k0 + j] * w[j];
    }
#pragma unroll
    for (int b = 0; b < 8; ++b) red[(wave * 8 + b) * 64 + lane] = acc[b];
    __syncthreads();
    { const int b = tid >> 6; float s = 0.f;
#pragma unroll
      for (int w = 0; w < 8; ++w) s += red[(w * 8 + b) * 64 + lane];
      MOD[(size_t)(l * 8 + b) * 6144 + cb * 64 + lane] = s + bm[cb * 64 + lane]; }
    __syncthreads();
}

__device__ __forceinline__ void normmod_row(const f32x4 (&v)[4], const float* gain, const float* shift, const float* scale, bf16* orow, int lane) {
    float ss = 0.f;
#pragma unroll
    for (int j = 0; j < 4; ++j) ss += (v[j].x * v[j].x + v[j].y * v[j].y) + (v[j].z * v[j].z + v[j].w * v[j].w);
    const float r = 1.f / sqrtf(wave_sum(ss) * (1.f / DM) + EPS);
    unsigned long long* o8 = (unsigned long long*)orow + lane;
#pragma unroll
    for (int j = 0; j < 4; ++j) { const f32x4 g = ((const f32x4*)gain)[lane + 64 * j], sh = ((const f32x4*)shift)[lane + 64 * j], sc = ((const f32x4*)scale)[lane + 64 * j];
        const f32x4 y = v[j] * r * g * (sc + 1.f) + sh;
        o8[64 * j] = (unsigned long long)pk2(y.x, y.y) | ((unsigned long long)pk2(y.z, y.w) << 32); }
}
__device__ __forceinline__ void normmod_phase(const float* X, const float* gain, const float* modl  , int sh_off, int sc_off, bf16* H, int gw, int NGW, int lane) {
    for (int m = gw; m < NTOK; m += NGW) {
        const f32x4* xr = (const f32x4*)(X + (size_t)m * DM) + lane; f32x4 v[4];
#pragma unroll
        for (int j = 0; j < 4; ++j) v[j] = xr[64 * j];
        const float* mb = modl + (size_t)(m >> 12) * 6144;
        normmod_row(v, gain, mb + sh_off, mb + sc_off, H + (size_t)m * DM, lane);
    }
}
__device__ __forceinline__ void finalnorm_row(const f32x4 (&v)[4], const float* gain, float* orow, int lane) {
    float ss = 0.f;
#pragma unroll
    for (int j = 0; j < 4; ++j) ss += (v[j].x * v[j].x + v[j].y * v[j].y) + (v[j].z * v[j].z + v[j].w * v[j].w);
    const float r = 1.f / sqrtf(wave_sum(ss) * (1.f / DM) + EPS);
#pragma unroll
    for (int j = 0; j < 4; ++j) ((f32x4*)orow)[lane + 64 * j] = v[j] * r * ((const f32x4*)gain)[lane + 64 * j];
}

__device__ __forceinline__ void rope_phase(bf16* P, const float* tab, int gtid, int NGT) {
    for (int idx = gtid; idx < NTOK * 16; idx += NGT) {
        const int tok = idx >> 4, grp = idx & 15, t = tok & (NT_ - 1);
        bf16* p = P + (size_t)tok * P0W + (grp < 8 ? 2560 : 3072) + (grp & 7) * 64;
        const v4u a = *(const v4u*)p, b = *(const v4u*)(p + 8);
        float x1[8], x2[8], cs[8], sn[8], y1[8], y2[8];
        unpack8(a, x1); unpack8(b, x2);
        const f32x4* tp = (const f32x4*)(tab + (size_t)t * 16);
        const f32x4 c0 = tp[0], c1 = tp[1], s0 = tp[2], s1 = tp[3];
        cs[0] = c0.x; cs[1] = c0.y; cs[2] = c0.z; cs[3] = c0.w; cs[4] = c1.x; cs[5] = c1.y; cs[6] = c1.z; cs[7] = c1.w;
        sn[0] = s0.x; sn[1] = s0.y; sn[2] = s0.z; sn[3] = s0.w; sn[4] = s1.x; sn[5] = s1.y; sn[6] = s1.z; sn[7] = s1.w;
#pragma unroll
        for (int i = 0; i < 8; ++i) { y1[i] = x1[i] * cs[i] - x2[i] * sn[i]; y2[i] = x2[i] * cs[i] + x1[i] * sn[i]; }
        *(v4u*)p = pack8(y1); *(v4u*)(p + 8) = pack8(y2);
    }
}

template <int ACT  >
__device__ __forceinline__ void gateout_phase(const float* OF, const float* OB, const float* gain, const bf16* P, int pitch, int gcol, bf16* CAT, int gw, int NGW, int lane) {
    const int hh = lane >> 4, e0 = (lane & 15) * 8;
    const f32x4 g0 = *(const f32x4*)(gain + e0), g1 = *(const f32x4*)(gain + e0 + 4);
    for (int m = gw; m < NTOK; m += NGW) {
        const float* pf = OF + (size_t)m * GW + hh * 128 + e0; const float* pb = OB + (size_t)m * GW + hh * 128 + e0;
        const f32x4 a0 = *(const f32x4*)pf + *(const f32x4*)pb, a1 = *(const f32x4*)(pf + 4) + *(const f32x4*)(pb + 4);
        float ss = (a0.x * a0.x + a0.y * a0.y) + (a0.z * a0.z + a0.w * a0.w) + (a1.x * a1.x + a1.y * a1.y) + (a1.z * a1.z + a1.w * a1.w);
        ss += __shfl_xor(ss, 1); ss += __shfl_xor(ss, 2); ss += __shfl_xor(ss, 4); ss += __shfl_xor(ss, 8);
        const float r = 1.f / sqrtf(ss * (1.f / 128.f) + EPS);
        float gv[8]; unpack8(*(const v4u*)(P + (size_t)m * pitch + gcol + hh * 128 + e0), gv);
        float y[8];
        const f32x4 n0 = a0 * r * g0, n1 = a1 * r * g1;
        y[0] = n0.x; y[1] = n0.y; y[2] = n0.z; y[3] = n0.w; y[4] = n1.x; y[5] = n1.y; y[6] = n1.z; y[7] = n1.w;
#pragma unroll
        for (int i = 0; i < 8; ++i) y[i] *= (ACT == 0) ? silu(gv[i]) : ((ACT == 1) ? sigm(gv[i]) : gv[i]);
        *(v4u*)(CAT + (size_t)m * DM + hh * 128 + e0) = pack8(y);
    }
}

struct EpiStoreBf16 {
    static constexpr bool PERM = true;
    bf16* O; int ldc;
    __device__ __forceinline__ void operator()(const pg8::f32x4 (&acc)[2][2][4][2], const pg8::Unit& u, int wr, int wc, int fr, int fq) const {
        const int row0 = u.arow0 + wr * 64 + fr, col0 = u.pn * 256 + wc * 32 + 8 * fq;
#pragma unroll
        for (int ai = 0; ai < 2; ++ai)
#pragma unroll
            for (int m = 0; m < 4; ++m) { bf16* rowp = O + (size_t)(row0 + ai * 128 + m * 16) * ldc + col0;
#pragma unroll
                for (int bj = 0; bj < 2; ++bj) { const pg8::f32x4 v0 = acc[ai][bj][m][0], v1 = acc[ai][bj][m][1];
                    v4u w; w.x = pg8::cvt_pk_bf16(v0[0], v0[1]); w.y = pg8::cvt_pk_bf16(v0[2], v0[3]); w.z = pg8::cvt_pk_bf16(v1[0], v1[1]); w.w = pg8::cvt_pk_bf16(v1[2], v1[3]);
                    *(v4u*)(rowp + bj * 128) = w; } }
    }
};
struct EpiProj0 {
    static constexpr bool PERM = true;
    bf16* O; const float* oml; const float* tab;
    __device__ __forceinline__ void operator()(const pg8::f32x4 (&acc)[2][2][4][2], const pg8::Unit& u, int wr, int wc, int fr, int fq) const {
        const int row0 = u.arow0 + wr * 64 + fr, colt = wc * 32 + 8 * fq, col0 = u.pn * 256 + colt;
        const int kind = (u.pn < 2 || u.pn == 8 || u.pn == 9) ? 1 : ((u.pn >= 4 && u.pn < 8) ? 2 : ((u.pn >= 10 && u.pn < 14) ? 3 : 0));
        const bool ropew = (kind == 3) && ((wc & 1) == 0);
#pragma unroll
        for (int ai = 0; ai < 2; ++ai)
#pragma unroll
            for (int m = 0; m < 4; ++m) { const int row = row0 + ai * 128 + m * 16; bf16* rowp = O + (size_t)row * P0W + col0;
                pg8::f32x4 cs0 = {0.f, 0.f, 0.f, 0.f}, cs1 = cs0, sn0 = cs0, sn1 = cs0;
                if (ropew) { const pg8::f32x4* tp = (const pg8::f32x4*)(tab + (size_t)(row & (NT_ - 1)) * 16); cs0 = tp[0]; cs1 = tp[1]; sn0 = tp[2]; sn1 = tp[3]; if (fq == 0) { sn0 = -sn0; sn1 = -sn1; } }
#pragma unroll
                for (int bj = 0; bj < 2; ++bj) { pg8::f32x4 v0 = acc[ai][bj][m][0], v1 = acc[ai][bj][m][1];
                    if (kind == 1) {
#pragma unroll
                        for (int j = 0; j < 4; ++j) { v0[j] = silu(v0[j]); v1[j] = silu(v1[j]); } }
                    else if (kind == 2) { const float* op = oml + (u.pn - 4) * 256 + bj * 128 + colt; const pg8::f32x4 o0 = *(const pg8::f32x4*)op, o1 = *(const pg8::f32x4*)(op + 4);
#pragma unroll
                        for (int j = 0; j < 4; ++j) { v0[j] = o0[j] * sigm(-v0[j]); v1[j] = o1[j] * sigm(-v1[j]); } }
                    else if (ropew) { pg8::f32x4 p0, p1;
#pragma unroll
                        for (int j = 0; j < 4; ++j) { p0[j] = __shfl_xor(v0[j], 16); p1[j] = __shfl_xor(v1[j], 16); }
                        if (fq < 2) { v0 = v0 * cs0 + p0 * sn0; v1 = v1 * cs1 + p1 * sn1; } }
                    v4u w; w.x = pg8::cvt_pk_bf16(v0[0], v0[1]); w.y = pg8::cvt_pk_bf16(v0[2], v0[3]); w.z = pg8::cvt_pk_bf16(v1[0], v1[1]); w.w = pg8::cvt_pk_bf16(v1[2], v1[3]);
                    *(v4u*)(rowp + bj * 128) = w; } }
    }
};
struct EpiResid {
    static constexpr bool PERM = false;
    const float* xin; float* out; const float* gm;
    __device__ __forceinline__ void operator()(const pg8::f32x4 (&acc)[2][2][4][2], const pg8::Unit& u, int wr, int wc, int fr, int fq) const {
        const int row0 = u.arow0 + wr * 64 + fr, col0 = u.pn * 256 + wc * 32 + 4 * fq;
#pragma unroll
        for (int ai = 0; ai < 2; ++ai)
#pragma unroll
            for (int m = 0; m < 4; ++m) { const int row = row0 + ai * 128 + m * 16; const float* gp = gm + (size_t)(row >> 12) * 6144 + col0; const size_t ro = (size_t)row * DM + col0;
#pragma unroll
                for (int bj = 0; bj < 2; ++bj)
#pragma unroll
                    for (int n = 0; n < 2; ++n) { const int c = bj * 128 + n * 16;
                        const pg8::f32x4 x4 = *(const pg8::f32x4*)(xin + ro + c), g4 = *(const pg8::f32x4*)(gp + c);
                        *(pg8::f32x4*)(out + ro + c) = x4 + g4 * acc[ai][bj][m][n]; } }
    }
};
struct EpiF32 {
    static constexpr bool PERM = false;
    float* C; int ldc;
    __device__ __forceinline__ void operator()(const pg8::f32x4 (&acc)[2][2][4][2], const pg8::Unit& u, int wr, int wc, int fr, int fq) const {
        const int row0 = u.arow0 + wr * 64 + fr, col0 = u.pn * 256 + wc * 32 + 4 * fq;
#pragma unroll
        for (int ai = 0; ai < 2; ++ai)
#pragma unroll
            for (int m = 0; m < 4; ++m) { float* rowp = C + (size_t)(row0 + ai * 128 + m * 16) * ldc + col0;
#pragma unroll
                for (int bj = 0; bj < 2; ++bj)
#pragma unroll
                    for (int n = 0; n < 2; ++n) *(pg8::f32x4*)(rowp + bj * 128 + n * 16) = acc[ai][bj][m][n]; }
    }
};
struct EpiGateUp {
    static constexpr bool PERM = true;
    bf16* HB;
    __device__ __forceinline__ void operator()(const pg8::f32x4 (&acc)[2][2][4][2], const pg8::Unit& u, int wr, int wc, int fr, int fq) const {
        const int col0 = u.pn * 128 + wc * 32 + 8 * fq;
#pragma unroll
        for (int ai = 0; ai < 2; ++ai)
#pragma unroll
            for (int m = 0; m < 4; ++m) { const int rl = ai * 128 + wr * 64 + m * 16 + fr;
                float y[8];
#pragma unroll
                for (int n = 0; n < 2; ++n)
#pragma unroll
                    for (int j = 0; j < 4; ++j) y[4 * n + j] = silu(acc[ai][0][m][n][j]) * acc[ai][1][m][n][j];
                if (rl < u.nvalid) *(v4u*)(HB + (size_t)(u.arow0 + rl) * EFF + col0) = pack8(y); }
    }
};
struct EpiDown {
    static constexpr bool PERM = true;
    unsigned char* Y;
    __device__ __forceinline__ void operator()(const pg8::f32x4 (&acc)[2][2][4][2], const pg8::Unit& u, int wr, int wc, int fr, int fq) const {
        const int col0 = u.pn * 256 + wc * 32 + 8 * fq;
#pragma unroll
        for (int ai = 0; ai < 2; ++ai)
#pragma unroll
            for (int m = 0; m < 4; ++m) { const int rl = ai * 128 + wr * 64 + m * 16 + fr; unsigned char* rowp = Y + (size_t)(u.arow0 + rl) * DM + col0;
#pragma unroll
                for (int bj = 0; bj < 2; ++bj) { const pg8::f32x4 v0 = acc[ai][bj][m][0] * 8.f, v1 = acc[ai][bj][m][1] * 8.f;
                    u32x2 w; w.x = 0u; w.y = 0u;
                    w.x = __builtin_amdgcn_cvt_pk_fp8_f32(v0[0], v0[1], w.x, false); w.x = __builtin_amdgcn_cvt_pk_fp8_f32(v0[2], v0[3], w.x, true);
                    w.y = __builtin_amdgcn_cvt_pk_fp8_f32(v1[0], v1[1], w.y, false); w.y = __builtin_amdgcn_cvt_pk_fp8_f32(v1[2], v1[3], w.y, true);
                    if (rl < u.nvalid) *(u32x2*)(rowp + bj * 128) = w; } }
    }
};

__device__ __forceinline__ void moe_tables(const unsigned* cntg, LAS int* tb, int tid) {
    LAS int* cnt = tb; LAS int* start = tb + 130; LAS int* tpre = tb + 260;
    __syncthreads();
    if (tid < NEXP) cnt[tid] = (int)__hip_atomic_load(cntg + tid, __ATOMIC_RELAXED, __HIP_MEMORY_SCOPE_AGENT);
    if (tid == NEXP) cnt[NEXP] = NTOK;
    __syncthreads();
    if (tid == 0) { int s = 0, t = 0; for (int e = 0; e < NEXP; ++e) { start[e] = s; tpre[e] = t; s += cnt[e]; t += (cnt[e] + 255) >> 8; }
        start[NEXP] = NSLOT; tpre[NEXP] = t; t += NTOK / 256; start[NEXP + 1] = NSLOT_ALL; tpre[NEXP + 1] = t; }
    __syncthreads();
}
struct GroupOrder {
    const LAS int* cnt; const LAS int* start; const LAS int* tpre; const int* list; int ntc, total, G, c;
    __device__ __forceinline__ void init(const LAS int* tb, const int* list_, int ntc_, int G_, int c_) { cnt = tb; start = tb + 130; tpre = tb + 260; list = list_; ntc = ntc_; total = tpre[NEXP + 1] * ntc_; G = G_; c = c_; }
    __device__ __forceinline__ bool next(int i, pg8::Unit& u) const {
        const int L = i * G + c; if (L >= total) return false;
        const int rt = L / ntc, pn = L - rt * ntc;
        int lo = 0, hi = NEXP + 1;
#pragma unroll 1
        while (hi - lo > 1) { const int mid = (lo + hi) >> 1; if (tpre[mid] <= rt) lo = mid; else hi = mid; }
        const int j = rt - tpre[lo], rem = cnt[lo] - 256 * j;
        u.pn = pn; u.arow0 = start[lo] + 256 * j; u.nvalid = rem < 256 ? rem : 256; u.bt = lo * ntc + pn; return true;
    }
    __device__ __forceinline__ int arow(const pg8::Unit& u, int r) const { const int idx = u.arow0 + (r < u.nvalid ? r : u.nvalid - 1); return list ? list[idx] : idx; }
};

template <int CTRL> __device__ __forceinline__ float dppf(float v) { return __builtin_bit_cast(float, __builtin_amdgcn_update_dpp(0, __builtin_bit_cast(int, v), CTRL, 0xf, 0xf, false)); }
template <int CTRL> __device__ __forceinline__ int dppi(int v) { return __builtin_amdgcn_update_dpp(0, v, CTRL, 0xf, 0xf, false); }
#define TK_ROR(n) (0x120 + (n))
__device__ __forceinline__ void topk_phase(const float* LOG, const float* rbias, int* TOPI, float* TOPW, int* RANK, unsigned* cntg, LAS unsigned char* lds, int bx, int G, int wave, int tid) {
    const int lane = tid & 63, q = lane & 15, row = lane >> 4, g = q >> 1;
    LAS unsigned* hist = (LAS unsigned*)lds; LAS unsigned* base = hist + 128; LAS unsigned short* le = (LAS unsigned short*)(lds + 1024); LAS unsigned short* lr = le + 1024;
    float bias[8]; { const f32x4 b0 = *(const f32x4*)(rbias + 8 * q), b1 = *(const f32x4*)(rbias + 8 * q + 4); bias[0] = b0.x; bias[1] = b0.y; bias[2] = b0.z; bias[3] = b0.w; bias[4] = b1.x; bias[5] = b1.y; bias[6] = b1.z; bias[7] = b1.w; }
    for (int blk = bx; blk < NTOK / 128; blk += G) {
        __syncthreads();
        if (tid < 128) hist[tid] = 0u;
        __syncthreads();
#pragma unroll 1
        for (int bt = 0; bt < 4; ++bt) {
            const int tl = wave * 16 + bt * 4 + row, tok = blk * 128 + tl;
            float sc[8], v[8];
            { const f32x4 l0 = *(const f32x4*)(LOG + (size_t)tok * 256 + 8 * q), l1 = *(const f32x4*)(LOG + (size_t)tok * 256 + 8 * q + 4);
              sc[0] = sigm_div(l0.x); sc[1] = sigm_div(l0.y); sc[2] = sigm_div(l0.z); sc[3] = sigm_div(l0.w); sc[4] = sigm_div(l1.x); sc[5] = sigm_div(l1.y); sc[6] = sigm_div(l1.z); sc[7] = sigm_div(l1.w); }
            float m1 = -INFINITY, m2 = -INFINITY;
#pragma unroll
            for (int j = 0; j < 8; ++j) { v[j] = sc[j] + bias[j]; const float lo = fminf(m1, v[j]); m1 = fmaxf(m1, v[j]); m2 = fmaxf(m2, lo); }
            { const float o1 = dppf<0xB1>(m1), o2 = dppf<0xB1>(m2); const float n1 = fmaxf(m1, o1), n2 = fmaxf(fminf(m1, o1), fmaxf(m2, o2)); m1 = n1; m2 = n2; }
            const float gs = m1 + m2; int better = 0;
#define TK_RANK(n) { const float og = dppf<TK_ROR(n)>(gs); const int oi = dppi<TK_ROR(n)>(g); better += (og > gs || (og == gs && oi < g)) ? 1 : 0; }
            TK_RANK(2) TK_RANK(4) TK_RANK(6) TK_RANK(8) TK_RANK(10) TK_RANK(12) TK_RANK(14)
#undef TK_RANK
            if (better >= 4) {
#pragma unroll
                for (int j = 0; j < 8; ++j) v[j] = -INFINITY; }
            int my_e = 0; float my_s = 0.f, ssum = 0.f;
#pragma unroll
            for (int k = 0; k < 8; ++k) {
                float bv = v[0], bs = sc[0]; int bi = 8 * q;
#pragma unroll
                for (int j = 1; j < 8; ++j) { const bool t = v[j] > bv; bv = t ? v[j] : bv; bs = t ? sc[j] : bs; bi = t ? 8 * q + j : bi; }
#define TK_STEP(n) { const float ov = dppf<TK_ROR(n)>(bv), os = dppf<TK_ROR(n)>(bs); const int oi = dppi<TK_ROR(n)>(bi); const bool t = (ov > bv) || (ov == bv && oi < bi); bv = t ? ov : bv; bs = t ? os : bs; bi = t ? oi : bi; }
                TK_STEP(1) TK_STEP(2) TK_STEP(4) TK_STEP(8)
#undef TK_STEP
#pragma unroll
                for (int j = 0; j < 8; ++j) v[j] = (bi == 8 * q + j) ? -INFINITY : v[j];
                if (q == k) { my_e = bi; my_s = bs; }
                ssum += bs;
            }
            if (q < 8) {
                const unsigned rk = __hip_atomic_fetch_add(hist + my_e, 1u, __ATOMIC_RELAXED, __HIP_MEMORY_SCOPE_WORKGROUP);
                TOPI[tok * 8 + q] = my_e; TOPW[tok * 8 + q] = my_s / ssum * 2.5f; le[tl * 8 + q] = (unsigned short)my_e; lr[tl * 8 + q] = (unsigned short)rk;
            }
        }
        __syncthreads();
        if (tid < 128) base[tid] = __hip_atomic_fetch_add(cntg + tid, hist[tid], __ATOMIC_RELAXED, __HIP_MEMORY_SCOPE_AGENT);
        __syncthreads();
        for (int i = tid; i < 1024; i += 512) RANK[blk * 1024 + i] = (int)(base[le[i]] + lr[i]);
    }
}
__device__ __forceinline__ void list_phase(const int* TOPI, const int* RANK, int* SLOT, int* LIST, const LAS int* tb, int gtid, int NGT) {
    const LAS int* start = tb + 130;
    for (int p = gtid; p < NSLOT; p += NGT) { const int s = start[TOPI[p]] + RANK[p]; SLOT[p] = s; LIST[s] = p >> 3; }
    for (int i = gtid; i < NTOK; i += NGT) LIST[NSLOT + i] = i;
}
__device__ __forceinline__ void combine_phase(float* X, const unsigned char* Y, const int* SLOT, const float* TOPW, const float* modl, int g_off,
                                              const float* ngain, const float* modn, int sh_off, int sc_off, bf16* H, const float* fgain, int gw, int NGW, int lane) {
    for (int m0 = gw; m0 < NTOK; m0 += 2 * NGW) {
        const int mm[2] = {m0, m0 + NGW}; const bool has2 = (m0 + NGW) < NTOK;
        int sl[2]; float wl[2];
#pragma unroll
        for (int q = 0; q < 2; ++q) { const int m = (q == 0 || has2) ? mm[q] : m0; sl[q] = (lane < 8) ? SLOT[m * 8 + lane] : NSLOT + m; wl[q] = (lane < 8) ? TOPW[m * 8 + lane] : 1.f; }
        f32x4 acc[2][4]; f32x4 xv[2][4];
#pragma unroll
        for (int q = 0; q < 2; ++q) { const int m = (q == 0 || has2) ? mm[q] : m0; const f32x4* xr = (const f32x4*)(X + (size_t)m * DM) + lane;
#pragma unroll
            for (int j = 0; j < 4; ++j) { acc[q][j] = (f32x4){0.f, 0.f, 0.f, 0.f}; xv[q][j] = xr[64 * j]; } }
#pragma unroll
        for (int k = 0; k < 9; ++k)
#pragma unroll
            for (int q = 0; q < 2; ++q) { const int s = __shfl(sl[q], k); const float w = __shfl(wl[q], k) * 0.125f;
                const unsigned* yr = (const unsigned*)(Y + (size_t)s * DM) + lane;
#pragma unroll
                for (int j = 0; j < 4; ++j) { const unsigned qv = yr[64 * j]; const f32x2 lo = __builtin_amdgcn_cvt_pk_f32_fp8(qv, false), hi = __builtin_amdgcn_cvt_pk_f32_fp8(qv, true);
                    acc[q][j] += (f32x4){lo.x, lo.y, hi.x, hi.y} * w; } }
#pragma unroll
        for (int q = 0; q < 2; ++q) { if (q == 1 && !has2) break; const int m = mm[q];
            f32x4* xr = (f32x4*)(X + (size_t)m * DM) + lane; const float* mb = modl + (size_t)(m >> 12) * 6144; f32x4 v[4];
#pragma unroll
            for (int j = 0; j < 4; ++j) v[j] = xv[q][j] + ((const f32x4*)(mb + g_off))[lane + 64 * j] * acc[q][j];
            if (fgain) finalnorm_row(v, fgain, X + (size_t)m * DM, lane);
            else {
#pragma unroll
                for (int j = 0; j < 4; ++j) xr[64 * j] = v[j];
                const float* mn = modn + (size_t)(m >> 12) * 6144;
                normmod_row(v, ngain, mn + sh_off, mn + sc_off, H + (size_t)m * DM, lane);
            } }
    }
}
__device__ __forceinline__ int q_pull(gu32* head, volatile LAS unsigned* slot, int tid) {
    __syncthreads();
    if (tid == 0) *slot = __hip_atomic_fetch_add(head, 1u, RLX_AGENT);
    __syncthreads();
    return (int)*slot;
}

__device__ __forceinline__ void convqk_phase(const bf16* P, const float* cw, const float* cb, bf16* QKC, int gtid, int NGT) {
    for (int idx = gtid; idx < NTOK * 128; idx += NGT) {
        const int tok = idx >> 7, c0 = (idx & 127) * 8, t = tok & (NT_ - 1);
        float acc[8];
#pragma unroll
        for (int i = 0; i < 8; ++i) acc[i] = cb[c0 + i];
#pragma unroll
        for (int j = 0; j < 5; ++j) { const int tj = t + j - 2;
            if (tj >= 0 && tj < NT_) { float x[8]; unpack8(*(const v4u*)(P + (size_t)(tok + j - 2) * P1W + c0), x);
#pragma unroll
                for (int i = 0; i < 8; ++i) acc[i] += cw[j * 1024 + c0 + i] * x[i]; } }
        const float sc = (c0 >= GW) ? 0.08838834764831845f : 1.f;
#pragma unroll
        for (int i = 0; i < 8; ++i) acc[i] = silu(acc[i]) * sc;
        *(v4u*)(QKC + (size_t)tok * DM + c0) = pack8(acc);
    }
}
namespace da {
using bf16x8 = __attribute__((ext_vector_type(8))) short;
using s16x4  = __attribute__((ext_vector_type(4))) short;
using f32x16 = __attribute__((ext_vector_type(16))) float;
constexpr float SCALE = 0.125f;
constexpr float THR = 8.f;
constexpr int KVBLK = 64, SHM_V = 16384, SHM_K = 16384;
#define DA_KSWZ(row, colB) ((row) * 256 + ((colB) ^ (((row) & 7) << 4)))
#define DA_SBAR() __builtin_amdgcn_sched_barrier(0)
#define DA_LBAR() do { asm volatile("s_waitcnt lgkmcnt(0)" ::: "memory"); __builtin_amdgcn_s_barrier(); asm volatile("" ::: "memory"); } while (0)
__device__ __forceinline__ int crow(int r, int hi) { return (r & 3) + 8 * (r >> 2) + 4 * hi; }
__device__ __forceinline__ unsigned cvtpk(float lo, float hi) { unsigned r; asm volatile("v_cvt_pk_bf16_f32 %0, %1, %2" : "=v"(r) : "v"(lo), "v"(hi)); return r; }
__device__ __forceinline__ void partialSM(f32x16& p0, f32x16& p1, float& m_reg, float& mn, float& alpha) {
  constexpr float C = SCALE * 1.4426950408889634f;
  float pmax = p0[0];
#pragma unroll
  for (int r = 1; r < 16; ++r) pmax = fmaxf(pmax, p0[r]);
#pragma unroll
  for (int r = 0; r < 16; ++r) pmax = fmaxf(pmax, p1[r]);
  { auto rr = __builtin_amdgcn_permlane32_swap(__float_as_uint(pmax), __float_as_uint(pmax), false, false);
    pmax = fmaxf(__uint_as_float(rr[0]), __uint_as_float(rr[1])); }
  if (__builtin_expect(__all(pmax - m_reg <= THR / SCALE), 1)) { mn = m_reg; alpha = 1.f; }
  else { mn = fmaxf(m_reg, pmax); alpha = __builtin_amdgcn_exp2f((m_reg - mn) * C); m_reg = mn; }
  float mnC = -mn * C;
#pragma unroll
  for (int r = 0; r < 16; ++r) p0[r] = fmaf(p0[r], C, mnC);
#pragma unroll
  for (int r = 0; r < 16; ++r) p1[r] = fmaf(p1[r], C, mnC);
#pragma unroll
  for (int r = 0; r < 16; ++r) p0[r] = __builtin_amdgcn_exp2f(p0[r]);
}
__device__ __forceinline__ void finishSM(f32x16& p0, f32x16& p1, float alpha, float& l_reg, bf16x8& pa0, bf16x8& pa1, bf16x8& pa2, bf16x8& pa3) {
#pragma unroll
  for (int r = 0; r < 16; ++r) p1[r] = __builtin_amdgcn_exp2f(p1[r]);
  float ps = 0;
#pragma unroll
  for (int r = 0; r < 16; ++r) ps += p0[r];
#pragma unroll
  for (int r = 0; r < 16; ++r) ps += p1[r];
  { auto rr = __builtin_amdgcn_permlane32_swap(__float_as_uint(ps), __float_as_uint(ps), false, false);
    ps = __uint_as_float(rr[0]) + __uint_as_float(rr[1]); }
  l_reg = l_reg * alpha + ps;
#define DA_PK4(P, BASE, OUT) do { unsigned a0 = cvtpk(P[BASE + 0], P[BASE + 1]), a1 = cvtpk(P[BASE + 2], P[BASE + 3]);   \
    unsigned b0 = cvtpk(P[BASE + 4], P[BASE + 5]), b1 = cvtpk(P[BASE + 6], P[BASE + 7]);                              \
    auto r0 = __builtin_amdgcn_permlane32_swap(a0, b0, false, false); auto r1 = __builtin_amdgcn_permlane32_swap(a1, b1, false, false); \
    v4u w = {r0[0], r1[0], r0[1], r1[1]}; OUT = __builtin_bit_cast(bf16x8, w); } while (0)
  DA_PK4(p0, 0, pa0); DA_PK4(p0, 8, pa1); DA_PK4(p1, 0, pa2); DA_PK4(p1, 8, pa3);
#undef DA_PK4
}
__device__ __forceinline__ void qkt(f32x16& p0, f32x16& p1, const LAS char* Ks, const bf16x8 (&qr)[4], int r32, int hi, int mapB) {
  p0 = f32x16{}; p1 = f32x16{};
#pragma unroll
  for (int d0 = 0; d0 < 4; ++d0) { const int cb = mapB + (d0 * 16 + hi * 8) * 2;
    const bf16x8 b0 = *(const LAS bf16x8*)(Ks + DA_KSWZ(r32, cb));
    const bf16x8 b1 = *(const LAS bf16x8*)(Ks + DA_KSWZ(32 + r32, cb));
    p0 = __builtin_amdgcn_mfma_f32_32x32x16_bf16(b0, qr[d0], p0, 0, 0, 0);
    p1 = __builtin_amdgcn_mfma_f32_32x32x16_bf16(b1, qr[d0], p1, 0, 0, 0); }
}
__device__ __forceinline__ int v_st(int k, int c) { const int kk = (k & ~0xC) | ((k & 4) << 1) | ((k & 8) >> 1); return ((kk >> 3) * 4 + (c >> 5)) * 512 + ((kk & 7) * 32 + (c & 31)) * 2; }
__device__ __forceinline__ int v_rd_base(int lane) { return ((lane & 3) << 3) | (((lane >> 2) & 3) << 6) | (((lane >> 4) & 1) << 5) | (((lane >> 5) & 1) << 8); }
constexpr int v_rd_off(int d0, int ks, int half) { return d0 * 512 + ks * 4096 + half * 2048; }
template <int OFF> __device__ __forceinline__ s16x4 tr_read(int vb) {
  s16x4 r; asm volatile("ds_read_b64_tr_b16 %0, %1 offset:%2" : "=&v"(r) : "v"(vb), "i"(OFF) : "memory"); return r;
}
template <int D0> __device__ __forceinline__ void pv_one(f32x16& od, int vb, bf16x8 pa0, bf16x8 pa1, bf16x8 pa2, bf16x8 pa3) {
  const s16x4 l0 = tr_read<v_rd_off(D0, 0, 0)>(vb), h0 = tr_read<v_rd_off(D0, 0, 1)>(vb), l1 = tr_read<v_rd_off(D0, 1, 0)>(vb), h1 = tr_read<v_rd_off(D0, 1, 1)>(vb);
  const s16x4 l2 = tr_read<v_rd_off(D0, 2, 0)>(vb), h2 = tr_read<v_rd_off(D0, 2, 1)>(vb), l3 = tr_read<v_rd_off(D0, 3, 0)>(vb), h3 = tr_read<v_rd_off(D0, 3, 1)>(vb);
  asm volatile("s_waitcnt lgkmcnt(0)" ::: "memory"); DA_SBAR();
#define DA_PK(L, H) (bf16x8){L[0], L[1], L[2], L[3], H[0], H[1], H[2], H[3]}
  od = __builtin_amdgcn_mfma_f32_32x32x16_bf16(pa0, DA_PK(l0, h0), od, 0, 0, 0);
  od = __builtin_amdgcn_mfma_f32_32x32x16_bf16(pa1, DA_PK(l1, h1), od, 0, 0, 0);
  od = __builtin_amdgcn_mfma_f32_32x32x16_bf16(pa2, DA_PK(l2, h2), od, 0, 0, 0);
  od = __builtin_amdgcn_mfma_f32_32x32x16_bf16(pa3, DA_PK(l3, h3), od, 0, 0, 0);
#undef DA_PK
}
__device__ __forceinline__ void pv_d0(f32x16 (&o)[4], int vb, bf16x8 pa0, bf16x8 pa1, bf16x8 pa2, bf16x8 pa3) {
  pv_one<0>(o[0], vb, pa0, pa1, pa2, pa3); pv_one<1>(o[1], vb, pa0, pa1, pa2, pa3); pv_one<2>(o[2], vb, pa0, pa1, pa2, pa3); pv_one<3>(o[3], vb, pa0, pa1, pa2, pa3);
}
__device__ __forceinline__ void unit(int u, const bf16* P, float lam, const float* subln, bf16* CAT, LAS char* lds, int tid) {
  const int qb = u & 31, h = (u >> 5) & 3, b = u >> 7;
  const int wid = tid >> 6, lane = tid & 63, r32 = lane & 31, hi = lane >> 5, mp = wid >> 2, wq = wid & 3;
  LAS char* V_lds = lds; LAS char* K_lds = lds + 2 * SHM_V;
  LAS float* ws = (LAS float*)(lds + 2 * SHM_V + 2 * SHM_K) + wid * 64; LAS float* li_l = ws; LAS float* al_l = ws + 32;
  float m_reg = -1e30f, l_reg = 0; f32x16 o[4] = {}; bf16x8 qr[4];
  const size_t rowbase = (size_t)b * NT_;
  const bf16* Qw = P + (rowbase + qb * 128 + wq * 32 + r32) * P0W + 2560 + h * 128 + mp * 64 + hi * 8;
#pragma unroll
  for (int d0 = 0; d0 < 4; ++d0) qr[d0] = *(const bf16x8*)(Qw + d0 * 16);
  const bf16* Kh = P + rowbase * P0W + 3072 + h * 128; const bf16* Vh = P + rowbase * P0W + 3584 + h * 128;
  const int mapB = mp * 128;
  const int sr = tid >> 4, sc = (tid & 15) * 8, vst0 = v_st(sr, sc), vst1 = v_st(32 + sr, sc);
  const int vb0 = (int)(uintptr_t)V_lds + v_rd_base(lane);
  struct { bf16x8 vs0, vs1, ks0, ks1; } sr_[2];
#define DA_SLOAD(i, k0) do { sr_[i].vs0 = *(const bf16x8*)(&Vh[(size_t)((k0) + sr) * P0W + sc]); sr_[i].vs1 = *(const bf16x8*)(&Vh[(size_t)((k0) + 32 + sr) * P0W + sc]); \
    sr_[i].ks0 = *(const bf16x8*)(&Kh[(size_t)((k0) + sr) * P0W + sc]); sr_[i].ks1 = *(const bf16x8*)(&Kh[(size_t)((k0) + 32 + sr) * P0W + sc]); } while (0)
#define DA_SWRITE(bb, i) do { *(LAS bf16x8*)(V_lds + (bb) * SHM_V + vst0) = sr_[i].vs0;          \
    *(LAS bf16x8*)(V_lds + (bb) * SHM_V + vst1) = sr_[i].vs1; const int kc = sc * 2;               \
    *(LAS bf16x8*)(K_lds + (bb) * SHM_K + DA_KSWZ(sr, kc)) = sr_[i].ks0;                       \
    *(LAS bf16x8*)(K_lds + (bb) * SHM_K + DA_KSWZ(32 + sr, kc)) = sr_[i].ks1; } while (0)
#define DA_SWAIT() asm volatile("s_waitcnt vmcnt(4)" ::: "memory")
#define DA_RESC(a) do { if (__any((a) < 1.f)) { if (hi == 0) al_l[r32] = (a); asm volatile("s_waitcnt lgkmcnt(0)" ::: "memory"); \
    _Pragma("unroll") for (int d = 0; d < 4; ++d) _Pragma("unroll") for (int r = 0; r < 16; ++r) o[d][r] *= al_l[crow(r, hi)]; } } while (0)
  f32x16 pA0, pA1, pB0, pB1; float mnA, mnB, alA, alB; bf16x8 pa0, pa1, pa2, pa3; constexpr int NT = NT_ / KVBLK;
  DA_SLOAD(0, 0); asm volatile("s_waitcnt vmcnt(0)" ::: "memory"); DA_SWRITE(0, 0); DA_LBAR();
  qkt(pA0, pA1, K_lds, qr, r32, hi, mapB); partialSM(pA0, pA1, m_reg, mnA, alA);
  DA_SLOAD(1, KVBLK); DA_SLOAD(0, 2 * KVBLK);
  DA_SWAIT(); DA_SWRITE(1, 1); DA_LBAR();
  for (int j = 1; j + 1 < NT; j += 2) {
    DA_SBAR(); qkt(pB0, pB1, K_lds + SHM_K, qr, r32, hi, mapB);
    finishSM(pA0, pA1, alA, l_reg, pa0, pa1, pa2, pa3); DA_SBAR();
    DA_SLOAD(1, (j + 2) * KVBLK); DA_SBAR();
    pv_d0(o, vb0, pa0, pa1, pa2, pa3); partialSM(pB0, pB1, m_reg, mnB, alB);
    DA_LBAR(); DA_SWAIT(); DA_SWRITE(0, 0);
    DA_RESC(alB); DA_LBAR();
    DA_SBAR(); qkt(pA0, pA1, K_lds, qr, r32, hi, mapB);
    finishSM(pB0, pB1, alB, l_reg, pa0, pa1, pa2, pa3); DA_SBAR();
    if (j + 3 < NT) DA_SLOAD(0, (j + 3) * KVBLK); DA_SBAR();
    pv_d0(o, vb0 + SHM_V, pa0, pa1, pa2, pa3); partialSM(pA0, pA1, m_reg, mnA, alA);
    DA_LBAR(); DA_SWAIT(); DA_SWRITE(1, 1);
    DA_RESC(alA); DA_LBAR();
  }
  DA_SBAR(); qkt(pB0, pB1, K_lds + SHM_K, qr, r32, hi, mapB);
  finishSM(pA0, pA1, alA, l_reg, pa0, pa1, pa2, pa3); DA_SBAR();
  pv_d0(o, vb0, pa0, pa1, pa2, pa3); partialSM(pB0, pB1, m_reg, mnB, alB);
  DA_LBAR(); DA_RESC(alB);
  finishSM(pB0, pB1, alB, l_reg, pa0, pa1, pa2, pa3); DA_SBAR();
  pv_d0(o, vb0 + SHM_V, pa0, pa1, pa2, pa3);
  if (hi == 0) li_l[r32] = l_reg; asm volatile("s_waitcnt lgkmcnt(0)" ::: "memory");
  float rli[16];
#pragma unroll
  for (int r = 0; r < 16; ++r) rli[r] = __builtin_amdgcn_rcpf(li_l[crow(r, hi)]);
  DA_LBAR();
  LAS float* X = (LAS float*)lds;
  if (mp == 1) {
#pragma unroll
    for (int d0 = 0; d0 < 4; ++d0)
#pragma unroll
      for (int r = 0; r < 16; ++r) X[(wq * 32 + crow(r, hi)) * 128 + d0 * 32 + r32] = o[d0][r] * rli[r];
  }
  DA_LBAR();
  if (mp == 0) {
#pragma unroll
    for (int d0 = 0; d0 < 4; ++d0)
#pragma unroll
      for (int r = 0; r < 16; ++r) { const int ix = (wq * 32 + crow(r, hi)) * 128 + d0 * 32 + r32; X[ix] = o[d0][r] * rli[r] - lam * X[ix]; }
  }
  DA_LBAR();
  { const int row = tid >> 2, qtr = tid & 3; const LAS f32x4* xp = (const LAS f32x4*)(X + row * 128 + qtr * 32); f32x4 xv[8]; float ss = 0.f;
#pragma unroll
    for (int i = 0; i < 8; ++i) { xv[i] = xp[i]; ss += (xv[i].x * xv[i].x + xv[i].y * xv[i].y) + (xv[i].z * xv[i].z + xv[i].w * xv[i].w); }
    ss += __shfl_xor(ss, 1); ss += __shfl_xor(ss, 2);
    const float rr = 0.8f / sqrtf(ss * (1.f / 128.f) + EPS);
    bf16* op = CAT + (rowbase + qb * 128 + row) * DM + GW + h * 128 + qtr * 32;
#pragma unroll
    for (int i = 0; i < 4; ++i) { const f32x4 g0 = *(const f32x4*)(subln + qtr * 32 + i * 8), g1 = *(const f32x4*)(subln + qtr * 32 + i * 8 + 4);
      const f32x4 y0 = xv[2 * i] * rr * g0, y1 = xv[2 * i + 1] * rr * g1;
      v4u w; w.x = pk2(y0.x, y0.y); w.y = pk2(y0.z, y0.w); w.z = pk2(y1.x, y1.y); w.w = pk2(y1.z, y1.w);
      *(v4u*)(op + i * 8) = w; } }
  DA_LBAR();
#undef DA_SLOAD
#undef DA_SWRITE
#undef DA_SWAIT
#undef DA_RESC
}
}
namespace na {
using da::bf16x8; using da::s16x4; using da::f32x16;
__device__ __forceinline__ int v_st2(int k, int c) { const int kk = (k & ~0xC) | ((k & 4) << 1) | ((k & 8) >> 1); return ((kk >> 3) * 2 + (c >> 5)) * 512 + ((kk & 7) * 32 + (c & 31)) * 2; }
constexpr int v_rd_off2(int d0, int ks, int half) { return d0 * 512 + ks * 2048 + half * 1024; }
template <int D0> __device__ __forceinline__ void pv_one2(f32x16& od, int vb, bf16x8 pa0, bf16x8 pa1, bf16x8 pa2, bf16x8 pa3) {
  const s16x4 l0 = da::tr_read<v_rd_off2(D0, 0, 0)>(vb), h0 = da::tr_read<v_rd_off2(D0, 0, 1)>(vb), l1 = da::tr_read<v_rd_off2(D0, 1, 0)>(vb), h1 = da::tr_read<v_rd_off2(D0, 1, 1)>(vb);
  const s16x4 l2 = da::tr_read<v_rd_off2(D0, 2, 0)>(vb), h2 = da::tr_read<v_rd_off2(D0, 2, 1)>(vb), l3 = da::tr_read<v_rd_off2(D0, 3, 0)>(vb), h3 = da::tr_read<v_rd_off2(D0, 3, 1)>(vb);
  asm volatile("s_waitcnt lgkmcnt(0)" ::: "memory"); DA_SBAR();
#define NA_PK(L, H) (bf16x8){L[0], L[1], L[2], L[3], H[0], H[1], H[2], H[3]}
  od = __builtin_amdgcn_mfma_f32_32x32x16_bf16(pa0, NA_PK(l0, h0), od, 0, 0, 0);
  od = __builtin_amdgcn_mfma_f32_32x32x16_bf16(pa1, NA_PK(l1, h1), od, 0, 0, 0);
  od = __builtin_amdgcn_mfma_f32_32x32x16_bf16(pa2, NA_PK(l2, h2), od, 0, 0, 0);
  od = __builtin_amdgcn_mfma_f32_32x32x16_bf16(pa3, NA_PK(l3, h3), od, 0, 0, 0);
#undef NA_PK
}
__device__ __forceinline__ void qtile(const bf16x8 (&kf)[2][4], const bf16x8 (&qr)[4], int col, const LAS float* brow, float& m_reg, float& l_reg, f32x16& o0, f32x16& o1,
                                      LAS float* al_l, int vb, int r32, int hi) {
  constexpr float C = 0.125f * 1.4426950408889634f, L2E = 1.4426950408889634f;
  f32x16 p0 = {}, p1 = {};
#pragma unroll
  for (int d0 = 0; d0 < 4; ++d0) { p0 = __builtin_amdgcn_mfma_f32_32x32x16_bf16(kf[0][d0], qr[d0], p0, 0, 0, 0); p1 = __builtin_amdgcn_mfma_f32_32x32x16_bf16(kf[1][d0], qr[d0], p1, 0, 0, 0); }
  int cs = col - 8; cs = cs < 0 ? 0 : (cs > 48 ? 48 : cs);
  float pmax = -INFINITY;
  const LAS float* ab = brow + (15 - col + 4 * hi); const int kofs = 4 * hi - cs;
#pragma unroll
  for (int r = 0; r < 16; ++r) { const int kr = (r & 3) + 8 * (r >> 2);
      const float s = fmaf(p0[r], C, ab[kr] * L2E); p0[r] = ((unsigned)(kr + kofs) < 16u) ? s : -INFINITY; pmax = fmaxf(pmax, p0[r]); }
#pragma unroll
  for (int r = 0; r < 16; ++r) { const int kr = 32 + (r & 3) + 8 * (r >> 2);
      const float s = fmaf(p1[r], C, ab[kr] * L2E); p1[r] = ((unsigned)(kr + kofs) < 16u) ? s : -INFINITY; pmax = fmaxf(pmax, p1[r]); }
  { auto rr = __builtin_amdgcn_permlane32_swap(__float_as_uint(pmax), __float_as_uint(pmax), false, false); pmax = fmaxf(__uint_as_float(rr[0]), __uint_as_float(rr[1])); }
  const float mn = fmaxf(m_reg, pmax), alpha = __builtin_amdgcn_exp2f(m_reg - mn); m_reg = mn;
  float ps = 0.f;
#pragma unroll
  for (int r = 0; r < 16; ++r) { p0[r] = __builtin_amdgcn_exp2f(p0[r] - mn); ps += p0[r]; }
#pragma unroll
  for (int r = 0; r < 16; ++r) { p1[r] = __builtin_amdgcn_exp2f(p1[r] - mn); ps += p1[r]; }
  { auto rr = __builtin_amdgcn_permlane32_swap(__float_as_uint(ps), __float_as_uint(ps), false, false); ps = __uint_as_float(rr[0]) + __uint_as_float(rr[1]); }
  l_reg = l_reg * alpha + ps;
  if (hi == 0) al_l[r32] = alpha; asm volatile("s_waitcnt lgkmcnt(0)" ::: "memory");
#pragma unroll
  for (int r = 0; r < 16; ++r) { const float a = al_l[da::crow(r, hi)]; o0[r] *= a; o1[r] *= a; }
  bf16x8 pa0, pa1, pa2, pa3;
#define NA_PK4(Pv, BASE, OUT) do { unsigned a0 = da::cvtpk(Pv[BASE + 0], Pv[BASE + 1]), a1 = da::cvtpk(Pv[BASE + 2], Pv[BASE + 3]);   \
    unsigned b0 = da::cvtpk(Pv[BASE + 4], Pv[BASE + 5]), b1 = da::cvtpk(Pv[BASE + 6], Pv[BASE + 7]);                              \
    auto r0 = __builtin_amdgcn_permlane32_swap(a0, b0, false, false); auto r1 = __builtin_amdgcn_permlane32_swap(a1, b1, false, false); \
    v4u w = {r0[0], r1[0], r0[1], r1[1]}; OUT = __builtin_bit_cast(bf16x8, w); } while (0)
  NA_PK4(p0, 0, pa0); NA_PK4(p0, 8, pa1); NA_PK4(p1, 0, pa2); NA_PK4(p1, 8, pa3);
#undef NA_PK4
  pv_one2<0>(o0, vb, pa0, pa1, pa2, pa3); pv_one2<1>(o1, vb, pa0, pa1, pa2, pa3);
}
__device__ __forceinline__ void item(int it, const bf16* P, const LAS float* BT, bf16* CAT, LAS char* vl, int lane) {
  const int head = it & 7, r = (it >> 3) & 63, b = it >> 9, r32 = lane & 31, hi = lane >> 5;
  const int tok0 = b * NT_ + r * 64; int rs = r - 4; rs = rs < 0 ? 0 : (rs > 56 ? 56 : rs);
  LAS float* li_l = (LAS float*)(vl + 8192); LAS float* al_l = li_l + 32;
  const int vb = (int)(uintptr_t)vl + da::v_rd_base(lane);
  bf16x8 q0[4], q1[4];
  { const bf16* qp = P + (size_t)(tok0 + r32) * P1W + 2048 + head * 64 + hi * 8;
#pragma unroll
    for (int d0 = 0; d0 < 4; ++d0) { q0[d0] = *(const bf16x8*)(qp + d0 * 16); q1[d0] = *(const bf16x8*)(qp + (size_t)32 * P1W + d0 * 16); } }
  f32x16 o00 = {}, o01 = {}, o10 = {}, o11 = {}; float m0 = -1e30f, m1 = -1e30f, l0 = 0.f, l1 = 0.f;
#pragma unroll 1
  for (int i = 0; i < 8; ++i) {
    const int krow0 = b * NT_ + (rs + i) * 64;
    bf16x8 kf[2][4], vv[8];
    { const bf16* kp = P + (size_t)(krow0 + r32) * P1W + 2560 + head * 64 + hi * 8;
#pragma unroll
      for (int d0 = 0; d0 < 4; ++d0) { kf[0][d0] = *(const bf16x8*)(kp + d0 * 16); kf[1][d0] = *(const bf16x8*)(kp + (size_t)32 * P1W + d0 * 16); }
      const bf16* vp = P + (size_t)(krow0 + lane) * P1W + 3072 + head * 64;
#pragma unroll
      for (int c8 = 0; c8 < 8; ++c8) vv[c8] = *(const bf16x8*)(vp + c8 * 8); }
#pragma unroll
    for (int c8 = 0; c8 < 8; ++c8) *(LAS bf16x8*)(vl + v_st2(lane, c8 * 8)) = vv[c8];
    asm volatile("s_waitcnt lgkmcnt(0)" ::: "memory");
    const LAS float* brow = BT + head * 465 + (rs + i - r + 7) * 31;
    int r32i = r32; asm volatile("" : "+v"(r32i));
    qtile(kf, q0, r32i, brow, m0, l0, o00, o01, al_l, vb, r32, hi);
    qtile(kf, q1, 32 + r32i, brow, m1, l1, o10, o11, al_l, vb, r32, hi);
  }
  bf16* op = CAT + (size_t)tok0 * DM + GW + head * 64 + r32;
  if (hi == 0) li_l[r32] = l0; asm volatile("s_waitcnt lgkmcnt(0)" ::: "memory");
#pragma unroll
  for (int rr = 0; rr < 16; ++rr) { const int qrow = da::crow(rr, hi); const float il = __builtin_amdgcn_rcpf(li_l[qrow]);
      op[(size_t)qrow * DM] = (bf16)f2bf(o00[rr] * il); op[(size_t)qrow * DM + 32] = (bf16)f2bf(o01[rr] * il); }
  asm volatile("s_waitcnt lgkmcnt(0)" ::: "memory");
  if (hi == 0) li_l[r32] = l1; asm volatile("s_waitcnt lgkmcnt(0)" ::: "memory");
#pragma unroll
  for (int rr = 0; rr < 16; ++rr) { const int qrow = 32 + da::crow(rr, hi); const float il = __builtin_amdgcn_rcpf(li_l[qrow - 32]);
      op[(size_t)qrow * DM] = (bf16)f2bf(o10[rr] * il); op[(size_t)qrow * DM + 32] = (bf16)f2bf(o11[rr] * il); }
  asm volatile("s_waitcnt lgkmcnt(0)" ::: "memory");
}
}
constexpr int MLP = 4;
namespace sc {
#define LBAR() do { asm volatile("s_waitcnt lgkmcnt(0)" ::: "memory"); __builtin_amdgcn_s_barrier(); asm volatile("" ::: "memory"); } while (0)

using bf16x8 = __attribute__((ext_vector_type(8))) short;
using f32x16 = __attribute__((ext_vector_type(16))) float;
constexpr int RS = 272;
constexpr int TS = 144;
template <int NS> __device__ __forceinline__ void mm(f32x16& c, const LAS char* xb, int xs, const LAS char* yb, int ys, int kb0, int lane) {
    const int r = lane & 31, h = lane >> 5;
    const LAS char* xp = xb + r * xs + kb0 + h * 16; const LAS char* yp = yb + r * ys + kb0 + h * 16;
#pragma unroll
    for (int s = 0; s < NS; ++s) { const bf16x8 a = *(const LAS bf16x8*)(xp + s * 32), b = *(const LAS bf16x8*)(yp + s * 32); c = __builtin_amdgcn_mfma_f32_32x32x16_bf16(a, b, c, 0, 0, 0); }
}
__device__ __forceinline__ unsigned long long pk4(float a, float b, float c, float d) { return (unsigned long long)pk2(a, b) | ((unsigned long long)pk2(c, d) << 32); }

__device__ __forceinline__ void hgrn_unit(int u, const bf16* P, float* OF, float* OB, LAS unsigned char* ldsu, int tid) {
    const int b = u >> 3, h = (u >> 1) & 3, dir = u & 1, wave = __builtin_amdgcn_readfirstlane(tid >> 6);
    LAS char* lds = (LAS char*)ldsu;
    LAS char* QM = lds; LAS char* KM = lds + 17408; LAS char* KMt = lds + 34816; LAS char* Vt = lds + 53248; LAS char* ST = lds + 71680; LAS char* AA = lds + 106496;
    LAS float* GT = (LAS float*)(lds + 115712); LAS float* CM = (LAS float*)(lds + 117760); LAS float* DL = (LAS float*)(lds + 118272); LAS float* FC = (LAS float*)(lds + 118784);
    const char* Pb = (const char*)(P + (size_t)b * NT_ * P0W); char* Ob = (char*)((dir ? OB : OF) + (size_t)b * NT_ * GW);
    const int sgn = dir ? -1 : 1, tz = dir ? NT_ - 1 : 0, sP = sgn * P0W * 2, fofs = (dir ? 1536 : 1024) * 2;
    int op = ((tz + sgn * ((tid >> 7) * 16)) * P0W + h * 128 + (tid & 127)) * 2;
    const int et = wave & 3, dt0 = 2 * (wave >> 2), tt = wave >> 2;
    const int tg = tid >> 7;
    f32x16 S0 = {}, S1 = {};
    unsigned rq[16], rf[16], rv[16];
#define HG_LOAD() do { _Pragma("unroll") for (int j = 0; j < 16; ++j) { const char* p = Pb + (unsigned)(op + j * sP); rq[j] = *(const unsigned short*)p; rv[j] = *(const unsigned short*)(p + 1024); rf[j] = *(const unsigned short*)(p + fofs); } \
        op += 64 * sP; } while (0)
    HG_LOAD();
#pragma unroll 1
    for (int c_ = 0; c_ < (NT_ / 64) * NREP(30); ++c_) { const int c = c_ & 63; if (c_ == 64) { S0 = f32x16{}; S1 = f32x16{}; }
        int tl_ = tid; asm volatile("" : "+v"(tl_)); const int d = tl_ & 127, lane = tl_ & 63;
#pragma unroll
        for (int j = 0; j < 16; ++j) { asm volatile("" : "+v"(rq[j])); asm volatile("" : "+v"(rf[j])); asm volatile("" : "+v"(rv[j])); }
        float qv[16], kv[16], cum[16]; float run = 0.f;
#pragma unroll
        for (int j = 0; j < 16; ++j) { kv[j] = __builtin_bit_cast(float, rf[j] << 16); run += __logf(1.f - kv[j]); cum[j] = run; qv[j] = __builtin_bit_cast(float, rq[j] << 16); }
        GT[tg * 128 + d] = run;
        LBAR();
        const float g0 = GT[d], g1 = GT[128 + d], g2 = GT[256 + d], g3 = GT[384 + d];
        const float cmid = g0 + g1, cL = cmid + g2 + g3;
        const float off = (tg == 0 ? 0.f : tg == 1 ? g0 : tg == 2 ? cmid : cmid + g2) - cmid;
        if (tg == 0) { CM[d] = __expf(cmid); DL[d] = __expf(cL); FC[d] = __expf(cL - cmid); }
        { unsigned kmw[8];
#pragma unroll
          for (int j = 0; j < 16; j += 2) {
              float x0 = off + cum[j], x1 = off + cum[j + 1];
              x0 = fminf(fmaxf(x0, -80.f), 80.f); x1 = fminf(fmaxf(x1, -80.f), 80.f);
              const float qm0 = qv[j] * __expf(x0), qm1 = qv[j + 1] * __expf(x1), km0 = kv[j] * __expf(-x0), km1 = kv[j + 1] * __expf(-x1);
              const unsigned qmp = pk2(qm0, qm1), kmp = pk2(km0, km1);
              const int t0 = tg * 16 + j;
              *(LAS unsigned short*)(QM + t0 * RS + d * 2) = (unsigned short)qmp; *(LAS unsigned short*)(QM + (t0 + 1) * RS + d * 2) = (unsigned short)(qmp >> 16);
              *(LAS unsigned short*)(KM + t0 * RS + d * 2) = (unsigned short)kmp; *(LAS unsigned short*)(KM + (t0 + 1) * RS + d * 2) = (unsigned short)(kmp >> 16);
              kmw[j >> 1] = kmp; }
          *(LAS v4u*)(KMt + d * TS + tg * 32) = (v4u){kmw[0], kmw[1], kmw[2], kmw[3]}; *(LAS v4u*)(KMt + d * TS + tg * 32 + 16) = (v4u){kmw[4], kmw[5], kmw[6], kmw[7]};
          v4u v0, v1; v0.x = rv[0] | (rv[1] << 16); v0.y = rv[2] | (rv[3] << 16); v0.z = rv[4] | (rv[5] << 16); v0.w = rv[6] | (rv[7] << 16);
          v1.x = rv[8] | (rv[9] << 16); v1.y = rv[10] | (rv[11] << 16); v1.z = rv[12] | (rv[13] << 16); v1.w = rv[14] | (rv[15] << 16);
          *(LAS v4u*)(Vt + d * TS + tg * 32) = v0; *(LAS v4u*)(Vt + d * TS + tg * 32 + 16) = v1; }
        if (c_ == 63 && NREP(30) == 2) op -= 64 * 64 * sP;
        if (c_ + 1 < (NT_ / 64) * NREP(30)) HG_LOAD();
        LBAR();
        { const int e = 32 * et + (lane & 31);
#pragma unroll
          for (int k = 0; k < 2; ++k)
#pragma unroll
              for (int i4 = 0; i4 < 4; ++i4) { const int d0 = 32 * (dt0 + k) + 8 * i4 + 4 * (lane >> 5); const f32x4 cm = *(const LAS f32x4*)(CM + d0);
                  const f32x16& S = k ? S1 : S0;
                  *(LAS unsigned long long*)(ST + e * RS + d0 * 2) = pk4(S[4 * i4] * cm.x, S[4 * i4 + 1] * cm.y, S[4 * i4 + 2] * cm.z, S[4 * i4 + 3] * cm.w); } }
        LBAR();
        f32x16 acc = {};
        mm<8>(acc, QM + 32 * tt * RS, RS, ST + 32 * et * RS, RS, 0, lane);
        if (wave < 3) { const int st = wave >> 1, t2 = (wave + 1) >> 1;
            f32x16 at = {};
            mm<8>(at, KM + 32 * st * RS, RS, QM + 32 * t2 * RS, RS, 0, lane);
            const int tg_ = 32 * t2 + (lane & 31);
#pragma unroll
            for (int i4 = 0; i4 < 4; ++i4) { const int s0 = 32 * st + 8 * i4 + 4 * (lane >> 5);
                *(LAS unsigned long long*)(AA + tg_ * TS + s0 * 2) = pk4(s0 <= tg_ ? at[4 * i4] : 0.f, s0 + 1 <= tg_ ? at[4 * i4 + 1] : 0.f, s0 + 2 <= tg_ ? at[4 * i4 + 2] : 0.f, s0 + 3 <= tg_ ? at[4 * i4 + 3] : 0.f); } }
#pragma unroll
        for (int k = 0; k < 2; ++k) { f32x16 p = {};
            mm<4>(p, KMt + 32 * (dt0 + k) * TS, TS, Vt + 32 * et * TS, TS, 0, lane);
            f32x16& S = k ? S1 : S0;
#pragma unroll
            for (int i4 = 0; i4 < 4; ++i4) { const int d0 = 32 * (dt0 + k) + 8 * i4 + 4 * (lane >> 5); const f32x4 dl = *(const LAS f32x4*)(DL + d0), fc = *(const LAS f32x4*)(FC + d0);
                S[4 * i4] = dl.x * S[4 * i4] + fc.x * p[4 * i4]; S[4 * i4 + 1] = dl.y * S[4 * i4 + 1] + fc.y * p[4 * i4 + 1];
                S[4 * i4 + 2] = dl.z * S[4 * i4 + 2] + fc.z * p[4 * i4 + 2]; S[4 * i4 + 3] = dl.w * S[4 * i4 + 3] + fc.w * p[4 * i4 + 3]; } }
        LBAR();
        if (tt == 0) mm<2>(acc, AA, TS, Vt + 32 * et * TS, TS, 0, lane); else mm<4>(acc, AA + 32 * TS, TS, Vt + 32 * et * TS, TS, 0, lane);
        { const int oo = ((tz + sgn * (c * 64 + 32 * tt + 4 * (lane >> 5))) * GW + h * 128 + 32 * et + (lane & 31)) * 4;
#pragma unroll
          for (int i = 0; i < 16; ++i) *(float*)(Ob + (unsigned)(oo + sgn * ((8 * (i >> 2) + (i & 3)) * GW * 4))) = acc[i]; }
    }
#undef HG_LOAD
    __syncthreads();
}

template <bool STATE_ONLY>
__device__ __forceinline__ void mlstm_unit(int u, int part, const bf16* P, const bf16* QKC, const float* ibias, const float* fbias, float* HF, float* HBk, float* CL, float* NL, float* FPL, LAS unsigned char* ldsu, int tid) {
    constexpr int MLC = (NT_ / 64) / MLP; const int cbase = part * MLC;
    const int b = u >> 3, h = (u >> 1) & 3, dir = u & 1, tg = tid >> 7, wave = __builtin_amdgcn_readfirstlane(tid >> 6);
    LAS char* lds = (LAS char*)ldsu;
    LAS char* Qs = lds; LAS char* Ks = lds + 17408; LAS char* KWt = lds + 34816; LAS char* Vt = lds + 53248; LAS char* ST = lds + 71680; LAS char* AA = lds + 106496;
    LAS float* GB = (LAS float*)(lds + 115712);
    LAS float* DENI = GB + 512; LAS float* DENA = DENI + 64; LAS float* NV = DENA + 128; LAS float* NP = NV + 256;
    const float ib = ibias[dir * 4 + h], fb = fbias[dir * 4 + h];
    const char* Pb = (const char*)(P + (size_t)b * NT_ * P1W); const char* Qb = (const char*)(QKC + (size_t)b * NT_ * DM); char* Ob = (char*)((dir ? HBk : HF) + (size_t)b * NT_ * GW);
    const int sgn = dir ? -1 : 1, tz = dir ? NT_ - 1 : 0;
    const int sK = sgn * DM * 2, sV = sgn * P1W * 2;
    int ok = ((tz + sgn * (cbase * 64 + tg * 16)) * DM + GW + h * 128 + (tid & 127)) * 2;
    int ov = ((tz + sgn * (cbase * 64 + tg * 16)) * P1W + 1024 + h * 128 + (tid & 127)) * 2;
    int oq = ((tz + sgn * (cbase * 64 + (tid >> 3))) * DM + h * 128 + (tid & 7) * 16) * 2;
    int og = ((tz + sgn * (cbase * 64 + (tid & 63))) * P1W + 3584 + dir * 8 + h) * 2;
    const int et = wave & 3, dt0 = 2 * (wave >> 2), tt = wave >> 2;
    f32x16 S0 = {}, S1 = {}; float facc = 0.f;
    float* const clw = CL + ((size_t)(u * MLP) * 16384) + (size_t)(wave * 2) * 1024 + (tid & 63);
    { float nv = 0.f;
      if (!STATE_ONLY) {
#pragma unroll 1
          for (int j = 0; j < part; ++j) { const float fj = __expf(FPL[u * MLP + j]); const float* cj = clw + (size_t)j * 16384;
#pragma unroll
              for (int i = 0; i < 16; ++i) { S0[i] = fj * S0[i] + cj[i * 64]; S1[i] = fj * S1[i] + cj[1024 + i * 64]; }
              if (tid < 128) nv = fj * nv + NL[(u * MLP + j) * 128 + tid]; } }
      if (tid < 128) { NV[tid] = nv; NV[128 + tid] = 0.f; } }
    if (!STATE_ONLY) { const int e = 32 * et + (tid & 31), hi_ = (tid >> 5) & 1;
#pragma unroll
        for (int k = 0; k < 2; ++k)
#pragma unroll
            for (int i4 = 0; i4 < 4; ++i4) { const int d0 = 32 * (dt0 + k) + 8 * i4 + 4 * hi_; const f32x16& S = k ? S1 : S0;
                *(LAS unsigned long long*)(ST + e * RS + d0 * 2) = pk4(S[4 * i4], S[4 * i4 + 1], S[4 * i4 + 2], S[4 * i4 + 3]); } }
    unsigned rk[16], rv[16]; v4u wq0 = {0u, 0u, 0u, 0u}, wq1 = wq0, wk0 = wq0, wk1 = wq0; unsigned rgi = 0, rgf = 0;
#define ML_LOAD() do { _Pragma("unroll") for (int j = 0; j < 16; ++j) { rk[j] = *(const unsigned short*)(Qb + (unsigned)(ok + j * sK)); rv[j] = *(const unsigned short*)(Pb + (unsigned)(ov + j * sV)); } \
        if (!STATE_ONLY) { const char* qp = Qb + (unsigned)oq; wq0 = *(const v4u*)qp; wq1 = *(const v4u*)(qp + 16); wk0 = *(const v4u*)(qp + GW * 2); wk1 = *(const v4u*)(qp + GW * 2 + 16); } \
        ok += 64 * sK; ov += 64 * sV; oq += 64 * sK; } while (0)
#define ML_GLOAD() do { if (tid < 64) { rgi = *(const unsigned short*)(Pb + (unsigned)og); rgf = *(const unsigned short*)(Pb + (unsigned)og + 8); } og += 64 * sV; } while (0)
#define ML_GATES(buf) do { if (tid < 64) { const float ig = __builtin_bit_cast(float, rgi << 16) + ib, x = __builtin_bit_cast(float, rgf << 16) + fb; const float lf = -__logf(1.f + __expf(-x)); float cs = lf; \
            _Pragma("unroll") for (int o = 1; o < 64; o <<= 1) { const float t_ = __shfl_up(cs, o); if ((tid & 63) >= o) cs += t_; } \
            const float cL = __shfl(cs, 63); facc += cL; LAS float* g_ = GB + (buf) * 256; \
            g_[tid] = __expf(cs); g_[64 + tid] = __expf(ig - cs); g_[128 + tid] = __expf(cL - cs + ig); if (tid == 0) g_[192] = __expf(cL); } } while (0)
    ML_GLOAD(); ML_GATES(0); ML_GLOAD(); ML_LOAD();
    __syncthreads();
#pragma unroll 1
    for (int c = 0; c < MLC; ++c) {
        int tl_ = tid; asm volatile("" : "+v"(tl_)); const int d = tl_ & 127, lane = tl_ & 63;
#pragma unroll
        for (int j = 0; j < 16; ++j) { asm volatile("" : "+v"(rk[j])); asm volatile("" : "+v"(rv[j])); }
        asm volatile("" : "+v"(wq0)); asm volatile("" : "+v"(wq1)); asm volatile("" : "+v"(wk0)); asm volatile("" : "+v"(wk1)); asm volatile("" : "+v"(rgi)); asm volatile("" : "+v"(rgf));
        const LAS float* G = GB + (c & 1) * 256; const LAS float* NVc = NV + (c & 1) * 128; LAS float* NVn = NV + ((c + 1) & 1) * 128;
        if (!STATE_ONLY) { const int t = tl_ >> 3, part = tl_ & 7;
          *(LAS v4u*)(Qs + t * RS + part * 32) = wq0; *(LAS v4u*)(Qs + t * RS + part * 32 + 16) = wq1; *(LAS v4u*)(Ks + t * RS + part * 32) = wk0; *(LAS v4u*)(Ks + t * RS + part * 32 + 16) = wk1; }
        { unsigned kw[8]; float ksum = 0.f;
#pragma unroll
          for (int j = 0; j < 16; j += 2) { const int t0 = tg * 16 + j; const float k0 = __builtin_bit_cast(float, rk[j] << 16) * G[128 + t0], k1 = __builtin_bit_cast(float, rk[j + 1] << 16) * G[128 + t0 + 1];
              ksum += k0 + k1; kw[j >> 1] = pk2(k0, k1); }
          NP[tg * 128 + d] = ksum;
          *(LAS v4u*)(KWt + d * TS + tg * 32) = (v4u){kw[0], kw[1], kw[2], kw[3]}; *(LAS v4u*)(KWt + d * TS + tg * 32 + 16) = (v4u){kw[4], kw[5], kw[6], kw[7]};
          v4u v0, v1; v0.x = rv[0] | (rv[1] << 16); v0.y = rv[2] | (rv[3] << 16); v0.z = rv[4] | (rv[5] << 16); v0.w = rv[6] | (rv[7] << 16);
          v1.x = rv[8] | (rv[9] << 16); v1.y = rv[10] | (rv[11] << 16); v1.z = rv[12] | (rv[13] << 16); v1.w = rv[14] | (rv[15] << 16);
          *(LAS v4u*)(Vt + d * TS + tg * 32) = v0; *(LAS v4u*)(Vt + d * TS + tg * 32 + 16) = v1; }
        if (c + 1 < MLC) { ML_GATES((c + 1) & 1); ML_LOAD(); if (c + 2 < MLC) ML_GLOAD(); }
        LBAR();
        f32x16 acc = {};
        if (!STATE_ONLY) {
        { const int t = tl_ >> 3, part = tl_ & 7; float qf[16]; unpack8(*(const LAS v4u*)(Qs + t * RS + part * 32), *(float(*)[8])&qf[0]); unpack8(*(const LAS v4u*)(Qs + t * RS + part * 32 + 16), *(float(*)[8])&qf[8]);
          float s = 0.f;
#pragma unroll
          for (int i = 0; i < 16; ++i) s += qf[i] * NVc[part * 16 + i];
          s += __shfl_xor(s, 1); s += __shfl_xor(s, 2); s += __shfl_xor(s, 4);
          if (part == 0) DENI[t] = s * G[t]; }
        mm<8>(acc, Qs + 32 * tt * RS, RS, ST + 32 * et * RS, RS, 0, lane);
#pragma unroll
        for (int i4 = 0; i4 < 4; ++i4) { const f32x4 rf = *(const LAS f32x4*)(G + 32 * tt + 8 * i4 + 4 * (lane >> 5));
            acc[4 * i4] *= rf.x; acc[4 * i4 + 1] *= rf.y; acc[4 * i4 + 2] *= rf.z; acc[4 * i4 + 3] *= rf.w; }
        if (wave < 3) { const int st = wave >> 1, t2 = (wave + 1) >> 1;
            f32x16 at = {};
            mm<8>(at, Ks + 32 * st * RS, RS, Qs + 32 * t2 * RS, RS, 0, lane);
            const int tg_ = 32 * t2 + (lane & 31); const float rowf = G[tg_]; float dsum = 0.f;
#pragma unroll
            for (int i4 = 0; i4 < 4; ++i4) { const int s0 = 32 * st + 8 * i4 + 4 * (lane >> 5); const f32x4 cf = *(const LAS f32x4*)(G + 64 + s0);
                const float a0 = s0 <= tg_ ? at[4 * i4] * cf.x * rowf : 0.f, a1 = s0 + 1 <= tg_ ? at[4 * i4 + 1] * cf.y * rowf : 0.f;
                const float a2 = s0 + 2 <= tg_ ? at[4 * i4 + 2] * cf.z * rowf : 0.f, a3 = s0 + 3 <= tg_ ? at[4 * i4 + 3] * cf.w * rowf : 0.f;
                dsum += (a0 + a1) + (a2 + a3);
                *(LAS unsigned long long*)(AA + tg_ * TS + s0 * 2) = pk4(a0, a1, a2, a3); }
            dsum += __shfl_xor(dsum, 32);
            if (lane < 32) DENA[st * 64 + tg_] = dsum;
            if (wave == 0 && lane < 32) DENA[64 + lane] = 0.f; }
        }
        { const float dls = G[192];
#pragma unroll
          for (int k = 0; k < 2; ++k) { f32x16 p = {};
              mm<4>(p, KWt + 32 * (dt0 + k) * TS, TS, Vt + 32 * et * TS, TS, 0, lane);
              f32x16& S = k ? S1 : S0;
#pragma unroll
              for (int i = 0; i < 16; ++i) S[i] = dls * S[i] + p[i]; }
          if (tl_ < 128) NVn[tl_] = dls * NVc[tl_] + ((NP[tl_] + NP[128 + tl_]) + (NP[256 + tl_] + NP[384 + tl_])); }
        if (!STATE_ONLY) {
        LBAR();
        if (tt == 0) mm<2>(acc, AA, TS, Vt + 32 * et * TS, TS, 0, lane); else mm<4>(acc, AA + 32 * TS, TS, Vt + 32 * et * TS, TS, 0, lane);
        { const int tc0 = 32 * tt + 4 * (lane >> 5); const int oo = ((tz + sgn * ((cbase + c) * 64 + tc0)) * GW + h * 128 + 32 * et + (lane & 31)) * 4;
#pragma unroll
          for (int i4 = 0; i4 < 4; ++i4) { const f32x4 di = *(const LAS f32x4*)(DENI + tc0 + 8 * i4), da = *(const LAS f32x4*)(DENA + tc0 + 8 * i4), db = *(const LAS f32x4*)(DENA + 64 + tc0 + 8 * i4);
              const f32x4 den = di + da + db;
#pragma unroll
              for (int j = 0; j < 4; ++j) *(float*)(Ob + (unsigned)(oo + sgn * ((8 * i4 + j) * GW * 4))) = acc[4 * i4 + j] * __builtin_amdgcn_rcpf(fmaxf(fabsf(den[j]), 1.f)); } }
        { const int e = 32 * et + (lane & 31);
#pragma unroll
          for (int k = 0; k < 2; ++k)
#pragma unroll
              for (int i4 = 0; i4 < 4; ++i4) { const int d0 = 32 * (dt0 + k) + 8 * i4 + 4 * (lane >> 5); const f32x16& S = k ? S1 : S0;
                  *(LAS unsigned long long*)(ST + e * RS + d0 * 2) = pk4(S[4 * i4], S[4 * i4 + 1], S[4 * i4 + 2], S[4 * i4 + 3]); } }
        }
        LBAR();
    }
    if (STATE_ONLY) {
        float* cw = clw + (size_t)part * 16384;
#pragma unroll
        for (int i = 0; i < 16; ++i) { cw[i * 64] = S0[i]; cw[1024 + i * 64] = S1[i]; }
        if (tid < 128) NL[(u * MLP + part) * 128 + tid] = NV[(MLC & 1) * 128 + tid];
        if (tid == 0) FPL[u * MLP + part] = facc;
    }
#undef ML_LOAD
#undef ML_GLOAD
#undef ML_GATES
}
}
#ifndef STOP_AFTER
#define STOP_AFTER 25
#endif
constexpr int N_PHASES = 26;
constexpr int N_CONV_HELPERS = 64;
struct Args { const float* in[44]; float* out; unsigned char* ws; int ph_lo, ph_hi, li, pad; };
__global__ void __launch_bounds__(NWAVES * 64, 2) fwd_kernel(Args args) {
    extern __shared__ __attribute__((aligned(16))) unsigned char lds_raw[];
    LAS unsigned char* lds = (LAS unsigned char*)lds_raw;
    volatile LAS unsigned* MISC = (volatile LAS unsigned*)(lds + MISC_OFF);
    LAS int* TB = (LAS int*)(lds + TBL_OFF);
    const int tid0 = threadIdx.x, wave = __builtin_amdgcn_readfirstlane(tid0 >> 6);
    const int G = gridDim.x, bx = blockIdx.x;
    const int gw = bx * NWAVES + wave, NGW = G * NWAVES, NGT = G * NWAVES * 64;
    unsigned char* ws = args.ws;
    gu32* ctl = (gu32*)(ws + WS_CTL);
    const float* x_in = args.in[0]; const float* c_in = args.in[1]; const float* lbl = args.in[2];
    const float* const* L0 = args.in + 3; const float* const* L1 = args.in + 23; const float* fnorm = args.in[43];
    float* xo = args.out;
    float* TAB = (float*)(ws + WS_TAB); float* MOD = (float*)(ws + WS_MOD); float* OML = (float*)(ws + WS_OML);
    bf16* WIN0 = (bf16*)(ws + WS_WIN0); bf16* WIN1 = (bf16*)(ws + WS_WIN1); bf16* WOUT0 = (bf16*)(ws + WS_WOUT0); bf16* WOUT1 = (bf16*)(ws + WS_WOUT1);
    bf16* ROUT0 = (bf16*)(ws + WS_ROUT0); bf16* ROUT1 = (bf16*)(ws + WS_ROUT1); bf16* GU = (bf16*)(ws + WS_GU); bf16* DN = (bf16*)(ws + WS_DN);
    bf16* H2A = (bf16*)(ws + WS_H2A); bf16* H2B = (bf16*)(ws + WS_H2B); bf16* PROJ = (bf16*)(ws + WS_PROJ); bf16* CAT = (bf16*)(ws + WS_CAT);
    float* OF = (float*)(ws + WS_OF); float* OB = (float*)(ws + WS_OB); bf16* QKC = (bf16*)(ws + WS_QKC);
    unsigned char* YB = (unsigned char*)(ws + WS_Y); bf16* HB = (bf16*)(ws + WS_HB); float* LOG = (float*)(ws + WS_LOG);
    int* TOPI = (int*)(ws + WS_TOPI); float* TOPW = (float*)(ws + WS_TOPW); int* RANK = (int*)(ws + WS_RANK); int* SLOT = (int*)(ws + WS_SLOT); int* LIST = (int*)(ws + WS_LIST);

    for (int u = tid0; u < (LDS_BYTES - LDSCTL_OFF) / 4; u += NWAVES * 64) ((LAS unsigned*)(lds + LDSCTL_OFF))[u] = 0u;
    __syncthreads();
    XcdBarrier bar = xcd_barrier_post((unsigned*)(ctl + CW_BAR + args.li * 4096), MISC + 8);
#ifndef PREFIX_K
#define PREFIX_K -1
#endif
    const int pass = args.li;
    const int lo = args.ph_lo, hi = args.ph_hi;
    gu32* const qh = ctl + CW_Q0 + pass * 256; unsigned* const cnt0 = (unsigned*)(ctl + CW_CNT0 + pass * 512); unsigned* const cnt1 = (unsigned*)(ctl + CW_CNT1 + pass * 512);
#define IN(k) (lo <= (k) && (k) < hi)
#define FRESH() int tid = wave * 64 + pg8::fresh_lane(); asm volatile("" : "+v"(tid)); const int lane = tid & 63; const int gtid = bx * (NWAVES * 64) + tid; (void)lane; (void)gtid
#define SEAM(k) do { if (IN(k) && IN((k) + 1)) xcd_barrier(bar); } while (0)
    LAS float* scr = (LAS float*)(lds + wave * 8448);

    if (IN(0)) { FRESH();
        if (bx < 192) mod_unit(bx, c_in, L0[2], L0[3], L1[2], L1[3], MOD, lds, tid, wave, lane);
        int jbase = 0;
        TR_JOB(L0[4], 4096, 1024, 0, 4096, WIN0, 0);
        TR_JOB(L1[4], 3600, 1024, 0, 2048, WIN1, 0);
        TR_JOB(L1[4], 3600, 1024, 2064, 1536, WIN1, 2048);
        TR_JOB(L1[4], 3600, 1024, 2048, 16, WIN1, 3584);
        TR_JOB(L0[5], 1024, 1024, 0, 1024, WOUT0, 0);
        TR_JOB(L1[5], 1024, 1024, 0, 1024, WOUT1, 0);
        TR_JOB(L0[12], 128, 1024, 0, 128, ROUT0, 0);
        TR_JOB(L1[12], 128, 1024, 0, 128, ROUT1, 0);
        { const v4u z = {0u, 0u, 0u, 0u};
          for (int i = gtid; i < 224 * 128; i += NGT) *(v4u*)(WIN1 + (size_t)3616 * 1024 + (size_t)i * 8) = z;
          for (int i = gtid; i < 128 * 128; i += NGT) { *(v4u*)(ROUT0 + (size_t)128 * 1024 + (size_t)i * 8) = z; *(v4u*)(ROUT1 + (size_t)128 * 1024 + (size_t)i * 8) = z; } }
        for (int i = gtid; i < 2 * GW; i += NGT) OML[i] = 1.f - 1.f / (1.f + __expf(lbl[2 * GW + i] - lbl[i]));
        for (int t = gtid; t < NT_; t += NGT) {
            const float invf[8] = {1.0f, 0.1939227432f, 0.0376060307f, 0.00729266461f, 0.00141421356f, 0.000274248188f, 5.31829573e-05f, 1.03133852e-05f};
#pragma unroll
            for (int i = 0; i < 8; ++i) { const float ang = (float)t * invf[i]; double rev = (double)ang * 0.15915494309189535; rev -= floor(rev); const float rv = (float)rev;
                TAB[t * 16 + i] = __builtin_amdgcn_cosf(rv); TAB[t * 16 + 8 + i] = __builtin_amdgcn_sinf(rv); }
        }
    }
    SEAM(0);
    if (IN(1)) { FRESH(); _Pragma("unroll 1") for (int rep_ = 0; rep_ < NREP(1); ++rep_) normmod_phase(x_in, L0[0], MOD, 0, 1024, H2A, gw, NGW, lane); }
    SEAM(1);
    if (IN(2)) { FRESH(); pg8::DenseOrder S; S.init(NTOK, P0W, G, bx); EpiProj0 E{PROJ, OML, TAB};
        _Pragma("unroll 1") for (int rep_ = 0; rep_ < NREP(2); ++rep_) pg8::gemm_phase<EpiProj0, pg8::DenseOrder, true>(lds, H2A, WIN0, DM, S, E, wave); }
    if (IN(2) && IN(4)) xcd_barrier(bar);
    if (IN(4)) { FRESH();
        if (bx < 64) sc::hgrn_unit(bx, PROJ, OF, OB, lds, tid);
        float lam;
        { float a = L0[7][lane] * L0[8][lane], b2 = L0[9][lane] * L0[10][lane]; a = wave_sum(a); b2 = wave_sum(b2); lam = __expf(a) - __expf(b2) + 0.2f; }
        const bool helper = (bx >= 64 && bx < 64 + N_CONV_HELPERS);
#pragma unroll 1
        for (int rnd = 0; rnd < 2; ++rnd) {
            if (rnd == 1 || helper)
                for (;;) { const int u0 = q_pull(qh + 64, MISC + 1, tid); if (u0 >= 1032 * NREP(27)) break; const int u = u0 % 1032;
#pragma unroll 1
                    for (int k = 0; k < 6; ++k) expert_item(L0[14], L0[15], L0[16], L0[17], L0[18], L0[19], GU, DN, u * 48 + wave * 6 + k, scr, lane); }
            if (rnd == 0)
                for (;;) { const int u = q_pull(qh, MISC + 0, tid); if (u >= 1024 * NREP(4)) break; da::unit(u & 1023, PROJ, lam, L0[11], CAT, (LAS char*)lds, tid); }
        }
    }
    SEAM(4);
    if (IN(5)) { FRESH(); _Pragma("unroll 1") for (int rep_ = 0; rep_ < NREP(5); ++rep_) gateout_phase<2>(OF, OB, L0[6], PROJ, P0W, 2048, CAT, gw, NGW, lane); }
    SEAM(5);
    if (IN(6)) { FRESH(); pg8::DenseOrder S; S.init(NTOK, DM, G, bx); EpiResid E{x_in, xo, MOD + 2048};
        _Pragma("unroll 1") for (int rep_ = 0; rep_ < NREP(6); ++rep_) pg8::gemm_phase<EpiResid, pg8::DenseOrder, true>(lds, CAT, WOUT0, DM, S, E, wave); }
    SEAM(6);
    if (IN(7)) { FRESH(); _Pragma("unroll 1") for (int rep_ = 0; rep_ < NREP(7); ++rep_) normmod_phase(xo, L0[1], MOD, 3072, 4096, H2A, gw, NGW, lane); }
    SEAM(7);
    if (IN(8)) { FRESH(); pg8::DenseOrder S; S.init(NTOK, 256, G, bx); EpiF32 E{LOG, 256};
        _Pragma("unroll 1") for (int rep_ = 0; rep_ < NREP(8); ++rep_) pg8::gemm_phase<EpiF32, pg8::DenseOrder, true>(lds, H2A, ROUT0, DM, S, E, wave); }
    SEAM(8);
    if (IN(9)) { FRESH(); topk_phase(LOG, L0[13], TOPI, TOPW, RANK, cnt0, lds, bx, G, wave, tid); }
    SEAM(9);
    if (IN(10)) { FRESH(); moe_tables(cnt0, TB, tid); _Pragma("unroll 1") for (int rep_ = 0; rep_ < NREP(10); ++rep_) list_phase(TOPI, RANK, SLOT, LIST, TB, gtid, NGT); }
    SEAM(10);
    if (IN(11)) { FRESH(); moe_tables(cnt0, TB, tid); GroupOrder S; S.init(TB, LIST, 2, G, bx); EpiGateUp E{HB};
        _Pragma("unroll 1") for (int rep_ = 0; rep_ < NREP(11); ++rep_) pg8::gemm_phase<EpiGateUp, GroupOrder, true>(lds, H2A, GU, DM, S, E, wave); }
    SEAM(11);
    if (IN(12)) { FRESH(); moe_tables(cnt0, TB, tid); GroupOrder S; S.init(TB, nullptr, 4, G, bx); EpiDown E{YB};
        _Pragma("unroll 1") for (int rep_ = 0; rep_ < NREP(12); ++rep_) pg8::gemm_phase<EpiDown, GroupOrder, true>(lds, HB, DN, EFF, S, E, wave); }
    SEAM(12);
    if (IN(13)) { FRESH(); combine_phase(xo, YB, SLOT, TOPW, MOD, 5120, L1[0], MOD + 8 * 6144, 0, 1024, H2B, nullptr, gw, NGW, lane); }
    SEAM(13);
    if (IN(14)) { FRESH(); pg8::DenseOrder S; S.init(NTOK, P1W, G, bx); EpiStoreBf16 E{PROJ, P1W};
        _Pragma("unroll 1") for (int rep_ = 0; rep_ < NREP(14); ++rep_) pg8::gemm_phase<EpiStoreBf16, pg8::DenseOrder, true>(lds, H2B, WIN1, DM, S, E, wave); }
    SEAM(14);
    if (IN(15)) { FRESH(); _Pragma("unroll 1") for (int rep_ = 0; rep_ < NREP(15); ++rep_) convqk_phase(PROJ, L1[6], L1[7], QKC, gtid, NGT); }
    SEAM(15);
    if (IN(16)) { FRESH();
        float* CLr = (float*)(ws + WS_LOG); float* NLr = CLr + (size_t)64 * MLP * 16384; float* FPr = NLr + 64 * MLP * 128;
#pragma unroll 1
        for (int w = bx; w < 64 * MLP; w += G) if ((w % MLP) != MLP - 1) sc::mlstm_unit<true>(w / MLP, w % MLP, PROJ, QKC, L1[8], L1[9], OF, OB, CLr, NLr, FPr, lds, tid);
        xcd_barrier(bar);
#pragma unroll 1
        for (int w = bx; w < 64 * MLP; w += G) sc::mlstm_unit<false>(w / MLP, w % MLP, PROJ, QKC, L1[8], L1[9], OF, OB, CLr, NLr, FPr, lds, tid);
        { LAS float* BT = (LAS float*)(lds + 69632); for (int i = tid; i < 3720; i += 512) BT[i] = L1[11][i];
          for (;;) { const int u = q_pull(qh + 128, MISC + 2, tid); if (u >= 512 * NREP(16)) break; na::item((u & 511) * 8 + wave, PROJ, BT, CAT, (LAS char*)lds + wave * 8448, lane); } }
        for (;;) { const int u0 = q_pull(qh + 192, MISC + 3, tid); if (u0 >= 1032 * NREP(28)) break; const int u = u0 % 1032;
#pragma unroll 1
            for (int k = 0; k < 6; ++k) expert_item(L1[14], L1[15], L1[16], L1[17], L1[18], L1[19], GU, DN, u * 48 + wave * 6 + k, scr, lane); }
    }
    SEAM(16);
    if (IN(17)) { FRESH(); _Pragma("unroll 1") for (int rep_ = 0; rep_ < NREP(17); ++rep_) gateout_phase<1>(OF, OB, L1[10], PROJ, P1W, 1536, CAT, gw, NGW, lane); }
    SEAM(17);
    if (IN(18)) { FRESH(); pg8::DenseOrder S; S.init(NTOK, DM, G, bx); EpiResid E{xo, xo, MOD + 8 * 6144 + 2048};
        pg8::gemm_phase<EpiResid, pg8::DenseOrder, true>(lds, CAT, WOUT1, DM, S, E, wave); }
    SEAM(18);
    if (IN(19)) { FRESH(); _Pragma("unroll 1") for (int rep_ = 0; rep_ < NREP(19); ++rep_) normmod_phase(xo, L1[1], MOD + 8 * 6144, 3072, 4096, H2A, gw, NGW, lane); }
    SEAM(19);
    if (IN(20)) { FRESH(); pg8::DenseOrder S; S.init(NTOK, 256, G, bx); EpiF32 E{LOG, 256};
        _Pragma("unroll 1") for (int rep_ = 0; rep_ < NREP(20); ++rep_) pg8::gemm_phase<EpiF32, pg8::DenseOrder, true>(lds, H2A, ROUT1, DM, S, E, wave); }
    SEAM(20);
    if (IN(21)) { FRESH(); topk_phase(LOG, L1[13], TOPI, TOPW, RANK, cnt1, lds, bx, G, wave, tid); }
    SEAM(21);
    if (IN(22)) { FRESH(); moe_tables(cnt1, TB, tid); _Pragma("unroll 1") for (int rep_ = 0; rep_ < NREP(22); ++rep_) list_phase(TOPI, RANK, SLOT, LIST, TB, gtid, NGT); }
    SEAM(22);
    if (IN(23)) { FRESH(); moe_tables(cnt1, TB, tid); GroupOrder S; S.init(TB, LIST, 2, G, bx); EpiGateUp E{HB};
        _Pragma("unroll 1") for (int rep_ = 0; rep_ < NREP(23); ++rep_) pg8::gemm_phase<EpiGateUp, GroupOrder, true>(lds, H2A, GU, DM, S, E, wave); }
    SEAM(23);
    if (IN(24)) { FRESH(); moe_tables(cnt1, TB, tid); GroupOrder S; S.init(TB, nullptr, 4, G, bx); EpiDown E{YB};
        _Pragma("unroll 1") for (int rep_ = 0; rep_ < NREP(24); ++rep_) pg8::gemm_phase<EpiDown, GroupOrder, true>(lds, HB, DN, EFF, S, E, wave); }
    SEAM(24);
    if (IN(25)) { FRESH(); combine_phase(xo, YB, SLOT, TOPW, MOD + 8 * 6144, 5120, nullptr, nullptr, 0, 0, nullptr, fnorm, gw, NGW, lane); }
    {
    if (pass == 1 && hi < N_PHASES && hi > 0 && IN(hi - 1)) { FRESH();
        xcd_barrier(bar);
        const float* src = (hi - 1 >= 6) ? (const float*)xo : x_in;
        for (int m = gw; m < NTOK; m += NGW) { const f32x4* xr = (const f32x4*)(src + (size_t)m * DM) + lane; f32x4 v[4];
#pragma unroll
            for (int j = 0; j < 4; ++j) v[j] = xr[64 * j];
            finalnorm_row(v, fnorm, xo + (size_t)m * DM, lane); }
    }
    }
#undef IN
#undef SEAM
}

extern "C" void kernel_launch(void* const* d_in, const int* in_sizes, int n_in, void* d_out, int out_size, void* d_ws, size_t ws_size, hipStream_t stream) {
    static int grid = 0;
    if (grid == 0) {
        if (n_in != 44 || in_sizes[0] != NTOK * DM || out_size != NTOK * DM || ws_size < WS_END) {
            fprintf(stderr, "kernel_launch: shape mismatch: n_in %d in0 %d out %d ws %zu (need %zu)\n", n_in, n_in > 0 ? in_sizes[0] : -1, out_size, ws_size, (size_t)WS_END); grid = -1; return; }
        int dev = 0, cus = 0, per_cu = 0;
        if (hipGetDevice(&dev) != hipSuccess || hipDeviceGetAttribute(&cus, hipDeviceAttributeMultiprocessorCount, dev) != hipSuccess) { grid = -1; return; }
        if (hipFuncSetAttribute((const void*)fwd_kernel, hipFuncAttributeMaxDynamicSharedMemorySize, LDS_BYTES) != hipSuccess) { fprintf(stderr, "kernel_launch: hipFuncSetAttribute failed\n"); grid = -1; return; }
        if (hipOccupancyMaxActiveBlocksPerMultiprocessor(&per_cu, (const void*)fwd_kernel, NWAVES * 64, LDS_BYTES) != hipSuccess || per_cu < 1) { fprintf(stderr, "kernel_launch: occupancy query reports %d\n", per_cu); }
        (void)hipGetLastError();
        grid = cus;
    }
    if (grid < 0) return;
    if (hipMemsetAsync((char*)d_ws + WS_CTL, 0, CTL_ZERO_BYTES, stream) != hipSuccess) return;
    Args a{};
    for (int i = 0; i < 44; ++i) a.in[i] = (const float*)d_in[i];
    a.out = (float*)d_out; a.ws = (unsigned char*)d_ws;
#if PREFIX_K >= 0
    a.ph_lo = 0; a.ph_hi = PREFIX_K + 1; a.li = 0;
    hipLaunchKernelGGL(fwd_kernel, dim3(grid), dim3(NWAVES * 64), LDS_BYTES, stream, a);
#endif
    a.ph_lo = 0; a.ph_hi = STOP_AFTER + 1; a.li = 1;
    hipLaunchKernelGGL(fwd_kernel, dim3(grid), dim3(NWAVES * 64), LDS_BYTES, stream, a);
    const hipError_t le = hipPeekAtLastError();
    if (le != hipSuccess) fprintf(stderr, "kernel_launch: launch failed: %s\n", hipGetErrorName(le));
}
```

```cpp
#include <hip/hip_runtime.h>
#include <cstdio>
#include <cstdint>

namespace pg8 {
#define PG8_LAS __attribute__((address_space(3)))
typedef unsigned short bf16_t;
typedef short bf16x8 __attribute__((ext_vector_type(8)));
typedef float f32x4 __attribute__((ext_vector_type(4)));
typedef unsigned u32x4 __attribute__((ext_vector_type(4)));
constexpr int BM = 256, BK = 64, HALF = 128, HTB = HALF * BK * 2  , STAGE_BYTES = 8 * HTB, NXCD = 8, WGM = 8;

__host__ __device__ __forceinline__ int lds_byte(int r, int c) { const int st = (r >> 4) * 2 + (c >> 5), rr = r & 15, cc = c & 31, ob = rr * 64 + cc * 2; return st * 1024 + (ob ^ (((ob >> 9) & 1) << 5)); }
__host__ __device__ __forceinline__ void stage_rc(int b, int& R, int& C) { const int st = b / 1024, sb = b % 1024, swz = sb ^ (((sb >> 9) & 1) << 5); R = (st >> 1) * 16 + swz / 64; C = (st & 1) * 32 + (swz % 64) / 2; }
__host__ __device__ __forceinline__ int perm32(int rho) { const int n = rho >> 4, i = rho & 15; return 8 * (i >> 2) + 4 * n + (i & 3); }

__device__ __forceinline__ int fresh_lane() { int l; asm volatile("v_mbcnt_lo_u32_b32 %0, -1, 0\n\tv_mbcnt_hi_u32_b32 %0, -1, %0" : "=v"(l)); return l; }

struct Unit { int pn, arow0, nvalid, bt; };

struct DenseOrder {
    int nM, nN, nwg, G, c;
    __device__ __forceinline__ void init(int M, int N, int G_, int c_) { nM = M / BM; nN = N / BM; nwg = nM * nN; G = G_; c = c_; }
    __device__ __forceinline__ bool next(int i, Unit& u) const {
        const long L = (long)i * G + c; if (L >= nwg) return false;
        int wgid = (int)L; { const int q = nwg / NXCD, r = nwg % NXCD, xcd = wgid % NXCD, off = wgid / NXCD; wgid = (xcd < r ? xcd * (q + 1) : r * (q + 1) + (xcd - r) * q) + off; }
        const int nig = WGM * nN, gid = wgid / nig, fm = gid * WGM, gsz = (nM - fm) < WGM ? (nM - fm) : WGM;
        const int pm = fm + ((wgid % nig) % gsz); u.pn = (wgid % nig) / gsz; u.arow0 = pm * BM; u.nvalid = BM; u.bt = u.pn; return true;
    }
    __device__ __forceinline__ int arow(const Unit& u, int r) const { return u.arow0 + r; }
};

__device__ __forceinline__ unsigned cvt_pk_bf16(float lo, float hi) { unsigned r; asm volatile("v_cvt_pk_bf16_f32 %0, %1, %2" : "=v"(r) : "v"(lo), "v"(hi)); return r; }

template <class Epi, class Sched, bool ALIGN_EPI>
__device__ __forceinline__ void gemm_phase(PG8_LAS unsigned char* lds, const bf16_t* A, const bf16_t* Bt, const int K, const Sched& S, const Epi& E, const int wid  ) {
    int tid = wid * 64 + pg8::fresh_lane(); asm volatile("" : "+v"(tid));
    const int lane = tid & 63, wr = wid >> 2, wc = wid & 3, fr = lane & 15, fq = lane >> 4;
    const int nt = K / BK;
    unsigned voffB[2];
#pragma unroll
    for (int i = 0; i < 2; ++i) { int R, C; stage_rc(tid * 16 + i * 8192, R, C); const int Rb = Epi::PERM ? ((R & ~31) + perm32(R & 31)) : R;
        voffB[i] = (unsigned)(Rb * K + C) * 2u; }
#define PG8_AOFF(U, o00, o01, o10, o11) do { int _t = wid * 64 + pg8::fresh_lane(); asm volatile("" : "+v"(_t)); int _R0, _C0, _R1, _C1; stage_rc(_t * 16, _R0, _C0); stage_rc(_t * 16 + 8192, _R1, _C1); \
        o00 = (unsigned)S.arow(U, _R0) * K2 + (unsigned)_C0 * 2u; o01 = (unsigned)S.arow(U, _R1) * K2 + (unsigned)_C1 * 2u; \
        o10 = (unsigned)S.arow(U, HALF + _R0) * K2 + (unsigned)_C0 * 2u; o11 = (unsigned)S.arow(U, HALF + _R1) * K2 + (unsigned)_C1 * 2u; } while (0)
    const unsigned K2 = (unsigned)K * 2u;
    const unsigned kstep = (unsigned)(BK * 2);
    const size_t hstep = (size_t)HALF * K * 2;
    const size_t tstep = 2 * hstep;
    const unsigned ldsw = (unsigned)wid * 1024u;
    const int aoff = lds_byte(wr * 64 + fr, fq * 8), boff = lds_byte(wc * 32 + fr, fq * 8);
    const char* Ab = (const char*)A; const char* Bb = (const char*)Bt;
#define PG8_SA(b, h) (((b) * 2 + (h)) * HTB)
#define PG8_SB(b, h) ((4 + (b) * 2 + (h)) * HTB)
#define PG8_STAGE_B(bufoff, gbase) do { _Pragma("unroll") for (int _i = 0; _i < 2; ++_i) \
        __builtin_amdgcn_global_load_lds((const unsigned*)((const char*)(gbase) + voffB[_i]), (PG8_LAS unsigned*)(lds + (bufoff) + ldsw + _i * 8192), 16, 0, 0); } while (0)
#define PG8_STAGE_A(bufoff, kbyte, o0, o1) do { \
        __builtin_amdgcn_global_load_lds((const unsigned*)(Ab + (size_t)((kbyte) + (o0))), (PG8_LAS unsigned*)(lds + (bufoff) + ldsw), 16, 0, 0); \
        __builtin_amdgcn_global_load_lds((const unsigned*)(Ab + (size_t)((kbyte) + (o1))), (PG8_LAS unsigned*)(lds + (bufoff) + ldsw + 8192), 16, 0, 0); } while (0)
#define PG8_LDA(dst, b, h) do { _Pragma("unroll") for (int m = 0; m < 4; ++m) _Pragma("unroll") for (int k = 0; k < 2; ++k) dst[m][k] = *(const PG8_LAS bf16x8*)(lds + PG8_SA(b, h) + aoff + m * 2048 + k * 1024); } while (0)
#define PG8_LDB(dst, b, h) do { _Pragma("unroll") for (int n = 0; n < 2; ++n) _Pragma("unroll") for (int k = 0; k < 2; ++k) dst[n][k] = *(const PG8_LAS bf16x8*)(lds + PG8_SB(b, h) + boff + n * 2048 + k * 1024); } while (0)
#define PG8_MMA(ai, bj, At, Bt_) do { __builtin_amdgcn_s_setprio(1); _Pragma("unroll") for (int m = 0; m < 4; ++m) _Pragma("unroll") for (int n = 0; n < 2; ++n) _Pragma("unroll") for (int k = 0; k < 2; ++k) \
        acc[ai][bj][m][n] = __builtin_amdgcn_mfma_f32_16x16x32_bf16(Bt_[n][k], At[m][k], acc[ai][bj][m][n], 0, 0, 0); __builtin_amdgcn_s_setprio(0); } while (0)
#define PG8_WAIT_V(n) asm volatile("s_waitcnt vmcnt(" #n ")" ::: "memory")
#define PG8_WAIT_L(n) asm volatile("s_waitcnt lgkmcnt(" #n ")" ::: "memory")
#define PG8_BAR __builtin_amdgcn_s_barrier()
#define PG8_SCHED __builtin_amdgcn_sched_barrier(0)
    Unit cur, nxt; int ui = 0;
    if (!S.next(0, cur)) return;
    f32x4 acc[2][2][4][2];
#pragma unroll
    for (int a = 0; a < 2; ++a)
#pragma unroll
        for (int b = 0; b < 2; ++b)
#pragma unroll
            for (int m = 0; m < 4; ++m)
#pragma unroll
                for (int n = 0; n < 2; ++n) acc[a][b][m][n] = (f32x4){0.f, 0.f, 0.f, 0.f};
    bf16x8 At[4][2], B0[2][2], B1[2][2];
    unsigned c00, c01, c10, c11, n00, n01, n10, n11;
    PG8_AOFF(cur, c00, c01, c10, c11);
    const char* cB = Bb + (size_t)cur.bt * tstep;
    PG8_STAGE_B(PG8_SB(0, 0), cB); PG8_STAGE_B(PG8_SB(0, 1), cB + hstep); PG8_STAGE_A(PG8_SA(0, 0), 0u, c00, c01); PG8_STAGE_A(PG8_SA(0, 1), 0u, c10, c11);
    if (wr == 1) PG8_BAR;
    PG8_WAIT_V(2); PG8_BAR;
    PG8_STAGE_B(PG8_SB(1, 0), cB + kstep); PG8_STAGE_A(PG8_SA(1, 0), kstep, c00, c01); PG8_STAGE_B(PG8_SB(1, 1), cB + hstep + kstep);
    PG8_WAIT_V(6); PG8_BAR;
    for (;;) {
        const bool has_next = S.next(ui + 1, nxt);
        if (has_next) { PG8_AOFF(nxt, n00, n01, n10, n11); } else { n00 = c00; n01 = c01; n10 = c10; n11 = c11; }
        const char* nB = has_next ? Bb + (size_t)nxt.bt * tstep : cB;
        for (int t = 0; t < nt; t += 2) {
            const bool last = (t == nt - 2);
            const unsigned kb1 = (unsigned)(t + 1) * kstep;
            const unsigned kb2 = last ? 0u : (unsigned)(t + 2) * kstep, kb3 = kb2 + kstep;
            const unsigned a00 = last ? n00 : c00, a01 = last ? n01 : c01, a10 = last ? n10 : c10, a11 = last ? n11 : c11;
            const char* b2 = last ? nB : cB + (size_t)(t + 2) * kstep; const char* b3 = b2 + kstep;
            PG8_LDB(B0, 0, 0); PG8_LDB(B1, 0, 1); PG8_SCHED; PG8_LDA(At, 0, 0); PG8_STAGE_A(PG8_SA(1, 1), kb1, c10, c11);
            PG8_WAIT_V(8); PG8_WAIT_L(0); PG8_BAR; PG8_MMA(0, 0, At, B0); PG8_MMA(0, 1, At, B1); PG8_BAR; PG8_SCHED;
            PG8_LDA(At, 0, 1); PG8_STAGE_B(PG8_SB(0, 0), b2); PG8_STAGE_B(PG8_SB(0, 1), b2 + hstep); PG8_STAGE_A(PG8_SA(0, 0), kb2, a00, a01);
            PG8_WAIT_V(8); PG8_WAIT_L(0); PG8_BAR; PG8_MMA(1, 0, At, B0); PG8_MMA(1, 1, At, B1); PG8_BAR; PG8_SCHED;
            PG8_LDB(B0, 1, 0); PG8_LDB(B1, 1, 1); PG8_SCHED; PG8_LDA(At, 1, 0); PG8_STAGE_A(PG8_SA(0, 1), kb2, a10, a11);
            PG8_WAIT_V(8); PG8_WAIT_L(0); PG8_BAR; PG8_MMA(0, 0, At, B0); PG8_MMA(0, 1, At, B1); PG8_BAR; PG8_SCHED;
            PG8_LDA(At, 1, 1); PG8_STAGE_B(PG8_SB(1, 0), b3); PG8_STAGE_B(PG8_SB(1, 1), b3 + hstep); PG8_STAGE_A(PG8_SA(1, 0), kb3, a00, a01);
            PG8_WAIT_V(8); PG8_WAIT_L(0); PG8_BAR; PG8_MMA(1, 0, At, B0); PG8_MMA(1, 1, At, B1); PG8_BAR; PG8_SCHED;
        }
        if constexpr (ALIGN_EPI) { if (wr == 0) PG8_BAR; }
        E(acc, cur, wr, wc, fr, fq);
        if (!has_next) break;
#pragma unroll
        for (int a = 0; a < 2; ++a)
#pragma unroll
            for (int b = 0; b < 2; ++b)
#pragma unroll
                for (int m = 0; m < 4; ++m)
#pragma unroll
                    for (int n = 0; n < 2; ++n) acc[a][b][m][n] = (f32x4){0.f, 0.f, 0.f, 0.f};
        cur = nxt; cB = nB; c00 = n00; c01 = n01; c10 = n10; c11 = n11; ++ui;
        if constexpr (ALIGN_EPI) { if (wr == 1) PG8_BAR; }
    }
    PG8_WAIT_V(0);
    if constexpr (!ALIGN_EPI) { if (wr == 0) PG8_BAR; }
    PG8_BAR;
#undef PG8_AOFF
#undef PG8_SA
#undef PG8_SB
#undef PG8_STAGE_A
#undef PG8_STAGE_B
#undef PG8_LDA
#undef PG8_LDB
#undef PG8_MMA
#undef PG8_WAIT_V
#undef PG8_WAIT_L
#undef PG8_BAR
#undef PG8_SCHED
}
}
#ifndef DUPMASK
#define DUPMASK 0u
#endif
#define NREP(k) (((DUPMASK >> (k)) & 1u) ? 2 : 1)
constexpr int NB = 8, NT_ = 4096, DM = 1024, NTOK = NB * NT_;
constexpr int GW = 512;
constexpr int P0W = 4096, P1W = 3840;
constexpr int NEXP = 128, EFF = 256, NSLOT = NTOK * 8, NSLOT_ALL = NSLOT + NTOK;
constexpr float EPS = 1e-6f;
constexpr int NWAVES = 8;

constexpr size_t MiB = 1u << 20;
constexpr size_t WS_CTL = 0, CTL_ZERO_BYTES = 1 * MiB;
constexpr size_t WS_TAB = 1 * MiB;
constexpr size_t WS_MOD = WS_TAB + 256 * 1024;
constexpr size_t WS_OML = WS_MOD + 2 * 8 * 6144 * 4;
constexpr size_t WS_WIN0 = 2 * MiB, WS_WIN1 = 10 * MiB, WS_WOUT0 = 18 * MiB, WS_WOUT1 = 20 * MiB, WS_ROUT0 = 22 * MiB, WS_ROUT1 = 23 * MiB;
constexpr size_t WS_GU = 24 * MiB;
constexpr size_t WS_DN = 153 * MiB;
constexpr size_t WS_H2A = 218 * MiB;
constexpr size_t WS_PROJ = 282 * MiB;
constexpr size_t WS_CAT = 538 * MiB;
constexpr size_t WS_OF = 602 * MiB, WS_OB = 666 * MiB;
constexpr size_t WS_QKC = 730 * MiB;
constexpr size_t WS_Y = 218 * MiB;
constexpr size_t WS_HB = 794 * MiB;
constexpr size_t WS_H2B = 794 * MiB;
constexpr size_t WS_LOG = 938 * MiB;
constexpr size_t WS_TOPI = 970 * MiB, WS_TOPW = 971 * MiB, WS_RANK = 972 * MiB, WS_SLOT = 973 * MiB, WS_LIST = 974 * MiB;
constexpr size_t WS_SSP = 976 * MiB;
constexpr size_t WS_END = 978 * MiB;
constexpr int CW_TMO = 0, CW_BAR = 16384  , CW_Q0 = 8192  , CW_CNT0 = 9216  , CW_CNT1 = 9472, CW_PANEL = 32768  , CW_SS = 65536  ;

constexpr int RING_BYTES = 131072;
constexpr int LDSCTL_OFF = RING_BYTES, MISC_OFF = LDSCTL_OFF + 320;
constexpr int LDS_BYTES = 147456;
constexpr int TBL_OFF = MISC_OFF + 128;
constexpr int PST_OFF = 135168;

#define GAS __attribute__((address_space(1)))
#define LAS __attribute__((address_space(3)))
typedef unsigned short bf16;
typedef unsigned v4u __attribute__((ext_vector_type(4)));
typedef float f32x4 __attribute__((ext_vector_type(4)));
typedef short bf16x8 __attribute__((ext_vector_type(8)));
typedef GAS unsigned gu32;
typedef GAS unsigned long long gu64;
#define RLX_AGENT __ATOMIC_RELAXED, __HIP_MEMORY_SCOPE_AGENT
#define LDS_WAIT() asm volatile("s_waitcnt lgkmcnt(0)" ::: "memory")
#define VM_WAIT() asm volatile("s_waitcnt vmcnt(0)" ::: "memory")
__device__ __forceinline__ unsigned long long rt() { return __builtin_amdgcn_s_memrealtime(); }
__device__ __forceinline__ unsigned f2bf(float f) { unsigned u = __builtin_bit_cast(unsigned, f); return (u + 0x7fffu + ((u >> 16) & 1u)) >> 16; }
__device__ __forceinline__ unsigned pk2(float lo, float hi) { return f2bf(lo) | (f2bf(hi) << 16); }
#define XB_TMO      128
#define XB_XCNT(j)  (256  + 64 * (j))
#define XB_XSUB(j)  (1280 + 64 * (j))
#define XB_XGEN(j)  (2304 + 64 * (j))
#define XB_TOP      3328
#define XB_TOPGEN   3392
#define XCD_BAR_WORDS 3456
#define XB_SPIN_CAP (1u << 18)

__device__ __forceinline__ unsigned xb_ld(unsigned* p)              { return __hip_atomic_load(p, __ATOMIC_RELAXED, __HIP_MEMORY_SCOPE_AGENT); }
__device__ __forceinline__ unsigned xb_add(unsigned* p, unsigned v) { return __hip_atomic_fetch_add(p, v, __ATOMIC_RELAXED, __HIP_MEMORY_SCOPE_AGENT); }
__device__ __forceinline__ unsigned xb_xcc_id() { return (unsigned)__builtin_amdgcn_s_getreg((3 << 11) | 20) & 0xFu; }
#define XB_SPIN(cond, bar) do { unsigned _sp = 0; while (cond) { __builtin_amdgcn_s_sleep(1); \
    if ((++_sp & 255u) == 0u) { if (xb_ld(&(bar)[XB_TMO])) break; if (_sp > XB_SPIN_CAP) { atomicAdd(&(bar)[XB_TMO], 1u); break; } } } } while (0)

struct XcdBarrier {
    unsigned* bar; unsigned x;
    volatile LAS unsigned* st;
};

__device__ __forceinline__ XcdBarrier xcd_barrier_post(unsigned* bar, volatile LAS unsigned* st) {
    XcdBarrier b; b.bar = bar; b.x = xb_xcc_id(); b.st = st;
    if (threadIdx.x == 0) (void)xb_add(&bar[XB_XCNT(b.x)], 1u);
    return b;
}
__device__ __forceinline__ void xcd_barrier_complete(unsigned* bar, unsigned x, unsigned& nloc, unsigned& nx) {
    const unsigned G = gridDim.x * gridDim.y * gridDim.z;
    unsigned sum, cnt, mine, sp = 0u;
    for (;;) {
        sum = 0u; cnt = 0u; mine = 0u;
#pragma unroll
        for (unsigned j = 0; j < 16; ++j) { const unsigned c = xb_ld(&bar[XB_XCNT(j)]); sum += c; cnt += (c > 0u) ? 1u : 0u; mine = (j == x) ? c : mine; }
        if (sum == G) break;
        __builtin_amdgcn_s_sleep(1);
        if ((++sp & 255u) == 0u) { if (xb_ld(&bar[XB_TMO])) break; if (sp > XB_SPIN_CAP) { atomicAdd(&bar[XB_TMO], 1u); break; } }
    }
    nloc = mine > 0u ? mine : 1u; nx = cnt > 0u ? cnt : 1u;
}

__device__ __forceinline__ void xcd_barrier(const XcdBarrier& b) {
    asm volatile("s_waitcnt vmcnt(0)" ::: "memory");
    __syncthreads();
    if (threadIdx.x == 0) {
        unsigned* bar = b.bar;
        __builtin_amdgcn_s_waitcnt(0);
        unsigned nloc = b.st[0], nx = b.st[1];
        if (nloc == 0u) { xcd_barrier_complete(bar, b.x, nloc, nx); b.st[0] = nloc; b.st[1] = nx; }
        const unsigned old = xb_add(&bar[XB_XSUB(b.x)], 1u);
        const unsigned gen = old / nloc;
        if (old + 1u == (gen + 1u) * nloc) {
            __builtin_amdgcn_fence(__ATOMIC_RELEASE, "agent");
            asm volatile("s_waitcnt vmcnt(0)" ::: "memory");
            const unsigned og = xb_add(&bar[XB_TOP], 1u);
            const unsigned tg = og / nx;
            if (og + 1u == (tg + 1u) * nx) xb_add(&bar[XB_TOPGEN], 1u);
            else XB_SPIN(xb_ld(&bar[XB_TOPGEN]) == tg, bar);
            __builtin_amdgcn_fence(__ATOMIC_ACQUIRE, "agent");
            xb_add(&bar[XB_XGEN(b.x)], 1u);
            asm volatile("s_waitcnt vmcnt(0)" ::: "memory");
        } else {
            XB_SPIN(xb_ld(&bar[XB_XGEN(b.x)]) == gen, bar);
            __builtin_amdgcn_fence(__ATOMIC_ACQUIRE, "agent");
            asm volatile("s_waitcnt vmcnt(0)" ::: "memory");
        }
    }
    __syncthreads();
}
typedef float f32x2 __attribute__((ext_vector_type(2)));
typedef unsigned u32x2 __attribute__((ext_vector_type(2)));
__device__ __forceinline__ float bflo(unsigned w) { return __builtin_bit_cast(float, w << 16); }
__device__ __forceinline__ float bfhi(unsigned w) { return __builtin_bit_cast(float, w & 0xffff0000u); }
__device__ __forceinline__ float bf2f(bf16 b) { return __builtin_bit_cast(float, (unsigned)b << 16); }
__device__ __forceinline__ float wave_sum(float v) {
#pragma unroll
    for (int o = 1; o < 64; o <<= 1) v += __shfl_xor(v, o);
    return v;
}
__device__ __forceinline__ float sigm(float x) { return __builtin_amdgcn_rcpf(1.f + __expf(-x)); }
__device__ __forceinline__ float sigm_div(float x) { return 1.f / (1.f + __expf(-x)); }
__device__ __forceinline__ float silu(float x) { return x * __builtin_amdgcn_rcpf(1.f + __expf(-x)); }
__device__ __forceinline__ void unpack8(v4u w, float (&f)[8]) { f[0] = bflo(w.x); f[1] = bfhi(w.x); f[2] = bflo(w.y); f[3] = bfhi(w.y); f[4] = bflo(w.z); f[5] = bfhi(w.z); f[6] = bflo(w.w); f[7] = bfhi(w.w); }
__device__ __forceinline__ v4u pack8(const float (&f)[8]) { v4u w; w.x = pk2(f[0], f[1]); w.y = pk2(f[2], f[3]); w.z = pk2(f[4], f[5]); w.w = pk2(f[6], f[7]); return w; }

__device__ __forceinline__ void tr_item(const float* W, int ldw, int k0, int c0, int cvalid, bf16* WT, int ldt, int r0, LAS float* scr, int lane) {
    float wv[32];
#pragma unroll
    for (int i = 0; i < 32; ++i) { const int kk = 2 * i + (lane >> 5), n = lane & 31; wv[i] = (n < cvalid) ? W[(size_t)(k0 + kk) * ldw + c0 + n] : 0.f; }
#pragma unroll
    for (int i = 0; i < 32; ++i) { const int kk = 2 * i + (lane >> 5), n = lane & 31; scr[kk * 33 + n] = wv[i]; }
    LDS_WAIT(); asm volatile("" ::: "memory");
    const int c = lane & 7;
#pragma unroll
    for (int j = 0; j < 4; ++j) { const int n = (lane >> 3) + 8 * j; const LAS float* s = scr + (8 * c) * 33 + n;
        v4u o; o.x = pk2(s[0 * 33], s[1 * 33]); o.y = pk2(s[2 * 33], s[3 * 33]); o.z = pk2(s[4 * 33], s[5 * 33]); o.w = pk2(s[6 * 33], s[7 * 33]);
        *(v4u*)(WT + (size_t)(r0 + n) * ldt + k0 + 8 * c) = o; }
    LDS_WAIT(); asm volatile("" ::: "memory");
}
__device__ __forceinline__ void expert_item(const float* gate, const float* up, const float* down, const float* sgate, const float* sup, const float* sdown,
                                            bf16* GU, bf16* DN, int it, LAS float* scr, int lane) {
    const int e = it / 384, r = it - e * 384;
    const bool sh = (e == NEXP);
    if (r < 256) {
        const bool isup = r >= 128; const int rr = r & 127, sub = rr >> 6, q = rr & 63, kb = q >> 2, nb = q & 3;
        const float* W = sh ? (isup ? sup : sgate) : ((isup ? up : gate) + (size_t)e * (DM * EFF));
        tr_item(W, EFF, kb * 64, sub * 128 + nb * 32, 32, GU + (size_t)e * (512 * DM), DM, 256 * sub + (isup ? 128 : 0) + nb * 32, scr, lane);
    } else {
        const int rr = r - 256, kb = rr >> 5, nb = rr & 31;
        const float* W = sh ? sdown : down + (size_t)e * (EFF * DM);
        tr_item(W, DM, kb * 64, nb * 32, 32, DN + (size_t)e * (DM * EFF), EFF, nb * 32, scr, lane);
    }
}
#define TR_JOB(W_, ldw_, K_, c0_, ncols_, WT_, r0_) do { const int _nb = ((ncols_) + 31) / 32, _ni = ((K_) / 64) * _nb; \
        for (int _it = (gw + NGW - (jbase % NGW)) % NGW; _it < _ni; _it += NGW) { const int _kb = _it / _nb, _nk = _it % _nb; const int _cv = (ncols_) - _nk * 32; \
            tr_item(W_, ldw_, _kb * 64, (c0_) + _nk * 32, _cv < 32 ? _cv : 32, WT_, K_, (r0_) + _nk * 32, scr, lane); } jbase += _ni; } while (0)

__device__ __forceinline__ void mod_unit(int u, const float* c, const float* wm0, const float* bm0, const float* wm1, const float* bm1, float* MOD, LAS unsigned char* lds, int tid, int wave, int lane) {
    LAS float* sc = (LAS float*)(lds + 69632);
    LAS float* red = (LAS float*)(lds + 69632 + 32768);
    const int l = u / 96, cb = u % 96; const float* wm = l ? wm1 : wm0; const float* bm = l ? bm1 : bm0;
    for (int i = tid; i < NB * DM; i += 512) sc[i] = silu(c[i]);
    __syncthreads();
    float acc[8];
#pragma unroll
    for (int b = 0; b < 8; ++b) acc[b] = 0.f;
    const float* wp = wm + (size_t)(wave * 128) * 6144 + cb * 64 + lane;
    for (int k0 = 0; k0 < 128; k0 += 8) {
        float w[8];
#pragma unroll
        for (int j = 0; j < 8; ++j) w[j] = wp[(size_t)(k0 + j) * 6144];
#pragma unroll
        for (int j = 0; j < 8; ++j)
#pragma unroll
            for (int b = 0; b < 8; ++b) acc[b] += sc[b * DM + wave * 128 + k0 + j] * w[j];
    }
#pragma unroll
    for (int b = 0; b < 8; ++b) red[(wave * 8 + b) * 64 + lane] = acc[b];
    __syncthreads();
    { const int b = tid >> 6; float s = 0.f;
#pragma unroll
      for (int w = 0; w < 8; ++w) s += red[(w * 8 + b) * 64 + lane];
      MOD[(size_t)(l * 8 + b) * 6144 + cb * 64 + lane] = s + bm[cb * 64 + lane]; }
    __syncthreads();
}

__device__ __forceinline__ void normmod_row(const f32x4 (&v)[4], const float* gain, const float* shift, const float* scale, bf16* orow, int lane) {
    float ss = 0.f;
#pragma unroll
    for (int j = 0; j < 4; ++j) ss += (v[j].x * v[j].x + v[j].y * v[j].y) + (v[j].z * v[j].z + v[j].w * v[j].w);
    const float r = 1.f / sqrtf(wave_sum(ss) * (1.f / DM) + EPS);
    unsigned long long* o8 = (unsigned long long*)orow + lane;
#pragma unroll
    for (int j = 0; j < 4; ++j) { const f32x4 g = ((const f32x4*)gain)[lane + 64 * j], sh = ((const f32x4*)shift)[lane + 64 * j], sc = ((const f32x4*)scale)[lane + 64 * j];
        const f32x4 y = v[j] * r * g * (sc + 1.f) + sh;
        o8[64 * j] = (unsigned long long)pk2(y.x, y.y) | ((unsigned long long)pk2(y.z, y.w) << 32); }
}
__device__ __forceinline__ void normmod_phase(const float* X, const float* gain, const float* modl  , int sh_off, int sc_off, bf16* H, int gw, int NGW, int lane) {
    for (int m = gw; m < NTOK; m += NGW) {
        const f32x4* xr = (const f32x4*)(X + (size_t)m * DM) + lane; f32x4 v[4];
#pragma unroll
        for (int j = 0; j < 4; ++j) v[j] = xr[64 * j];
        const float* mb = modl + (size_t)(m >> 12) * 6144;
        normmod_row(v, gain, mb + sh_off, mb + sc_off, H + (size_t)m * DM, lane);
    }
}
__device__ __forceinline__ void finalnorm_row(const f32x4 (&v)[4], const float* gain, float* orow, int lane) {
    float ss = 0.f;
#pragma unroll
    for (int j = 0; j < 4; ++j) ss += (v[j].x * v[j].x + v[j].y * v[j].y) + (v[j].z * v[j].z + v[j].w * v[j].w);
    const float r = 1.f / sqrtf(wave_sum(ss) * (1.f / DM) + EPS);
#pragma unroll
    for (int j = 0; j < 4; ++j) ((f32x4*)orow)[lane + 64 * j] = v[j] * r * ((const f32x4*)gain)[lane + 64 * j];
}

__device__ __forceinline__ void rope_phase(bf16* P, const float* tab, int gtid, int NGT) {
    for (int idx = gtid; idx < NTOK * 16; idx += NGT) {
        const int tok = idx >> 4, grp = idx & 15, t = tok & (NT_ - 1);
        bf16* p = P + (size_t)tok * P0W + (grp < 8 ? 2560 : 3072) + (grp & 7) * 64;
        const v4u a = *(const v4u*)p, b = *(const v4u*)(p + 8);
        float x1[8], x2[8], cs[8], sn[8], y1[8], y2[8];
        unpack8(a, x1); unpack8(b, x2);
        const f32x4* tp = (const f32x4*)(tab + (size_t)t * 16);
        const f32x4 c0 = tp[0], c1 = tp[1], s0 = tp[2], s1 = tp[3];
        cs[0] = c0.x; cs[1] = c0.y; cs[2] = c0.z; cs[3] = c0.w; cs[4] = c1.x; cs[5] = c1.y; cs[6] = c1.z; cs[7] = c1.w;
        sn[0] = s0.x; sn[1] = s0.y; sn[2] = s0.z; sn[3] = s0.w; sn[4] = s1.x; sn[5] = s1.y; sn[6] = s1.z; sn[7] = s1.w;
#pragma unroll
        for (int i = 0; i < 8; ++i) { y1[i] = x1[i] * cs[i] - x2[i] * sn[i]; y2[i] = x2[i] * cs[i] + x1[i] * sn[i]; }
        *(v4u*)p = pack8(y1); *(v4u*)(p + 8) = pack8(y2);
    }
}

template <int ACT  >
__device__ __forceinline__ void gateout_phase(const float* OF, const float* OB, const float* gain, const bf16* P, int pitch, int gcol, bf16* CAT, int gw, int NGW, int lane) {
    const int hh = lane >> 4, e0 = (lane & 15) * 8;
    const f32x4 g0 = *(const f32x4*)(gain + e0), g1 = *(const f32x4*)(gain + e0 + 4);
    for (int m = gw; m < NTOK; m += NGW) {
        const float* pf = OF + (size_t)m * GW + hh * 128 + e0; const float* pb = OB + (size_t)m * GW + hh * 128 + e0;
        const f32x4 a0 = *(const f32x4*)pf + *(const f32x4*)pb, a1 = *(const f32x4*)(pf + 4) + *(const f32x4*)(pb + 4);
        float ss = (a0.x * a0.x + a0.y * a0.y) + (a0.z * a0.z + a0.w * a0.w) + (a1.x * a1.x + a1.y * a1.y) + (a1.z * a1.z + a1.w * a1.w);
        ss += __shfl_xor(ss, 1); ss += __shfl_xor(ss, 2); ss += __shfl_xor(ss, 4); ss += __shfl_xor(ss, 8);
        const float r = 1.f / sqrtf(ss * (1.f / 128.f) + EPS);
        float gv[8]; unpack8(*(const v4u*)(P + (size_t)m * pitch + gcol + hh * 128 + e0), gv);
        float y[8];
        const f32x4 n0 = a0 * r * g0, n1 = a1 * r * g1;
        y[0] = n0.x; y[1] = n0.y; y[2] = n0.z; y[3] = n0.w; y[4] = n1.x; y[5] = n1.y; y[6] = n1.z; y[7] = n1.w;
#pragma unroll
        for (int i = 0; i < 8; ++i) y[i] *= (ACT == 0) ? silu(gv[i]) : ((ACT == 1) ? sigm(gv[i]) : gv[i]);
        *(v4u*)(CAT + (size_t)m * DM + hh * 128 + e0) = pack8(y);
    }
}

struct EpiStoreBf16 {
    static constexpr bool PERM = true;
    bf16* O; int ldc;
    __device__ __forceinline__ void operator()(pg8::f32x4 (&acc)[2][2][4][2], const pg8::Unit& u, int wr, int wc, int fr, int fq) const {
        const int row0 = u.arow0 + wr * 64 + fr, col0 = u.pn * 256 + wc * 32 + 8 * fq;
#pragma unroll
        for (int ai = 0; ai < 2; ++ai)
#pragma unroll
            for (int m = 0; m < 4; ++m) { bf16* rowp = O + (size_t)(row0 + ai * 128 + m * 16) * ldc + col0;
#pragma unroll
                for (int bj = 0; bj < 2; ++bj) { const pg8::f32x4 v0 = acc[ai][bj][m][0], v1 = acc[ai][bj][m][1];
                    v4u w; w.x = pg8::cvt_pk_bf16(v0[0], v0[1]); w.y = pg8::cvt_pk_bf16(v0[2], v0[3]); w.z = pg8::cvt_pk_bf16(v1[0], v1[1]); w.w = pg8::cvt_pk_bf16(v1[2], v1[3]);
                    *(v4u*)(rowp + bj * 128) = w; } }
    }
};
struct EpiProj0 {
    static constexpr bool PERM = true;
    bf16* O; const float* oml; const float* tab;
    __device__ __forceinline__ void operator()(pg8::f32x4 (&acc)[2][2][4][2], const pg8::Unit& u, int wr, int wc, int fr, int fq) const {
        const int row0 = u.arow0 + wr * 64 + fr, colt = wc * 32 + 8 * fq, col0 = u.pn * 256 + colt;
        const int kind = (u.pn < 2 || u.pn == 8 || u.pn == 9) ? 1 : ((u.pn >= 4 && u.pn < 8) ? 2 : ((u.pn >= 10 && u.pn < 14) ? 3 : 0));
        const bool ropew = (kind == 3) && ((wc & 1) == 0);
#pragma unroll
        for (int ai = 0; ai < 2; ++ai)
#pragma unroll
            for (int m = 0; m < 4; ++m) { const int row = row0 + ai * 128 + m * 16; bf16* rowp = O + (size_t)row * P0W + col0;
                pg8::f32x4 cs0 = {0.f, 0.f, 0.f, 0.f}, cs1 = cs0, sn0 = cs0, sn1 = cs0;
                if (ropew) { const pg8::f32x4* tp = (const pg8::f32x4*)(tab + (size_t)(row & (NT_ - 1)) * 16); cs0 = tp[0]; cs1 = tp[1]; sn0 = tp[2]; sn1 = tp[3]; if (fq == 0) { sn0 = -sn0; sn1 = -sn1; } }
#pragma unroll
                for (int bj = 0; bj < 2; ++bj) { pg8::f32x4 v0 = acc[ai][bj][m][0], v1 = acc[ai][bj][m][1];
                    if (kind == 1) {
#pragma unroll
                        for (int j = 0; j < 4; ++j) { v0[j] = silu(v0[j]); v1[j] = silu(v1[j]); } }
                    else if (kind == 2) { const float* op = oml + (u.pn - 4) * 256 + bj * 128 + colt; const pg8::f32x4 o0 = *(const pg8::f32x4*)op, o1 = *(const pg8::f32x4*)(op + 4);
#pragma unroll
                        for (int j = 0; j < 4; ++j) { v0[j] = o0[j] * sigm(-v0[j]); v1[j] = o1[j] * sigm(-v1[j]); } }
                    else if (ropew) { pg8::f32x4 p0, p1;
#pragma unroll
                        for (int j = 0; j < 4; ++j) { p0[j] = __shfl_xor(v0[j], 16); p1[j] = __shfl_xor(v1[j], 16); }
                        if (fq < 2) { v0 = v0 * cs0 + p0 * sn0; v1 = v1 * cs1 + p1 * sn1; } }
                    v4u w; w.x = pg8::cvt_pk_bf16(v0[0], v0[1]); w.y = pg8::cvt_pk_bf16(v0[2], v0[3]); w.z = pg8::cvt_pk_bf16(v1[0], v1[1]); w.w = pg8::cvt_pk_bf16(v1[2], v1[3]);
                    *(v4u*)(rowp + bj * 128) = w; } }
    }
};
struct EpiResid {
    static constexpr bool PERM = false;
    const float* xin; float* out; const float* gm;
    __device__ __forceinline__ void operator()(pg8::f32x4 (&acc)[2][2][4][2], const pg8::Unit& u, int wr, int wc, int fr, int fq) const {
        const int row0 = u.arow0 + wr * 64 + fr, col0 = u.pn * 256 + wc * 32 + 4 * fq;
#pragma unroll
        for (int ai = 0; ai < 2; ++ai)
#pragma unroll
            for (int m = 0; m < 4; ++m) { const int row = row0 + ai * 128 + m * 16; const float* gp = gm + (size_t)(row >> 12) * 6144 + col0; const size_t ro = (size_t)row * DM + col0;
#pragma unroll
                for (int bj = 0; bj < 2; ++bj)
#pragma unroll
                    for (int n = 0; n < 2; ++n) { const int c = bj * 128 + n * 16;
                        const pg8::f32x4 x4 = *(const pg8::f32x4*)(xin + ro + c), g4 = *(const pg8::f32x4*)(gp + c);
                        *(pg8::f32x4*)(out + ro + c) = x4 + g4 * acc[ai][bj][m][n]; } }
    }
};
struct EpiResidNorm {
    static constexpr bool PERM = false;
    const float* xin; float* out; const float* gm; const float* gain; const float* shm; const float* scm; bf16* H; float* SSP; gu32* cnt; LAS float* P;
    __device__ __forceinline__ void operator()(pg8::f32x4 (&acc)[2][2][4][2], const pg8::Unit& u, int wr, int wc, int fr, int fq) const {
        const int row0 = u.arow0 + wr * 64 + fr, col0 = u.pn * 256 + wc * 32 + 4 * fq, pm = u.arow0 >> 8, wave = wr * 4 + wc, tidl = wave * 64 + fq * 16 + fr;
#pragma unroll
        for (int ai = 0; ai < 2; ++ai)
#pragma unroll
            for (int m = 0; m < 4; ++m) { const int row = row0 + ai * 128 + m * 16; const float* gp = gm + (size_t)(row >> 12) * 6144 + col0; const size_t ro = (size_t)row * DM + col0; float ss = 0.f;
#pragma unroll
                for (int bj = 0; bj < 2; ++bj)
#pragma unroll
                    for (int n = 0; n < 2; ++n) { const int c = bj * 128 + n * 16;
                        const pg8::f32x4 x1 = *(const pg8::f32x4*)(xin + ro + c) + *(const pg8::f32x4*)(gp + c) * acc[ai][bj][m][n];
                        *(pg8::f32x4*)(out + ro + c) = x1; acc[ai][bj][m][n] = x1; ss += (x1[0] * x1[0] + x1[1] * x1[1]) + (x1[2] * x1[2] + x1[3] * x1[3]); }
                ss += __shfl_xor(ss, 16); ss += __shfl_xor(ss, 32);
                if (fq == 0) P[(ai * 128 + wr * 64 + m * 16 + fr) * 4 + wc] = ss; }
        asm volatile("s_waitcnt lgkmcnt(0)" ::: "memory"); __builtin_amdgcn_s_barrier(); asm volatile("" ::: "memory");
        if (tidl < 256) { const pg8::f32x4 p4 = *(const LAS pg8::f32x4*)(P + tidl * 4);
            __hip_atomic_store(SSP + (size_t)(u.arow0 + tidl) * 4 + u.pn, (p4[0] + p4[1]) + (p4[2] + p4[3]), __ATOMIC_RELAXED, __HIP_MEMORY_SCOPE_AGENT); }
        asm volatile("s_waitcnt vmcnt(0)" ::: "memory");
        if (wave < 4 && (fr | fq) == 0) (void)__hip_atomic_fetch_add(cnt + pm * 64, 1u, RLX_AGENT);
        { unsigned spins = 0;
          while ((unsigned)__builtin_amdgcn_readfirstlane((int)__hip_atomic_load(cnt + pm * 64, RLX_AGENT)) < 16u) { __builtin_amdgcn_s_sleep(2); if (++spins > (1u << 20)) break; } }
        float rr[2][4];
#pragma unroll
        for (int ai = 0; ai < 2; ++ai)
#pragma unroll
            for (int m = 0; m < 4; ++m) { const float* sp = SSP + (size_t)(row0 + ai * 128 + m * 16) * 4;
                const float s0 = __hip_atomic_load(sp, __ATOMIC_RELAXED, __HIP_MEMORY_SCOPE_AGENT), s1 = __hip_atomic_load(sp + 1, __ATOMIC_RELAXED, __HIP_MEMORY_SCOPE_AGENT);
                const float s2 = __hip_atomic_load(sp + 2, __ATOMIC_RELAXED, __HIP_MEMORY_SCOPE_AGENT), s3 = __hip_atomic_load(sp + 3, __ATOMIC_RELAXED, __HIP_MEMORY_SCOPE_AGENT);
                rr[ai][m] = 1.f / sqrtf(((s0 + s1) + (s2 + s3)) * (1.f / DM) + EPS); }
        const size_t bo = (size_t)(row0 >> 12) * 6144 + col0;
#pragma unroll
        for (int bj = 0; bj < 2; ++bj)
#pragma unroll
            for (int n = 0; n < 2; ++n) { const int c = bj * 128 + n * 16;
                const pg8::f32x4 g4 = *(const pg8::f32x4*)(gain + col0 + c), sh4 = *(const pg8::f32x4*)(shm + bo + c), sc4 = *(const pg8::f32x4*)(scm + bo + c) + 1.f;
#pragma unroll
                for (int ai = 0; ai < 2; ++ai)
#pragma unroll
                    for (int m = 0; m < 4; ++m) { const pg8::f32x4 y = acc[ai][bj][m][n] * rr[ai][m] * g4 * sc4 + sh4;
                        u32x2 w; w.x = pg8::cvt_pk_bf16(y[0], y[1]); w.y = pg8::cvt_pk_bf16(y[2], y[3]);
                        *(u32x2*)(H + (size_t)(row0 + ai * 128 + m * 16) * DM + col0 + c) = w; } }
    }
};
struct EpiF32 {
    static constexpr bool PERM = false;
    float* C; int ldc;
    __device__ __forceinline__ void operator()(pg8::f32x4 (&acc)[2][2][4][2], const pg8::Unit& u, int wr, int wc, int fr, int fq) const {
        const int row0 = u.arow0 + wr * 64 + fr, col0 = u.pn * 256 + wc * 32 + 4 * fq;
#pragma unroll
        for (int ai = 0; ai < 2; ++ai)
#pragma unroll
            for (int m = 0; m < 4; ++m) { float* rowp = C + (size_t)(row0 + ai * 128 + m * 16) * ldc + col0;
#pragma unroll
                for (int bj = 0; bj < 2; ++bj)
#pragma unroll
                    for (int n = 0; n < 2; ++n) *(pg8::f32x4*)(rowp + bj * 128 + n * 16) = acc[ai][bj][m][n]; }
    }
};
struct EpiGateUp {
    static constexpr bool PERM = true;
    bf16* HB;
    __device__ __forceinline__ void operator()(pg8::f32x4 (&acc)[2][2][4][2], const pg8::Unit& u, int wr, int wc, int fr, int fq) const {
        const int col0 = u.pn * 128 + wc * 32 + 8 * fq;
#pragma unroll
        for (int ai = 0; ai < 2; ++ai)
#pragma unroll
            for (int m = 0; m < 4; ++m) { const int rl = ai * 128 + wr * 64 + m * 16 + fr;
                float y[8];
#pragma unroll
                for (int n = 0; n < 2; ++n)
#pragma unroll
                    for (int j = 0; j < 4; ++j) y[4 * n + j] = silu(acc[ai][0][m][n][j]) * acc[ai][1][m][n][j];
                if (rl < u.nvalid) *(v4u*)(HB + (size_t)(u.arow0 + rl) * EFF + col0) = pack8(y); }
    }
};
struct EpiDown {
    static constexpr bool PERM = true;
    unsigned char* Y;
    __device__ __forceinline__ void operator()(pg8::f32x4 (&acc)[2][2][4][2], const pg8::Unit& u, int wr, int wc, int fr, int fq) const {
        const int col0 = u.pn * 256 + wc * 32 + 8 * fq;
#pragma unroll
        for (int ai = 0; ai < 2; ++ai)
#pragma unroll
            for (int m = 0; m < 4; ++m) { const int rl = ai * 128 + wr * 64 + m * 16 + fr; unsigned char* rowp = Y + (size_t)(u.arow0 + rl) * DM + col0;
#pragma unroll
                for (int bj = 0; bj < 2; ++bj) { const pg8::f32x4 v0 = acc[ai][bj][m][0] * 8.f, v1 = acc[ai][bj][m][1] * 8.f;
                    u32x2 w; w.x = 0u; w.y = 0u;
                    w.x = __builtin_amdgcn_cvt_pk_fp8_f32(v0[0], v0[1], w.x, false); w.x = __builtin_amdgcn_cvt_pk_fp8_f32(v0[2], v0[3], w.x, true);
                    w.y = __builtin_amdgcn_cvt_pk_fp8_f32(v1[0], v1[1], w.y, false); w.y = __builtin_amdgcn_cvt_pk_fp8_f32(v1[2], v1[3], w.y, true);
                    if (rl < u.nvalid) *(u32x2*)(rowp + bj * 128) = w; } }
    }
};

__device__ __forceinline__ void moe_tables(const unsigned* cntg, LAS int* tb, int tid) {
    LAS int* cnt = tb; LAS int* start = tb + 130; LAS int* tpre = tb + 260;
    __syncthreads();
    if (tid < 64) {
        const int c0 = (int)__hip_atomic_load(cntg + 2 * tid, __ATOMIC_RELAXED, __HIP_MEMORY_SCOPE_AGENT), c1 = (int)__hip_atomic_load(cntg + 2 * tid + 1, __ATOMIC_RELAXED, __HIP_MEMORY_SCOPE_AGENT);
        const int t0 = (c0 + 255) >> 8, t1 = (c1 + 255) >> 8;
        int sc = c0 + c1, st = t0 + t1;
#pragma unroll
        for (int o = 1; o < 64; o <<= 1) { const int a = __shfl_up(sc, o), b2 = __shfl_up(st, o); if (tid >= o) { sc += a; st += b2; } }
        const int es = sc - c0 - c1, et = st - t0 - t1;
        cnt[2 * tid] = c0; cnt[2 * tid + 1] = c1; start[2 * tid] = es; start[2 * tid + 1] = es + c0; tpre[2 * tid] = et; tpre[2 * tid + 1] = et + t0;
        if (tid == 63) { cnt[NEXP] = NTOK; start[NEXP] = NSLOT; tpre[NEXP] = st; start[NEXP + 1] = NSLOT_ALL; tpre[NEXP + 1] = st + NTOK / 256; }
    }
    __syncthreads();
}
struct GroupOrder {
    const LAS int* cnt; const LAS int* start; const LAS int* tpre; const int* list; int ntc, total, G, c;
    __device__ __forceinline__ void init(const LAS int* tb, const int* list_, int ntc_, int G_, int c_) { cnt = tb; start = tb + 130; tpre = tb + 260; list = list_; ntc = ntc_; total = tpre[NEXP + 1] * ntc_; G = G_; c = c_; }
    __device__ __forceinline__ bool next(int i, pg8::Unit& u) const {
        const int L = i * G + c; if (L >= total) return false;
        const int rt = L / ntc, pn = L - rt * ntc;
        int lo = 0, hi = NEXP + 1;
#pragma unroll 1
        while (hi - lo > 1) { const int mid = (lo + hi) >> 1; if (tpre[mid] <= rt) lo = mid; else hi = mid; }
        const int j = rt - tpre[lo], rem = cnt[lo] - 256 * j;
        u.pn = pn; u.arow0 = start[lo] + 256 * j; u.nvalid = rem < 256 ? rem : 256; u.bt = lo * ntc + pn; return true;
    }
    __device__ __forceinline__ int arow(const pg8::Unit& u, int r) const { const int idx = u.arow0 + (r < u.nvalid ? r : u.nvalid - 1); return list ? list[idx] : idx; }
};

template <int CTRL> __device__ __forceinline__ float dppf(float v) { return __builtin_bit_cast(float, __builtin_amdgcn_update_dpp(0, __builtin_bit_cast(int, v), CTRL, 0xf, 0xf, false)); }
template <int CTRL> __device__ __forceinline__ int dppi(int v) { return __builtin_amdgcn_update_dpp(0, v, CTRL, 0xf, 0xf, false); }
#define TK_ROR(n) (0x120 + (n))
__device__ __forceinline__ void topk_phase(const float* LOG, const float* rbias, int* TOPI, float* TOPW, int* RANK, unsigned* cntg, LAS unsigned char* lds, int bx, int G, int wave, int tid) {
    const int lane = tid & 63, q = lane & 15, row = lane >> 4, g = q >> 1;
    LAS unsigned* hist = (LAS unsigned*)lds; LAS unsigned* base = hist + 128; LAS unsigned short* le = (LAS unsigned short*)(lds + 1024); LAS unsigned short* lr = le + 1024;
    float bias[8]; { const f32x4 b0 = *(const f32x4*)(rbias + 8 * q), b1 = *(const f32x4*)(rbias + 8 * q + 4); bias[0] = b0.x; bias[1] = b0.y; bias[2] = b0.z; bias[3] = b0.w; bias[4] = b1.x; bias[5] = b1.y; bias[6] = b1.z; bias[7] = b1.w; }
    for (int blk = bx; blk < NTOK / 128; blk += G) {
        __syncthreads();
        if (tid < 128) hist[tid] = 0u;
        __syncthreads();
#pragma unroll 1
        for (int bt = 0; bt < 4; ++bt) {
            const int tl = wave * 16 + bt * 4 + row, tok = blk * 128 + tl;
            float sc[8], v[8];
            { const f32x4 l0 = *(const f32x4*)(LOG + (size_t)tok * 256 + 8 * q), l1 = *(const f32x4*)(LOG + (size_t)tok * 256 + 8 * q + 4);
              sc[0] = sigm_div(l0.x); sc[1] = sigm_div(l0.y); sc[2] = sigm_div(l0.z); sc[3] = sigm_div(l0.w); sc[4] = sigm_div(l1.x); sc[5] = sigm_div(l1.y); sc[6] = sigm_div(l1.z); sc[7] = sigm_div(l1.w); }
            float m1 = -INFINITY, m2 = -INFINITY;
#pragma unroll
            for (int j = 0; j < 8; ++j) { v[j] = sc[j] + bias[j]; const float lo = fminf(m1, v[j]); m1 = fmaxf(m1, v[j]); m2 = fmaxf(m2, lo); }
            { const float o1 = dppf<0xB1>(m1), o2 = dppf<0xB1>(m2); const float n1 = fmaxf(m1, o1), n2 = fmaxf(fminf(m1, o1), fmaxf(m2, o2)); m1 = n1; m2 = n2; }
            const float gs = m1 + m2; int better = 0;
#define TK_RANK(n) { const float og = dppf<TK_ROR(n)>(gs); const int oi = dppi<TK_ROR(n)>(g); better += (og > gs || (og == gs && oi < g)) ? 1 : 0; }
            TK_RANK(2) TK_RANK(4) TK_RANK(6) TK_RANK(8) TK_RANK(10) TK_RANK(12) TK_RANK(14)
#undef TK_RANK
            if (better >= 4) {
#pragma unroll
                for (int j = 0; j < 8; ++j) v[j] = -INFINITY; }
            int my_e = 0; float my_s = 0.f, ssum = 0.f;
#pragma unroll
            for (int k = 0; k < 8; ++k) {
                float bv = v[0], bs = sc[0]; int bi = 8 * q;
#pragma unroll
                for (int j = 1; j < 8; ++j) { const bool t = v[j] > bv; bv = t ? v[j] : bv; bs = t ? sc[j] : bs; bi = t ? 8 * q + j : bi; }
#define TK_STEP(n) { const float ov = dppf<TK_ROR(n)>(bv), os = dppf<TK_ROR(n)>(bs); const int oi = dppi<TK_ROR(n)>(bi); const bool t = (ov > bv) || (ov == bv && oi < bi); bv = t ? ov : bv; bs = t ? os : bs; bi = t ? oi : bi; }
                TK_STEP(1) TK_STEP(2) TK_STEP(4) TK_STEP(8)
#undef TK_STEP
#pragma unroll
                for (int j = 0; j < 8; ++j) v[j] = (bi == 8 * q + j) ? -INFINITY : v[j];
                if (q == k) { my_e = bi; my_s = bs; }
                ssum += bs;
            }
            if (q < 8) {
                const unsigned rk = __hip_atomic_fetch_add(hist + my_e, 1u, __ATOMIC_RELAXED, __HIP_MEMORY_SCOPE_WORKGROUP);
                TOPI[tok * 8 + q] = my_e; TOPW[tok * 8 + q] = my_s / ssum * 2.5f; le[tl * 8 + q] = (unsigned short)my_e; lr[tl * 8 + q] = (unsigned short)rk;
            }
        }
        __syncthreads();
        if (tid < 128) base[tid] = __hip_atomic_fetch_add(cntg + tid, hist[tid], __ATOMIC_RELAXED, __HIP_MEMORY_SCOPE_AGENT);
        __syncthreads();
        for (int i = tid; i < 1024; i += 512) RANK[blk * 1024 + i] = (int)(base[le[i]] + lr[i]);
    }
}
__device__ __forceinline__ void list_phase(const int* TOPI, const int* RANK, int* SLOT, int* LIST, const LAS int* tb, int gtid, int NGT) {
    const LAS int* start = tb + 130;
    for (int p = gtid; p < NSLOT; p += NGT) { const int s = start[TOPI[p]] + RANK[p]; SLOT[p] = s; LIST[s] = p >> 3; }
    for (int i = gtid; i < NTOK; i += NGT) LIST[NSLOT + i] = i;
}
__device__ __forceinline__ void combine_phase(float* X, const unsigned char* Y, const int* SLOT, const float* TOPW, const float* modl, int g_off,
                                              const float* ngain, const float* modn, int sh_off, int sc_off, bf16* H, const float* fgain, int gw, int NGW, int lane) {
    constexpr int NTF = 4;
    for (int m0 = gw; m0 < NTOK; m0 += NTF * NGW) {
        int sl[NTF]; float wl[NTF];
#pragma unroll
        for (int q = 0; q < NTF; ++q) { const int mq = m0 + q * NGW; const int m = mq < NTOK ? mq : m0; sl[q] = (lane < 8) ? SLOT[m * 8 + lane] : NSLOT + m; wl[q] = (lane < 8) ? TOPW[m * 8 + lane] : 1.f; }
        f32x4 acc[NTF][4];
#pragma unroll
        for (int q = 0; q < NTF; ++q)
#pragma unroll
            for (int j = 0; j < 4; ++j) acc[q][j] = (f32x4){0.f, 0.f, 0.f, 0.f};
#pragma unroll
        for (int k = 0; k < 9; ++k)
#pragma unroll
            for (int q = 0; q < NTF; ++q) { const int s = __shfl(sl[q], k); const float w = __shfl(wl[q], k) * 0.125f;
                const unsigned* yr = (const unsigned*)(Y + (size_t)s * DM) + lane;
#pragma unroll
                for (int j = 0; j < 4; ++j) { const unsigned qv = yr[64 * j]; const f32x2 lo = __builtin_amdgcn_cvt_pk_f32_fp8(qv, false), hi = __builtin_amdgcn_cvt_pk_f32_fp8(qv, true);
                    acc[q][j] += (f32x4){lo.x, lo.y, hi.x, hi.y} * w; } }
#pragma unroll
        for (int q = 0; q < NTF; ++q) { const int m = m0 + q * NGW; if (m >= NTOK) break;
            f32x4* xr = (f32x4*)(X + (size_t)m * DM) + lane; const float* mb = modl + (size_t)(m >> 12) * 6144; f32x4 v[4];
#pragma unroll
            for (int j = 0; j < 4; ++j) v[j] = xr[64 * j] + ((const f32x4*)(mb + g_off))[lane + 64 * j] * acc[q][j];
            if (fgain) finalnorm_row(v, fgain, X + (size_t)m * DM, lane);
            else {
#pragma unroll
                for (int j = 0; j < 4; ++j) xr[64 * j] = v[j];
                const float* mn = modn + (size_t)(m >> 12) * 6144;
                normmod_row(v, ngain, mn + sh_off, mn + sc_off, H + (size_t)m * DM, lane);
            } }
    }
}
__device__ __forceinline__ int q_pull(gu32* head, volatile LAS unsigned* slot, int tid) {
    __syncthreads();
    if (tid == 0) *slot = __hip_atomic_fetch_add(head, 1u, RLX_AGENT);
    __syncthreads();
    return (int)*slot;
}

__device__ __forceinline__ void convqk_phase(const bf16* P, const float* cw, const float* cb, bf16* QKC, int gtid, int NGT) {
    for (int idx = gtid; idx < NTOK * 128; idx += NGT) {
        const int tok = idx >> 7, c0 = (idx & 127) * 8, t = tok & (NT_ - 1);
        float acc[8];
#pragma unroll
        for (int i = 0; i < 8; ++i) acc[i] = cb[c0 + i];
#pragma unroll
        for (int j = 0; j < 5; ++j) { const int tj = t + j - 2;
            if (tj >= 0 && tj < NT_) { float x[8]; unpack8(*(const v4u*)(P + (size_t)(tok + j - 2) * P1W + c0), x);
#pragma unroll
                for (int i = 0; i < 8; ++i) acc[i] += cw[j * 1024 + c0 + i] * x[i]; } }
        const float sc = (c0 >= GW) ? 0.08838834764831845f : 1.f;
#pragma unroll
        for (int i = 0; i < 8; ++i) acc[i] = silu(acc[i]) * sc;
        *(v4u*)(QKC + (size_t)tok * DM + c0) = pack8(acc);
    }
}
namespace da {
using bf16x8 = __attribute__((ext_vector_type(8))) short;
using s16x4  = __attribute__((ext_vector_type(4))) short;
using f32x16 = __attribute__((ext_vector_type(16))) float;
constexpr float SCALE = 0.125f;
constexpr float THR = 8.f;
constexpr int KVBLK = 64, SHM_V = 16384, SHM_K = 16384;
#define DA_KSWZ(row, colB) ((row) * 256 + ((colB) ^ (((row) & 7) << 4)))
#define DA_SBAR() __builtin_amdgcn_sched_barrier(0)
#define DA_LBAR() do { asm volatile("s_waitcnt lgkmcnt(0)" ::: "memory"); __builtin_amdgcn_s_barrier(); asm volatile("" ::: "memory"); } while (0)
__device__ __forceinline__ int crow(int r, int hi) { return (r & 3) + 8 * (r >> 2) + 4 * hi; }
__device__ __forceinline__ unsigned cvtpk(float lo, float hi) { unsigned r; asm volatile("v_cvt_pk_bf16_f32 %0, %1, %2" : "=v"(r) : "v"(lo), "v"(hi)); return r; }
__device__ __forceinline__ void partialSM(f32x16& p0, f32x16& p1, float& m_reg, float& mn, float& alpha) {
  constexpr float C = SCALE * 1.4426950408889634f;
  float pmax = p0[0];
#pragma unroll
  for (int r = 1; r < 16; ++r) pmax = fmaxf(pmax, p0[r]);
#pragma unroll
  for (int r = 0; r < 16; ++r) pmax = fmaxf(pmax, p1[r]);
  { auto rr = __builtin_amdgcn_permlane32_swap(__float_as_uint(pmax), __float_as_uint(pmax), false, false);
    pmax = fmaxf(__uint_as_float(rr[0]), __uint_as_float(rr[1])); }
  if (__builtin_expect(__all(pmax - m_reg <= THR / SCALE), 1)) { mn = m_reg; alpha = 1.f; }
  else { mn = fmaxf(m_reg, pmax); alpha = __builtin_amdgcn_exp2f((m_reg - mn) * C); m_reg = mn; }
  float mnC = -mn * C;
#pragma unroll
  for (int r = 0; r < 16; ++r) p0[r] = fmaf(p0[r], C, mnC);
#pragma unroll
  for (int r = 0; r < 16; ++r) p1[r] = fmaf(p1[r], C, mnC);
#pragma unroll
  for (int r = 0; r < 16; ++r) p0[r] = __builtin_amdgcn_exp2f(p0[r]);
}
__device__ __forceinline__ void finishSM(f32x16& p0, f32x16& p1, float alpha, float& l_reg, bf16x8& pa0, bf16x8& pa1, bf16x8& pa2, bf16x8& pa3) {
#pragma unroll
  for (int r = 0; r < 16; ++r) p1[r] = __builtin_amdgcn_exp2f(p1[r]);
  float ps = 0;
#pragma unroll
  for (int r = 0; r < 16; ++r) ps += p0[r];
#pragma unroll
  for (int r = 0; r < 16; ++r) ps += p1[r];
  { auto rr = __builtin_amdgcn_permlane32_swap(__float_as_uint(ps), __float_as_uint(ps), false, false);
    ps = __uint_as_float(rr[0]) + __uint_as_float(rr[1]); }
  l_reg = l_reg * alpha + ps;
#define DA_PK4(P, BASE, OUT) do { unsigned a0 = cvtpk(P[BASE + 0], P[BASE + 1]), a1 = cvtpk(P[BASE + 2], P[BASE + 3]);   \
    unsigned b0 = cvtpk(P[BASE + 4], P[BASE + 5]), b1 = cvtpk(P[BASE + 6], P[BASE + 7]);                              \
    auto r0 = __builtin_amdgcn_permlane32_swap(a0, b0, false, false); auto r1 = __builtin_amdgcn_permlane32_swap(a1, b1, false, false); \
    v4u w = {r0[0], r1[0], r0[1], r1[1]}; OUT = __builtin_bit_cast(bf16x8, w); } while (0)
  DA_PK4(p0, 0, pa0); DA_PK4(p0, 8, pa1); DA_PK4(p1, 0, pa2); DA_PK4(p1, 8, pa3);
#undef DA_PK4
}
__device__ __forceinline__ void qkt(f32x16& p0, f32x16& p1, const LAS char* Ks, const bf16x8 (&qr)[4], int r32, int hi, int mapB) {
  p0 = f32x16{}; p1 = f32x16{};
#pragma unroll
  for (int d0 = 0; d0 < 4; ++d0) { const int cb = mapB + (d0 * 16 + hi * 8) * 2;
    const bf16x8 b0 = *(const LAS bf16x8*)(Ks + DA_KSWZ(r32, cb));
    const bf16x8 b1 = *(const LAS bf16x8*)(Ks + DA_KSWZ(32 + r32, cb));
    p0 = __builtin_amdgcn_mfma_f32_32x32x16_bf16(b0, qr[d0], p0, 0, 0, 0);
    p1 = __builtin_amdgcn_mfma_f32_32x32x16_bf16(b1, qr[d0], p1, 0, 0, 0); }
}
__device__ __forceinline__ int v_st(int k, int c) { const int kk = (k & ~0xC) | ((k & 4) << 1) | ((k & 8) >> 1); return ((kk >> 3) * 4 + (c >> 5)) * 512 + ((kk & 7) * 32 + (c & 31)) * 2; }
__device__ __forceinline__ int v_rd_base(int lane) { return ((lane & 3) << 3) | (((lane >> 2) & 3) << 6) | (((lane >> 4) & 1) << 5) | (((lane >> 5) & 1) << 8); }
constexpr int v_rd_off(int d0, int ks, int half) { return d0 * 512 + ks * 4096 + half * 2048; }
template <int OFF> __device__ __forceinline__ s16x4 tr_read(int vb) {
  s16x4 r; asm volatile("ds_read_b64_tr_b16 %0, %1 offset:%2" : "=&v"(r) : "v"(vb), "i"(OFF) : "memory"); return r;
}
template <int D0> __device__ __forceinline__ void pv_one(f32x16& od, int vb, bf16x8 pa0, bf16x8 pa1, bf16x8 pa2, bf16x8 pa3) {
  const s16x4 l0 = tr_read<v_rd_off(D0, 0, 0)>(vb), h0 = tr_read<v_rd_off(D0, 0, 1)>(vb), l1 = tr_read<v_rd_off(D0, 1, 0)>(vb), h1 = tr_read<v_rd_off(D0, 1, 1)>(vb);
  const s16x4 l2 = tr_read<v_rd_off(D0, 2, 0)>(vb), h2 = tr_read<v_rd_off(D0, 2, 1)>(vb), l3 = tr_read<v_rd_off(D0, 3, 0)>(vb), h3 = tr_read<v_rd_off(D0, 3, 1)>(vb);
  asm volatile("s_waitcnt lgkmcnt(0)" ::: "memory"); DA_SBAR();
#define DA_PK(L, H) (bf16x8){L[0], L[1], L[2], L[3], H[0], H[1], H[2], H[3]}
  od = __builtin_amdgcn_mfma_f32_32x32x16_bf16(pa0, DA_PK(l0, h0), od, 0, 0, 0);
  od = __builtin_amdgcn_mfma_f32_32x32x16_bf16(pa1, DA_PK(l1, h1), od, 0, 0, 0);
  od = __builtin_amdgcn_mfma_f32_32x32x16_bf16(pa2, DA_PK(l2, h2), od, 0, 0, 0);
  od = __builtin_amdgcn_mfma_f32_32x32x16_bf16(pa3, DA_PK(l3, h3), od, 0, 0, 0);
#undef DA_PK
}
__device__ __forceinline__ void pv_d0(f32x16 (&o)[4], int vb, bf16x8 pa0, bf16x8 pa1, bf16x8 pa2, bf16x8 pa3) {
  pv_one<0>(o[0], vb, pa0, pa1, pa2, pa3); pv_one<1>(o[1], vb, pa0, pa1, pa2, pa3); pv_one<2>(o[2], vb, pa0, pa1, pa2, pa3); pv_one<3>(o[3], vb, pa0, pa1, pa2, pa3);
}
__device__ __forceinline__ void unit(int u, const bf16* P, float lam, const float* subln, bf16* CAT, LAS char* lds, int tid) {
  const int qb = u & 31, h = (u >> 5) & 3, b = u >> 7;
  const int wid = tid >> 6, lane = tid & 63, r32 = lane & 31, hi = lane >> 5, mp = wid >> 2, wq = wid & 3;
  LAS char* V_lds = lds; LAS char* K_lds = lds + 2 * SHM_V;
  LAS float* ws = (LAS float*)(lds + 2 * SHM_V + 2 * SHM_K) + wid * 64; LAS float* li_l = ws; LAS float* al_l = ws + 32;
  float m_reg = -1e30f, l_reg = 0; f32x16 o[4] = {}; bf16x8 qr[4];
  const size_t rowbase = (size_t)b * NT_;
  const bf16* Qw = P + (rowbase + qb * 128 + wq * 32 + r32) * P0W + 2560 + h * 128 + mp * 64 + hi * 8;
#pragma unroll
  for (int d0 = 0; d0 < 4; ++d0) qr[d0] = *(const bf16x8*)(Qw + d0 * 16);
  const bf16* Kh = P + rowbase * P0W + 3072 + h * 128; const bf16* Vh = P + rowbase * P0W + 3584 + h * 128;
  const int mapB = mp * 128;
  const int sr = tid >> 4, sc = (tid & 15) * 8, vst0 = v_st(sr, sc), vst1 = v_st(32 + sr, sc);
  const int vb0 = (int)(uintptr_t)V_lds + v_rd_base(lane);
  struct { bf16x8 vs0, vs1, ks0, ks1; } sr_[2];
#define DA_SLOAD(i, k0) do { sr_[i].vs0 = *(const bf16x8*)(&Vh[(size_t)((k0) + sr) * P0W + sc]); sr_[i].vs1 = *(const bf16x8*)(&Vh[(size_t)((k0) + 32 + sr) * P0W + sc]); \
    sr_[i].ks0 = *(const bf16x8*)(&Kh[(size_t)((k0) + sr) * P0W + sc]); sr_[i].ks1 = *(const bf16x8*)(&Kh[(size_t)((k0) + 32 + sr) * P0W + sc]); } while (0)
#define DA_SWRITE(bb, i) do { *(LAS bf16x8*)(V_lds + (bb) * SHM_V + vst0) = sr_[i].vs0;          \
    *(LAS bf16x8*)(V_lds + (bb) * SHM_V + vst1) = sr_[i].vs1; const int kc = sc * 2;               \
    *(LAS bf16x8*)(K_lds + (bb) * SHM_K + DA_KSWZ(sr, kc)) = sr_[i].ks0;                       \
    *(LAS bf16x8*)(K_lds + (bb) * SHM_K + DA_KSWZ(32 + sr, kc)) = sr_[i].ks1; } while (0)
#define DA_SWAIT() asm volatile("s_waitcnt vmcnt(4)" ::: "memory")
#define DA_RESC(a) do { if (__any((a) < 1.f)) { if (hi == 0) al_l[r32] = (a); asm volatile("s_waitcnt lgkmcnt(0)" ::: "memory"); \
    _Pragma("unroll") for (int d = 0; d < 4; ++d) _Pragma("unroll") for (int r = 0; r < 16; ++r) o[d][r] *= al_l[crow(r, hi)]; } } while (0)
  f32x16 pA0, pA1, pB0, pB1; float mnA, mnB, alA, alB; bf16x8 pa0, pa1, pa2, pa3; constexpr int NT = NT_ / KVBLK;
  DA_SLOAD(0, 0); asm volatile("s_waitcnt vmcnt(0)" ::: "memory"); DA_SWRITE(0, 0); DA_LBAR();
  qkt(pA0, pA1, K_lds, qr, r32, hi, mapB); partialSM(pA0, pA1, m_reg, mnA, alA);
  DA_SLOAD(1, KVBLK); DA_SLOAD(0, 2 * KVBLK);
  DA_SWAIT(); DA_SWRITE(1, 1); DA_LBAR();
  for (int j = 1; j + 1 < NT; j += 2) {
    DA_SBAR(); qkt(pB0, pB1, K_lds + SHM_K, qr, r32, hi, mapB);
    finishSM(pA0, pA1, alA, l_reg, pa0, pa1, pa2, pa3); DA_SBAR();
    DA_SLOAD(1, (j + 2) * KVBLK); DA_SBAR();
    pv_d0(o, vb0, pa0, pa1, pa2, pa3); partialSM(pB0, pB1, m_reg, mnB, alB);
    DA_LBAR(); DA_SWAIT(); DA_SWRITE(0, 0);
    DA_RESC(alB); DA_LBAR();
    DA_SBAR(); qkt(pA0, pA1, K_lds, qr, r32, hi, mapB);
    finishSM(pB0, pB1, alB, l_reg, pa0, pa1, pa2, pa3); DA_SBAR();
    if (j + 3 < NT) DA_SLOAD(0, (j + 3) * KVBLK); DA_SBAR();
    pv_d0(o, vb0 + SHM_V, pa0, pa1, pa2, pa3); partialSM(pA0, pA1, m_reg, mnA, alA);
    DA_LBAR(); DA_SWAIT(); DA_SWRITE(1, 1);
    DA_RESC(alA); DA_LBAR();
  }
  DA_SBAR(); qkt(pB0, pB1, K_lds + SHM_K, qr, r32, hi, mapB);
  finishSM(pA0, pA1, alA, l_reg, pa0, pa1, pa2, pa3); DA_SBAR();
  pv_d0(o, vb0, pa0, pa1, pa2, pa3); partialSM(pB0, pB1, m_reg, mnB, alB);
  DA_LBAR(); DA_RESC(alB);
  finishSM(pB0, pB1, alB, l_reg, pa0, pa1, pa2, pa3); DA_SBAR();
  pv_d0(o, vb0 + SHM_V, pa0, pa1, pa2, pa3);
  if (hi == 0) li_l[r32] = l_reg; asm volatile("s_waitcnt lgkmcnt(0)" ::: "memory");
  float rli[16];
#pragma unroll
  for (int r = 0; r < 16; ++r) rli[r] = __builtin_amdgcn_rcpf(li_l[crow(r, hi)]);
  DA_LBAR();
  LAS float* X = (LAS float*)lds;
  if (mp == 1) {
#pragma unroll
    for (int d0 = 0; d0 < 4; ++d0)
#pragma unroll
      for (int r = 0; r < 16; ++r) X[(wq * 32 + crow(r, hi)) * 128 + d0 * 32 + r32] = o[d0][r] * rli[r];
  }
  DA_LBAR();
  if (mp == 0) {
#pragma unroll
    for (int d0 = 0; d0 < 4; ++d0)
#pragma unroll
      for (int r = 0; r < 16; ++r) { const int ix = (wq * 32 + crow(r, hi)) * 128 + d0 * 32 + r32; X[ix] = o[d0][r] * rli[r] - lam * X[ix]; }
  }
  DA_LBAR();
  { const int row = tid >> 2, qtr = tid & 3; const LAS f32x4* xp = (const LAS f32x4*)(X + row * 128 + qtr * 32); f32x4 xv[8]; float ss = 0.f;
#pragma unroll
    for (int i = 0; i < 8; ++i) { xv[i] = xp[i]; ss += (xv[i].x * xv[i].x + xv[i].y * xv[i].y) + (xv[i].z * xv[i].z + xv[i].w * xv[i].w); }
    ss += __shfl_xor(ss, 1); ss += __shfl_xor(ss, 2);
    const float rr = 0.8f / sqrtf(ss * (1.f / 128.f) + EPS);
    bf16* op = CAT + (rowbase + qb * 128 + row) * DM + GW + h * 128 + qtr * 32;
#pragma unroll
    for (int i = 0; i < 4; ++i) { const f32x4 g0 = *(const f32x4*)(subln + qtr * 32 + i * 8), g1 = *(const f32x4*)(subln + qtr * 32 + i * 8 + 4);
      const f32x4 y0 = xv[2 * i] * rr * g0, y1 = xv[2 * i + 1] * rr * g1;
      v4u w; w.x = pk2(y0.x, y0.y); w.y = pk2(y0.z, y0.w); w.z = pk2(y1.x, y1.y); w.w = pk2(y1.z, y1.w);
      *(v4u*)(op + i * 8) = w; } }
  DA_LBAR();
#undef DA_SLOAD
#undef DA_SWRITE
#undef DA_SWAIT
#undef DA_RESC
}
}
namespace na {
using da::bf16x8; using da::s16x4; using da::f32x16;
__device__ __forceinline__ int v_st2(int k, int c) { const int kk = (k & ~0xC) | ((k & 4) << 1) | ((k & 8) >> 1); return ((kk >> 3) * 2 + (c >> 5)) * 512 + ((kk & 7) * 32 + (c & 31)) * 2; }
constexpr int v_rd_off2(int d0, int ks, int half) { return d0 * 512 + ks * 2048 + half * 1024; }
template <int D0> __device__ __forceinline__ void pv_one2(f32x16& od, int vb, bf16x8 pa0, bf16x8 pa1, bf16x8 pa2, bf16x8 pa3) {
  const s16x4 l0 = da::tr_read<v_rd_off2(D0, 0, 0)>(vb), h0 = da::tr_read<v_rd_off2(D0, 0, 1)>(vb), l1 = da::tr_read<v_rd_off2(D0, 1, 0)>(vb), h1 = da::tr_read<v_rd_off2(D0, 1, 1)>(vb);
  const s16x4 l2 = da::tr_read<v_rd_off2(D0, 2, 0)>(vb), h2 = da::tr_read<v_rd_off2(D0, 2, 1)>(vb), l3 = da::tr_read<v_rd_off2(D0, 3, 0)>(vb), h3 = da::tr_read<v_rd_off2(D0, 3, 1)>(vb);
  asm volatile("s_waitcnt lgkmcnt(0)" ::: "memory"); DA_SBAR();
#define NA_PK(L, H) (bf16x8){L[0], L[1], L[2], L[3], H[0], H[1], H[2], H[3]}
  od = __builtin_amdgcn_mfma_f32_32x32x16_bf16(pa0, NA_PK(l0, h0), od, 0, 0, 0);
  od = __builtin_amdgcn_mfma_f32_32x32x16_bf16(pa1, NA_PK(l1, h1), od, 0, 0, 0);
  od = __builtin_amdgcn_mfma_f32_32x32x16_bf16(pa2, NA_PK(l2, h2), od, 0, 0, 0);
  od = __builtin_amdgcn_mfma_f32_32x32x16_bf16(pa3, NA_PK(l3, h3), od, 0, 0, 0);
#undef NA_PK
}
__device__ __forceinline__ void qtile(const bf16x8 (&kf)[2][4], const bf16x8 (&qr)[4], int col, const LAS float* brow, float& m_reg, float& l_reg, f32x16& o0, f32x16& o1,
                                      LAS float* al_l, int vb, int r32, int hi) {
  constexpr float C = 0.125f * 1.4426950408889634f, L2E = 1.4426950408889634f;
  f32x16 p0 = {}, p1 = {};
#pragma unroll
  for (int d0 = 0; d0 < 4; ++d0) { p0 = __builtin_amdgcn_mfma_f32_32x32x16_bf16(kf[0][d0], qr[d0], p0, 0, 0, 0); p1 = __builtin_amdgcn_mfma_f32_32x32x16_bf16(kf[1][d0], qr[d0], p1, 0, 0, 0); }
  int cs = col - 8; cs = cs < 0 ? 0 : (cs > 48 ? 48 : cs);
  float pmax = -INFINITY;
  const LAS float* ab = brow + (15 - col + 4 * hi); const int kofs = 4 * hi - cs;
#pragma unroll
  for (int r = 0; r < 16; ++r) { const int kr = (r & 3) + 8 * (r >> 2);
      const float s = fmaf(p0[r], C, ab[kr] * L2E); p0[r] = ((unsigned)(kr + kofs) < 16u) ? s : -INFINITY; pmax = fmaxf(pmax, p0[r]); }
#pragma unroll
  for (int r = 0; r < 16; ++r) { const int kr = 32 + (r & 3) + 8 * (r >> 2);
      const float s = fmaf(p1[r], C, ab[kr] * L2E); p1[r] = ((unsigned)(kr + kofs) < 16u) ? s : -INFINITY; pmax = fmaxf(pmax, p1[r]); }
  { auto rr = __builtin_amdgcn_permlane32_swap(__float_as_uint(pmax), __float_as_uint(pmax), false, false); pmax = fmaxf(__uint_as_float(rr[0]), __uint_as_float(rr[1])); }
  const float mn = fmaxf(m_reg, pmax), alpha = __builtin_amdgcn_exp2f(m_reg - mn); m_reg = mn;
  float ps = 0.f;
#pragma unroll
  for (int r = 0; r < 16; ++r) { p0[r] = __builtin_amdgcn_exp2f(p0[r] - mn); ps += p0[r]; }
#pragma unroll
  for (int r = 0; r < 16; ++r) { p1[r] = __builtin_amdgcn_exp2f(p1[r] - mn); ps += p1[r]; }
  { auto rr = __builtin_amdgcn_permlane32_swap(__float_as_uint(ps), __float_as_uint(ps), false, false); ps = __uint_as_float(rr[0]) + __uint_as_float(rr[1]); }
  l_reg = l_reg * alpha + ps;
  if (hi == 0) al_l[r32] = alpha; asm volatile("s_waitcnt lgkmcnt(0)" ::: "memory");
#pragma unroll
  for (int r = 0; r < 16; ++r) { const float a = al_l[da::crow(r, hi)]; o0[r] *= a; o1[r] *= a; }
  bf16x8 pa0, pa1, pa2, pa3;
#define NA_PK4(Pv, BASE, OUT) do { unsigned a0 = da::cvtpk(Pv[BASE + 0], Pv[BASE + 1]), a1 = da::cvtpk(Pv[BASE + 2], Pv[BASE + 3]);   \
    unsigned b0 = da::cvtpk(Pv[BASE + 4], Pv[BASE + 5]), b1 = da::cvtpk(Pv[BASE + 6], Pv[BASE + 7]);                              \
    auto r0 = __builtin_amdgcn_permlane32_swap(a0, b0, false, false); auto r1 = __builtin_amdgcn_permlane32_swap(a1, b1, false, false); \
    v4u w = {r0[0], r1[0], r0[1], r1[1]}; OUT = __builtin_bit_cast(bf16x8, w); } while (0)
  NA_PK4(p0, 0, pa0); NA_PK4(p0, 8, pa1); NA_PK4(p1, 0, pa2); NA_PK4(p1, 8, pa3);
#undef NA_PK4
  pv_one2<0>(o0, vb, pa0, pa1, pa2, pa3); pv_one2<1>(o1, vb, pa0, pa1, pa2, pa3);
}
__device__ __forceinline__ void item(int it, const bf16* P, const LAS float* BT, bf16* CAT, LAS char* vl, int lane) {
  const int head = it & 7, r = (it >> 3) & 63, b = it >> 9, r32 = lane & 31, hi = lane >> 5;
  const int tok0 = b * NT_ + r * 64; int rs = r - 4; rs = rs < 0 ? 0 : (rs > 56 ? 56 : rs);
  LAS float* li_l = (LAS float*)(vl + 8192); LAS float* al_l = li_l + 32;
  const int vb = (int)(uintptr_t)vl + da::v_rd_base(lane);
  bf16x8 q0[4], q1[4];
  { const bf16* qp = P + (size_t)(tok0 + r32) * P1W + 2048 + head * 64 + hi * 8;
#pragma unroll
    for (int d0 = 0; d0 < 4; ++d0) { q0[d0] = *(const bf16x8*)(qp + d0 * 16); q1[d0] = *(const bf16x8*)(qp + (size_t)32 * P1W + d0 * 16); } }
  f32x16 o00 = {}, o01 = {}, o10 = {}, o11 = {}; float m0 = -1e30f, m1 = -1e30f, l0 = 0.f, l1 = 0.f;
#pragma unroll 1
  for (int i = 0; i < 8; ++i) {
    const int krow0 = b * NT_ + (rs + i) * 64;
    bf16x8 kf[2][4], vv[8];
    { const bf16* kp = P + (size_t)(krow0 + r32) * P1W + 2560 + head * 64 + hi * 8;
#pragma unroll
      for (int d0 = 0; d0 < 4; ++d0) { kf[0][d0] = *(const bf16x8*)(kp + d0 * 16); kf[1][d0] = *(const bf16x8*)(kp + (size_t)32 * P1W + d0 * 16); }
      const bf16* vp = P + (size_t)(krow0 + lane) * P1W + 3072 + head * 64;
#pragma unroll
      for (int c8 = 0; c8 < 8; ++c8) vv[c8] = *(const bf16x8*)(vp + c8 * 8); }
#pragma unroll
    for (int c8 = 0; c8 < 8; ++c8) *(LAS bf16x8*)(vl + v_st2(lane, c8 * 8)) = vv[c8];
    asm volatile("s_waitcnt lgkmcnt(0)" ::: "memory");
    const LAS float* brow = BT + head * 465 + (rs + i - r + 7) * 31;
    int r32i = r32; asm volatile("" : "+v"(r32i));
    qtile(kf, q0, r32i, brow, m0, l0, o00, o01, al_l, vb, r32, hi);
    qtile(kf, q1, 32 + r32i, brow, m1, l1, o10, o11, al_l, vb, r32, hi);
  }
  bf16* op = CAT + (size_t)tok0 * DM + GW + head * 64 + r32;
  if (hi == 0) li_l[r32] = l0; asm volatile("s_waitcnt lgkmcnt(0)" ::: "memory");
#pragma unroll
  for (int rr = 0; rr < 16; ++rr) { const int qrow = da::crow(rr, hi); const float il = __builtin_amdgcn_rcpf(li_l[qrow]);
      op[(size_t)qrow * DM] = (bf16)f2bf(o00[rr] * il); op[(size_t)qrow * DM + 32] = (bf16)f2bf(o01[rr] * il); }
  asm volatile("s_waitcnt lgkmcnt(0)" ::: "memory");
  if (hi == 0) li_l[r32] = l1; asm volatile("s_waitcnt lgkmcnt(0)" ::: "memory");
#pragma unroll
  for (int rr = 0; rr < 16; ++rr) { const int qrow = 32 + da::crow(rr, hi); const float il = __builtin_amdgcn_rcpf(li_l[qrow - 32]);
      op[(size_t)qrow * DM] = (bf16)f2bf(o10[rr] * il); op[(size_t)qrow * DM + 32] = (bf16)f2bf(o11[rr] * il); }
  asm volatile("s_waitcnt lgkmcnt(0)" ::: "memory");
}
}
constexpr int MLP = 4;
namespace sc {
#define LBAR() do { asm volatile("s_waitcnt lgkmcnt(0)" ::: "memory"); __builtin_amdgcn_s_barrier(); asm volatile("" ::: "memory"); } while (0)

using bf16x8 = __attribute__((ext_vector_type(8))) short;
using f32x16 = __attribute__((ext_vector_type(16))) float;
constexpr int RS = 272;
constexpr int TS = 144;
template <int NS> __device__ __forceinline__ void mm(f32x16& c, const LAS char* xb, int xs, const LAS char* yb, int ys, int kb0, int lane) {
    const int r = lane & 31, h = lane >> 5;
    const LAS char* xp = xb + r * xs + kb0 + h * 16; const LAS char* yp = yb + r * ys + kb0 + h * 16;
#pragma unroll
    for (int s = 0; s < NS; ++s) { const bf16x8 a = *(const LAS bf16x8*)(xp + s * 32), b = *(const LAS bf16x8*)(yp + s * 32); c = __builtin_amdgcn_mfma_f32_32x32x16_bf16(a, b, c, 0, 0, 0); }
}
__device__ __forceinline__ unsigned long long pk4(float a, float b, float c, float d) { return (unsigned long long)pk2(a, b) | ((unsigned long long)pk2(c, d) << 32); }

__device__ __forceinline__ void hgrn_unit(int u, const bf16* P, float* OF, float* OB, LAS unsigned char* ldsu, int tid) {
    const int b = u >> 3, h = (u >> 1) & 3, dir = u & 1, wave = __builtin_amdgcn_readfirstlane(tid >> 6);
    LAS char* lds = (LAS char*)ldsu;
    LAS char* QM = lds; LAS char* KM = lds + 17408; LAS char* KMt = lds + 34816; LAS char* Vt = lds + 53248; LAS char* ST = lds + 71680; LAS char* AA = lds + 106496;
    LAS float* GT = (LAS float*)(lds + 115712); LAS float* CM = (LAS float*)(lds + 117760); LAS float* DL = (LAS float*)(lds + 118272); LAS float* FC = (LAS float*)(lds + 118784);
    const char* Pb = (const char*)(P + (size_t)b * NT_ * P0W); char* Ob = (char*)((dir ? OB : OF) + (size_t)b * NT_ * GW);
    const int sgn = dir ? -1 : 1, tz = dir ? NT_ - 1 : 0, sP = sgn * P0W * 2, fofs = (dir ? 1536 : 1024) * 2;
    int op = ((tz + sgn * ((tid >> 7) * 16)) * P0W + h * 128 + (tid & 127)) * 2;
    const int et = wave & 3, dt0 = 2 * (wave >> 2), tt = wave >> 2;
    const int tg = tid >> 7;
    f32x16 S0 = {}, S1 = {};
    unsigned rq[16], rf[16], rv[16];
#define HG_LOAD() do { _Pragma("unroll") for (int j = 0; j < 16; ++j) { const char* p = Pb + (unsigned)(op + j * sP); rq[j] = *(const unsigned short*)p; rv[j] = *(const unsigned short*)(p + 1024); rf[j] = *(const unsigned short*)(p + fofs); } \
        op += 64 * sP; } while (0)
    HG_LOAD();
#pragma unroll 1
    for (int c_ = 0; c_ < (NT_ / 64) * NREP(30); ++c_) { const int c = c_ & 63; if (c_ == 64) { S0 = f32x16{}; S1 = f32x16{}; }
        int tl_ = tid; asm volatile("" : "+v"(tl_)); const int d = tl_ & 127, lane = tl_ & 63;
#pragma unroll
        for (int j = 0; j < 16; ++j) { asm volatile("" : "+v"(rq[j])); asm volatile("" : "+v"(rf[j])); asm volatile("" : "+v"(rv[j])); }
        float qv[16], kv[16], cum[16]; float run = 0.f;
#pragma unroll
        for (int j = 0; j < 16; ++j) { kv[j] = __builtin_bit_cast(float, rf[j] << 16); run += __logf(1.f - kv[j]); cum[j] = run; qv[j] = __builtin_bit_cast(float, rq[j] << 16); }
        GT[tg * 128 + d] = run;
        LBAR();
        const float g0 = GT[d], g1 = GT[128 + d], g2 = GT[256 + d], g3 = GT[384 + d];
        const float cmid = g0 + g1, cL = cmid + g2 + g3;
        const float off = (tg == 0 ? 0.f : tg == 1 ? g0 : tg == 2 ? cmid : cmid + g2) - cmid;
        if (tg == 0) { CM[d] = __expf(cmid); DL[d] = __expf(cL); FC[d] = __expf(cL - cmid); }
        { unsigned kmw[8];
#pragma unroll
          for (int j = 0; j < 16; j += 2) {
              float x0 = off + cum[j], x1 = off + cum[j + 1];
              x0 = fminf(fmaxf(x0, -80.f), 80.f); x1 = fminf(fmaxf(x1, -80.f), 80.f);
              const float qm0 = qv[j] * __expf(x0), qm1 = qv[j + 1] * __expf(x1), km0 = kv[j] * __expf(-x0), km1 = kv[j + 1] * __expf(-x1);
              const unsigned qmp = pk2(qm0, qm1), kmp = pk2(km0, km1);
              const int t0 = tg * 16 + j;
              *(LAS unsigned short*)(QM + t0 * RS + d * 2) = (unsigned short)qmp; *(LAS unsigned short*)(QM + (t0 + 1) * RS + d * 2) = (unsigned short)(qmp >> 16);
              *(LAS unsigned short*)(KM + t0 * RS + d * 2) = (unsigned short)kmp; *(LAS unsigned short*)(KM + (t0 + 1) * RS + d * 2) = (unsigned short)(kmp >> 16);
              kmw[j >> 1] = kmp; }
          *(LAS v4u*)(KMt + d * TS + tg * 32) = (v4u){kmw[0], kmw[1], kmw[2], kmw[3]}; *(LAS v4u*)(KMt + d * TS + tg * 32 + 16) = (v4u){kmw[4], kmw[5], kmw[6], kmw[7]};
          v4u v0, v1; v0.x = rv[0] | (rv[1] << 16); v0.y = rv[2] | (rv[3] << 16); v0.z = rv[4] | (rv[5] << 16); v0.w = rv[6] | (rv[7] << 16);
          v1.x = rv[8] | (rv[9] << 16); v1.y = rv[10] | (rv[11] << 16); v1.z = rv[12] | (rv[13] << 16); v1.w = rv[14] | (rv[15] << 16);
          *(LAS v4u*)(Vt + d * TS + tg * 32) = v0; *(LAS v4u*)(Vt + d * TS + tg * 32 + 16) = v1; }
        if (c_ == 63 && NREP(30) == 2) op -= 64 * 64 * sP;
        if (c_ + 1 < (NT_ / 64) * NREP(30)) HG_LOAD();
        LBAR();
        { const int e = 32 * et + (lane & 31);
#pragma unroll
          for (int k = 0; k < 2; ++k)
#pragma unroll
              for (int i4 = 0; i4 < 4; ++i4) { const int d0 = 32 * (dt0 + k) + 8 * i4 + 4 * (lane >> 5); const f32x4 cm = *(const LAS f32x4*)(CM + d0);
                  const f32x16& S = k ? S1 : S0;
                  *(LAS unsigned long long*)(ST + e * RS + d0 * 2) = pk4(S[4 * i4] * cm.x, S[4 * i4 + 1] * cm.y, S[4 * i4 + 2] * cm.z, S[4 * i4 + 3] * cm.w); } }
        LBAR();
        f32x16 acc = {};
        mm<8>(acc, QM + 32 * tt * RS, RS, ST + 32 * et * RS, RS, 0, lane);
        if (wave < 3) { const int st = wave >> 1, t2 = (wave + 1) >> 1;
            f32x16 at = {};
            mm<8>(at, KM + 32 * st * RS, RS, QM + 32 * t2 * RS, RS, 0, lane);
            const int tg_ = 32 * t2 + (lane & 31);
#pragma unroll
            for (int i4 = 0; i4 < 4; ++i4) { const int s0 = 32 * st + 8 * i4 + 4 * (lane >> 5);
                *(LAS unsigned long long*)(AA + tg_ * TS + s0 * 2) = pk4(s0 <= tg_ ? at[4 * i4] : 0.f, s0 + 1 <= tg_ ? at[4 * i4 + 1] : 0.f, s0 + 2 <= tg_ ? at[4 * i4 + 2] : 0.f, s0 + 3 <= tg_ ? at[4 * i4 + 3] : 0.f); } }
#pragma unroll
        for (int k = 0; k < 2; ++k) { f32x16 p = {};
            mm<4>(p, KMt + 32 * (dt0 + k) * TS, TS, Vt + 32 * et * TS, TS, 0, lane);
            f32x16& S = k ? S1 : S0;
#pragma unroll
            for (int i4 = 0; i4 < 4; ++i4) { const int d0 = 32 * (dt0 + k) + 8 * i4 + 4 * (lane >> 5); const f32x4 dl = *(const LAS f32x4*)(DL + d0), fc = *(const LAS f32x4*)(FC + d0);
                S[4 * i4] = dl.x * S[4 * i4] + fc.x * p[4 * i4]; S[4 * i4 + 1] = dl.y * S[4 * i4 + 1] + fc.y * p[4 * i4 + 1];
                S[4 * i4 + 2] = dl.z * S[4 * i4 + 2] + fc.z * p[4 * i4 + 2]; S[4 * i4 + 3] = dl.w * S[4 * i4 + 3] + fc.w * p[4 * i4 + 3]; } }
        LBAR();
        if (tt == 0) mm<2>(acc, AA, TS, Vt + 32 * et * TS, TS, 0, lane); else mm<4>(acc, AA + 32 * TS, TS, Vt + 32 * et * TS, TS, 0, lane);
        { const int oo = ((tz + sgn * (c * 64 + 32 * tt + 4 * (lane >> 5))) * GW + h * 128 + 32 * et + (lane & 31)) * 4;
#pragma unroll
          for (int i = 0; i < 16; ++i) *(float*)(Ob + (unsigned)(oo + sgn * ((8 * (i >> 2) + (i & 3)) * GW * 4))) = acc[i]; }
    }
#undef HG_LOAD
    __syncthreads();
}

template <bool STATE_ONLY>
__device__ __forceinline__ void mlstm_unit(int u, int part, const bf16* P, const bf16* QKC, const float* ibias, const float* fbias, float* HF, float* HBk, float* CL, float* NL, float* FPL, LAS unsigned char* ldsu, int tid) {
    constexpr int MLC = (NT_ / 64) / MLP; const int cbase = part * MLC;
    const int b = u >> 3, h = (u >> 1) & 3, dir = u & 1, tg = tid >> 7, wave = __builtin_amdgcn_readfirstlane(tid >> 6);
    LAS char* lds = (LAS char*)ldsu;
    LAS char* Qs = lds; LAS char* Ks = lds + 17408; LAS char* KWt = lds + 34816; LAS char* Vt = lds + 53248; LAS char* ST = lds + 71680; LAS char* AA = lds + 106496;
    LAS float* GB = (LAS float*)(lds + 115712);
    LAS float* DENI = GB + 512; LAS float* DENA = DENI + 64; LAS float* NV = DENA + 128; LAS float* NP = NV + 256;
    const float ib = ibias[dir * 4 + h], fb = fbias[dir * 4 + h];
    const char* Pb = (const char*)(P + (size_t)b * NT_ * P1W); const char* Qb = (const char*)(QKC + (size_t)b * NT_ * DM); char* Ob = (char*)((dir ? HBk : HF) + (size_t)b * NT_ * GW);
    const int sgn = dir ? -1 : 1, tz = dir ? NT_ - 1 : 0;
    const int sK = sgn * DM * 2, sV = sgn * P1W * 2;
    int ok = ((tz + sgn * (cbase * 64 + tg * 16)) * DM + GW + h * 128 + (tid & 127)) * 2;
    int ov = ((tz + sgn * (cbase * 64 + tg * 16)) * P1W + 1024 + h * 128 + (tid & 127)) * 2;
    int oq = ((tz + sgn * (cbase * 64 + (tid >> 3))) * DM + h * 128 + (tid & 7) * 16) * 2;
    int og = ((tz + sgn * (cbase * 64 + (tid & 63))) * P1W + 3584 + dir * 8 + h) * 2;
    const int et = wave & 3, dt0 = 2 * (wave >> 2), tt = wave >> 2;
    f32x16 S0 = {}, S1 = {}; float facc = 0.f;
    float* const clw = CL + ((size_t)(u * MLP) * 16384) + (size_t)(wave * 2) * 1024 + (tid & 63);
    { float nv = 0.f;
      if (!STATE_ONLY) {
#pragma unroll 1
          for (int j = 0; j < part; ++j) { const float fj = __expf(FPL[u * MLP + j]); const float* cj = clw + (size_t)j * 16384;
#pragma unroll
              for (int i = 0; i < 16; ++i) { S0[i] = fj * S0[i] + cj[i * 64]; S1[i] = fj * S1[i] + cj[1024 + i * 64]; }
              if (tid < 128) nv = fj * nv + NL[(u * MLP + j) * 128 + tid]; } }
      if (tid < 128) { NV[tid] = nv; NV[128 + tid] = 0.f; } }
    if (!STATE_ONLY) { const int e = 32 * et + (tid & 31), hi_ = (tid >> 5) & 1;
#pragma unroll
        for (int k = 0; k < 2; ++k)
#pragma unroll
            for (int i4 = 0; i4 < 4; ++i4) { const int d0 = 32 * (dt0 + k) + 8 * i4 + 4 * hi_; const f32x16& S = k ? S1 : S0;
                *(LAS unsigned long long*)(ST + e * RS + d0 * 2) = pk4(S[4 * i4], S[4 * i4 + 1], S[4 * i4 + 2], S[4 * i4 + 3]); } }
    unsigned rk[16], rv[16]; v4u wq0 = {0u, 0u, 0u, 0u}, wq1 = wq0, wk0 = wq0, wk1 = wq0; unsigned rgi = 0, rgf = 0;
#define ML_LOAD() do { _Pragma("unroll") for (int j = 0; j < 16; ++j) { rk[j] = *(const unsigned short*)(Qb + (unsigned)(ok + j * sK)); rv[j] = *(const unsigned short*)(Pb + (unsigned)(ov + j * sV)); } \
        if (!STATE_ONLY) { const char* qp = Qb + (unsigned)oq; wq0 = *(const v4u*)qp; wq1 = *(const v4u*)(qp + 16); wk0 = *(const v4u*)(qp + GW * 2); wk1 = *(const v4u*)(qp + GW * 2 + 16); } \
        ok += 64 * sK; ov += 64 * sV; oq += 64 * sK; } while (0)
#define ML_GLOAD() do { if (tid < 64) { rgi = *(const unsigned short*)(Pb + (unsigned)og); rgf = *(const unsigned short*)(Pb + (unsigned)og + 8); } og += 64 * sV; } while (0)
#define ML_GATES(buf) do { if (tid < 64) { const float ig = __builtin_bit_cast(float, rgi << 16) + ib, x = __builtin_bit_cast(float, rgf << 16) + fb; const float lf = -__logf(1.f + __expf(-x)); float cs = lf; \
            _Pragma("unroll") for (int o = 1; o < 64; o <<= 1) { const float t_ = __shfl_up(cs, o); if ((tid & 63) >= o) cs += t_; } \
            const float cL = __shfl(cs, 63); facc += cL; LAS float* g_ = GB + (buf) * 256; \
            g_[tid] = __expf(cs); g_[64 + tid] = __expf(ig - cs); g_[128 + tid] = __expf(cL - cs + ig); if (tid == 0) g_[192] = __expf(cL); } } while (0)
    ML_GLOAD(); ML_GATES(0); ML_GLOAD(); ML_LOAD();
    __syncthreads();
#pragma unroll 1
    for (int c = 0; c < MLC; ++c) {
        int tl_ = tid; asm volatile("" : "+v"(tl_)); const int d = tl_ & 127, lane = tl_ & 63;
#pragma unroll
        for (int j = 0; j < 16; ++j) { asm volatile("" : "+v"(rk[j])); asm volatile("" : "+v"(rv[j])); }
        asm volatile("" : "+v"(wq0)); asm volatile("" : "+v"(wq1)); asm volatile("" : "+v"(wk0)); asm volatile("" : "+v"(wk1)); asm volatile("" : "+v"(rgi)); asm volatile("" : "+v"(rgf));
        const LAS float* G = GB + (c & 1) * 256; const LAS float* NVc = NV + (c & 1) * 128; LAS float* NVn = NV + ((c + 1) & 1) * 128;
        if (!STATE_ONLY) { const int t = tl_ >> 3, part = tl_ & 7;
          *(LAS v4u*)(Qs + t * RS + part * 32) = wq0; *(LAS v4u*)(Qs + t * RS + part * 32 + 16) = wq1; *(LAS v4u*)(Ks + t * RS + part * 32) = wk0; *(LAS v4u*)(Ks + t * RS + part * 32 + 16) = wk1; }
        { unsigned kw[8]; float ksum = 0.f;
#pragma unroll
          for (int j = 0; j < 16; j += 2) { const int t0 = tg * 16 + j; const float k0 = __builtin_bit_cast(float, rk[j] << 16) * G[128 + t0], k1 = __builtin_bit_cast(float, rk[j + 1] << 16) * G[128 + t0 + 1];
              ksum += k0 + k1; kw[j >> 1] = pk2(k0, k1); }
          NP[tg * 128 + d] = ksum;
          *(LAS v4u*)(KWt + d * TS + tg * 32) = (v4u){kw[0], kw[1], kw[2], kw[3]}; *(LAS v4u*)(KWt + d * TS + tg * 32 + 16) = (v4u){kw[4], kw[5], kw[6], kw[7]};
          v4u v0, v1; v0.x = rv[0] | (rv[1] << 16); v0.y = rv[2] | (rv[3] << 16); v0.z = rv[4] | (rv[5] << 16); v0.w = rv[6] | (rv[7] << 16);
          v1.x = rv[8] | (rv[9] << 16); v1.y = rv[10] | (rv[11] << 16); v1.z = rv[12] | (rv[13] << 16); v1.w = rv[14] | (rv[15] << 16);
          *(LAS v4u*)(Vt + d * TS + tg * 32) = v0; *(LAS v4u*)(Vt + d * TS + tg * 32 + 16) = v1; }
        if (c + 1 < MLC) { ML_GATES((c + 1) & 1); ML_LOAD(); if (c + 2 < MLC) ML_GLOAD(); }
        LBAR();
        f32x16 acc = {};
        if (!STATE_ONLY) {
        { const int t = tl_ >> 3, part = tl_ & 7; float qf[16]; unpack8(*(const LAS v4u*)(Qs + t * RS + part * 32), *(float(*)[8])&qf[0]); unpack8(*(const LAS v4u*)(Qs + t * RS + part * 32 + 16), *(float(*)[8])&qf[8]);
          float s = 0.f;
#pragma unroll
          for (int i = 0; i < 16; ++i) s += qf[i] * NVc[part * 16 + i];
          s += __shfl_xor(s, 1); s += __shfl_xor(s, 2); s += __shfl_xor(s, 4);
          if (part == 0) DENI[t] = s * G[t]; }
        mm<8>(acc, Qs + 32 * tt * RS, RS, ST + 32 * et * RS, RS, 0, lane);
#pragma unroll
        for (int i4 = 0; i4 < 4; ++i4) { const f32x4 rf = *(const LAS f32x4*)(G + 32 * tt + 8 * i4 + 4 * (lane >> 5));
            acc[4 * i4] *= rf.x; acc[4 * i4 + 1] *= rf.y; acc[4 * i4 + 2] *= rf.z; acc[4 * i4 + 3] *= rf.w; }
        if (wave < 3) { const int st = wave >> 1, t2 = (wave + 1) >> 1;
            f32x16 at = {};
            mm<8>(at, Ks + 32 * st * RS, RS, Qs + 32 * t2 * RS, RS, 0, lane);
            const int tg_ = 32 * t2 + (lane & 31); const float rowf = G[tg_]; float dsum = 0.f;
#pragma unroll
            for (int i4 = 0; i4 < 4; ++i4) { const int s0 = 32 * st + 8 * i4 + 4 * (lane >> 5); const f32x4 cf = *(const LAS f32x4*)(G + 64 + s0);
                const float a0 = s0 <= tg_ ? at[4 * i4] * cf.x * rowf : 0.f, a1 = s0 + 1 <= tg_ ? at[4 * i4 + 1] * cf.y * rowf : 0.f;
                const float a2 = s0 + 2 <= tg_ ? at[4 * i4 + 2] * cf.z * rowf : 0.f, a3 = s0 + 3 <= tg_ ? at[4 * i4 + 3] * cf.w * rowf : 0.f;
                dsum += (a0 + a1) + (a2 + a3);
                *(LAS unsigned long long*)(AA + tg_ * TS + s0 * 2) = pk4(a0, a1, a2, a3); }
            dsum += __shfl_xor(dsum, 32);
            if (lane < 32) DENA[st * 64 + tg_] = dsum;
            if (wave == 0 && lane < 32) DENA[64 + lane] = 0.f; }
        }
        { const float dls = G[192];
#pragma unroll
          for (int k = 0; k < 2; ++k) { f32x16 p = {};
              mm<4>(p, KWt + 32 * (dt0 + k) * TS, TS, Vt + 32 * et * TS, TS, 0, lane);
              f32x16& S = k ? S1 : S0;
#pragma unroll
              for (int i = 0; i < 16; ++i) S[i] = dls * S[i] + p[i]; }
          if (tl_ < 128) NVn[tl_] = dls * NVc[tl_] + ((NP[tl_] + NP[128 + tl_]) + (NP[256 + tl_] + NP[384 + tl_])); }
        if (!STATE_ONLY) {
        LBAR();
        if (tt == 0) mm<2>(acc, AA, TS, Vt + 32 * et * TS, TS, 0, lane); else mm<4>(acc, AA + 32 * TS, TS, Vt + 32 * et * TS, TS, 0, lane);
        { const int tc0 = 32 * tt + 4 * (lane >> 5); const int oo = ((tz + sgn * ((cbase + c) * 64 + tc0)) * GW + h * 128 + 32 * et + (lane & 31)) * 4;
#pragma unroll
          for (int i4 = 0; i4 < 4; ++i4) { const f32x4 di = *(const LAS f32x4*)(DENI + tc0 + 8 * i4), da = *(const LAS f32x4*)(DENA + tc0 + 8 * i4), db = *(const LAS f32x4*)(DENA + 64 + tc0 + 8 * i4);
              const f32x4 den = di + da + db;
#pragma unroll
              for (int j = 0; j < 4; ++j) *(float*)(Ob + (unsigned)(oo + sgn * ((8 * i4 + j) * GW * 4))) = acc[4 * i4 + j] * __builtin_amdgcn_rcpf(fmaxf(fabsf(den[j]), 1.f)); } }
        { const int e = 32 * et + (lane & 31);
#pragma unroll
          for (int k = 0; k < 2; ++k)
#pragma unroll
              for (int i4 = 0; i4 < 4; ++i4) { const int d0 = 32 * (dt0 + k) + 8 * i4 + 4 * (lane >> 5); const f32x16& S = k ? S1 : S0;
                  *(LAS unsigned long long*)(ST + e * RS + d0 * 2) = pk4(S[4 * i4], S[4 * i4 + 1], S[4 * i4 + 2], S[4 * i4 + 3]); } }
        }
        LBAR();
    }
    if (STATE_ONLY) {
        float* cw = clw + (size_t)part * 16384;
#pragma unroll
        for (int i = 0; i < 16; ++i) { cw[i * 64] = S0[i]; cw[1024 + i * 64] = S1[i]; }
        if (tid < 128) NL[(u * MLP + part) * 128 + tid] = NV[(MLC & 1) * 128 + tid];
        if (tid == 0) FPL[u * MLP + part] = facc;
    }
#undef ML_LOAD
#undef ML_GLOAD
#undef ML_GATES
}
}
#ifndef STOP_AFTER
#define STOP_AFTER 25
#endif
constexpr int N_PHASES = 26;
constexpr int N_CONV_HELPERS = 64;
struct Args { const float* in[44]; float* out; unsigned char* ws; int ph_lo, ph_hi, li, pad; };
__global__ void __launch_bounds__(NWAVES * 64, 2) fwd_kernel(Args args) {
    extern __shared__ __attribute__((aligned(16))) unsigned char lds_raw[];
    LAS unsigned char* lds = (LAS unsigned char*)lds_raw;
    volatile LAS unsigned* MISC = (volatile LAS unsigned*)(lds + MISC_OFF);
    LAS int* TB = (LAS int*)(lds + TBL_OFF);
    const int tid0 = threadIdx.x, wave = __builtin_amdgcn_readfirstlane(tid0 >> 6);
    const int G = gridDim.x, bx = blockIdx.x;
    const int gw = bx * NWAVES + wave, NGW = G * NWAVES, NGT = G * NWAVES * 64;
    unsigned char* ws = args.ws;
    gu32* ctl = (gu32*)(ws + WS_CTL);
    const float* x_in = args.in[0]; const float* c_in = args.in[1]; const float* lbl = args.in[2];
    const float* const* L0 = args.in + 3; const float* const* L1 = args.in + 23; const float* fnorm = args.in[43];
    float* xo = args.out;
    float* TAB = (float*)(ws + WS_TAB); float* MOD = (float*)(ws + WS_MOD); float* OML = (float*)(ws + WS_OML);
    bf16* WIN0 = (bf16*)(ws + WS_WIN0); bf16* WIN1 = (bf16*)(ws + WS_WIN1); bf16* WOUT0 = (bf16*)(ws + WS_WOUT0); bf16* WOUT1 = (bf16*)(ws + WS_WOUT1);
    bf16* ROUT0 = (bf16*)(ws + WS_ROUT0); bf16* ROUT1 = (bf16*)(ws + WS_ROUT1); bf16* GU = (bf16*)(ws + WS_GU); bf16* DN = (bf16*)(ws + WS_DN);
    bf16* H2A = (bf16*)(ws + WS_H2A); bf16* H2B = (bf16*)(ws + WS_H2B); bf16* PROJ = (bf16*)(ws + WS_PROJ); bf16* CAT = (bf16*)(ws + WS_CAT);
    float* OF = (float*)(ws + WS_OF); float* OB = (float*)(ws + WS_OB); bf16* QKC = (bf16*)(ws + WS_QKC);
    unsigned char* YB = (unsigned char*)(ws + WS_Y); bf16* HB = (bf16*)(ws + WS_HB); float* LOG = (float*)(ws + WS_LOG);
    int* TOPI = (int*)(ws + WS_TOPI); float* TOPW = (float*)(ws + WS_TOPW); int* RANK = (int*)(ws + WS_RANK); int* SLOT = (int*)(ws + WS_SLOT); int* LIST = (int*)(ws + WS_LIST);

    for (int u = tid0; u < (LDS_BYTES - LDSCTL_OFF) / 4; u += NWAVES * 64) ((LAS unsigned*)(lds + LDSCTL_OFF))[u] = 0u;
    __syncthreads();
    XcdBarrier bar = xcd_barrier_post((unsigned*)(ctl + CW_BAR + args.li * 4096), MISC + 8);
#ifndef PREFIX_K
#define PREFIX_K -1
#endif
    const int pass = args.li;
    const int lo = args.ph_lo, hi = args.ph_hi;
    gu32* const qh = ctl + CW_Q0 + pass * 256; unsigned* const cnt0 = (unsigned*)(ctl + CW_CNT0 + pass * 512); unsigned* const cnt1 = (unsigned*)(ctl + CW_CNT1 + pass * 512);
#define IN(k) (lo <= (k) && (k) < hi)
#define FRESH() int tid = wave * 64 + pg8::fresh_lane(); asm volatile("" : "+v"(tid)); const int lane = tid & 63; const int gtid = bx * (NWAVES * 64) + tid; (void)lane; (void)gtid
#define SEAM(k) do { if (IN(k) && IN((k) + 1)) xcd_barrier(bar); } while (0)
    LAS float* scr = (LAS float*)(lds + wave * 8448);

    if (IN(0)) { FRESH();
        if (bx < 192) mod_unit(bx, c_in, L0[2], L0[3], L1[2], L1[3], MOD, lds, tid, wave, lane);
        int jbase = 0;
        TR_JOB(L0[4], 4096, 1024, 0, 4096, WIN0, 0);
        TR_JOB(L1[4], 3600, 1024, 0, 2048, WIN1, 0);
        TR_JOB(L1[4], 3600, 1024, 2064, 1536, WIN1, 2048);
        TR_JOB(L1[4], 3600, 1024, 2048, 16, WIN1, 3584);
        TR_JOB(L0[5], 1024, 1024, 0, 1024, WOUT0, 0);
        TR_JOB(L1[5], 1024, 1024, 0, 1024, WOUT1, 0);
        TR_JOB(L0[12], 128, 1024, 0, 128, ROUT0, 0);
        TR_JOB(L1[12], 128, 1024, 0, 128, ROUT1, 0);
        { const v4u z = {0u, 0u, 0u, 0u};
          for (int i = gtid; i < 224 * 128; i += NGT) *(v4u*)(WIN1 + (size_t)3616 * 1024 + (size_t)i * 8) = z;
          for (int i = gtid; i < 128 * 128; i += NGT) { *(v4u*)(ROUT0 + (size_t)128 * 1024 + (size_t)i * 8) = z; *(v4u*)(ROUT1 + (size_t)128 * 1024 + (size_t)i * 8) = z; } }
        for (int i = gtid; i < 2 * GW; i += NGT) OML[i] = 1.f - 1.f / (1.f + __expf(lbl[2 * GW + i] - lbl[i]));
        for (int t = gtid; t < NT_; t += NGT) {
            const float invf[8] = {1.0f, 0.1939227432f, 0.0376060307f, 0.00729266461f, 0.00141421356f, 0.000274248188f, 5.31829573e-05f, 1.03133852e-05f};
#pragma unroll
            for (int i = 0; i < 8; ++i) { const float ang = (float)t * invf[i]; double rev = (double)ang * 0.15915494309189535; rev -= floor(rev); const float rv = (float)rev;
                TAB[t * 16 + i] = __builtin_amdgcn_cosf(rv); TAB[t * 16 + 8 + i] = __builtin_amdgcn_sinf(rv); }
        }
    }
    SEAM(0);
    if (IN(1)) { FRESH(); _Pragma("unroll 1") for (int rep_ = 0; rep_ < NREP(1); ++rep_) normmod_phase(x_in, L0[0], MOD, 0, 1024, H2A, gw, NGW, lane); }
    SEAM(1);
    if (IN(2)) { FRESH(); pg8::DenseOrder S; S.init(NTOK, P0W, G, bx); EpiProj0 E{PROJ, OML, TAB};
        _Pragma("unroll 1") for (int rep_ = 0; rep_ < NREP(2); ++rep_) pg8::gemm_phase<EpiProj0, pg8::DenseOrder, true>(lds, H2A, WIN0, DM, S, E, wave); }
    if (IN(2) && IN(4)) xcd_barrier(bar);
    if (IN(4)) { FRESH();
        if (bx < 64) sc::hgrn_unit(bx, PROJ, OF, OB, lds, tid);
        float lam;
        { float a = L0[7][lane] * L0[8][lane], b2 = L0[9][lane] * L0[10][lane]; a = wave_sum(a); b2 = wave_sum(b2); lam = __expf(a) - __expf(b2) + 0.2f; }
        { bool more_conv = true;
          for (;;) { const int u = q_pull(qh, MISC + 0, tid); if (u >= 1024 * NREP(4)) break; da::unit(u & 1023, PROJ, lam, L0[11], CAT, (LAS char*)lds, tid);
              if (more_conv) { const int u0 = q_pull(qh + 64, MISC + 1, tid); if (u0 >= 1032 * NREP(27)) more_conv = false; else { const int uc = u0 % 1032;
#pragma unroll 1
                  for (int k = 0; k < 6; ++k) expert_item(L0[14], L0[15], L0[16], L0[17], L0[18], L0[19], GU, DN, uc * 48 + wave * 6 + k, scr, lane); } } }
          for (;;) { const int u0 = q_pull(qh + 64, MISC + 1, tid); if (u0 >= 1032 * NREP(27)) break; const int uc = u0 % 1032;
#pragma unroll 1
              for (int k = 0; k < 6; ++k) expert_item(L0[14], L0[15], L0[16], L0[17], L0[18], L0[19], GU, DN, uc * 48 + wave * 6 + k, scr, lane); } }
    }
    SEAM(4);
    if (IN(5)) { FRESH(); _Pragma("unroll 1") for (int rep_ = 0; rep_ < NREP(5); ++rep_) gateout_phase<2>(OF, OB, L0[6], PROJ, P0W, 2048, CAT, gw, NGW, lane); }
    SEAM(5);
    if (IN(6)) { FRESH(); pg8::DenseOrder S; S.init(NTOK, DM, G, bx); EpiResidNorm E{x_in, xo, MOD + 2048, L0[1], MOD + 3072, MOD + 4096, H2A, (float*)(ws + WS_SSP), ctl + CW_PANEL, (LAS float*)(lds + PST_OFF)};
        pg8::gemm_phase<EpiResidNorm, pg8::DenseOrder, true>(lds, CAT, WOUT0, DM, S, E, wave); }
    if (IN(6) && IN(8)) xcd_barrier(bar);
    if (IN(8)) { FRESH(); pg8::DenseOrder S; S.init(NTOK, 256, G, bx); EpiF32 E{LOG, 256};
        _Pragma("unroll 1") for (int rep_ = 0; rep_ < NREP(8); ++rep_) pg8::gemm_phase<EpiF32, pg8::DenseOrder, true>(lds, H2A, ROUT0, DM, S, E, wave); }
    SEAM(8);
    if (IN(9)) { FRESH(); topk_phase(LOG, L0[13], TOPI, TOPW, RANK, cnt0, lds, bx, G, wave, tid); }
    SEAM(9);
    if (IN(10)) { FRESH(); moe_tables(cnt0, TB, tid); _Pragma("unroll 1") for (int rep_ = 0; rep_ < NREP(10); ++rep_) list_phase(TOPI, RANK, SLOT, LIST, TB, gtid, NGT); }
    SEAM(10);
    if (IN(11)) { FRESH(); moe_tables(cnt0, TB, tid); GroupOrder S; S.init(TB, LIST, 2, G, bx); EpiGateUp E{HB};
        _Pragma("unroll 1") for (int rep_ = 0; rep_ < NREP(11); ++rep_) pg8::gemm_phase<EpiGateUp, GroupOrder, true>(lds, H2A, GU, DM, S, E, wave); }
    SEAM(11);
    if (IN(12)) { FRESH(); moe_tables(cnt0, TB, tid); GroupOrder S; S.init(TB, nullptr, 4, G, bx); EpiDown E{YB};
        _Pragma("unroll 1") for (int rep_ = 0; rep_ < NREP(12); ++rep_) pg8::gemm_phase<EpiDown, GroupOrder, true>(lds, HB, DN, EFF, S, E, wave); }
    SEAM(12);
    if (IN(13)) { FRESH(); combine_phase(xo, YB, SLOT, TOPW, MOD, 5120, L1[0], MOD + 8 * 6144, 0, 1024, H2B, nullptr, gw, NGW, lane); }
    SEAM(13);
    if (IN(14)) { FRESH(); pg8::DenseOrder S; S.init(NTOK, P1W, G, bx); EpiStoreBf16 E{PROJ, P1W};
        _Pragma("unroll 1") for (int rep_ = 0; rep_ < NREP(14); ++rep_) pg8::gemm_phase<EpiStoreBf16, pg8::DenseOrder, true>(lds, H2B, WIN1, DM, S, E, wave); }
    SEAM(14);
    if (IN(15)) { FRESH(); _Pragma("unroll 1") for (int rep_ = 0; rep_ < NREP(15); ++rep_) convqk_phase(PROJ, L1[6], L1[7], QKC, gtid, NGT); }
    SEAM(15);
    if (IN(16)) { FRESH();
        float* CLr = (float*)(ws + WS_LOG); float* NLr = CLr + (size_t)64 * MLP * 16384; float* FPr = NLr + 64 * MLP * 128;
#pragma unroll 1
        for (int w = bx; w < 64 * MLP; w += G) if ((w % MLP) != MLP - 1) sc::mlstm_unit<true>(w / MLP, w % MLP, PROJ, QKC, L1[8], L1[9], OF, OB, CLr, NLr, FPr, lds, tid);
        xcd_barrier(bar);
#pragma unroll 1
        for (int w = bx; w < 64 * MLP; w += G) sc::mlstm_unit<false>(w / MLP, w % MLP, PROJ, QKC, L1[8], L1[9], OF, OB, CLr, NLr, FPr, lds, tid);
        { LAS float* BT = (LAS float*)(lds + 69632); for (int i = tid; i < 3720; i += 512) BT[i] = L1[11][i];
          for (;;) { const int u = q_pull(qh + 128, MISC + 2, tid); if (u >= 512 * NREP(16)) break; na::item((u & 511) * 8 + wave, PROJ, BT, CAT, (LAS char*)lds + wave * 8448, lane); } }
        for (;;) { const int u0 = q_pull(qh + 192, MISC + 3, tid); if (u0 >= 1032 * NREP(28)) break; const int u = u0 % 1032;
#pragma unroll 1
            for (int k = 0; k < 6; ++k) expert_item(L1[14], L1[15], L1[16], L1[17], L1[18], L1[19], GU, DN, u * 48 + wave * 6 + k, scr, lane); }
    }
    SEAM(16);
    if (IN(17)) { FRESH(); _Pragma("unroll 1") for (int rep_ = 0; rep_ < NREP(17); ++rep_) gateout_phase<1>(OF, OB, L1[10], PROJ, P1W, 1536, CAT, gw, NGW, lane); }
    SEAM(17);
    if (IN(18)) { FRESH(); pg8::DenseOrder S; S.init(NTOK, DM, G, bx); EpiResidNorm E{xo, xo, MOD + 8 * 6144 + 2048, L1[1], MOD + 8 * 6144 + 3072, MOD + 8 * 6144 + 4096, H2A, (float*)(ws + WS_SSP) + (size_t)NTOK * 4, ctl + CW_PANEL + 8192, (LAS float*)(lds + PST_OFF)};
        pg8::gemm_phase<EpiResidNorm, pg8::DenseOrder, true>(lds, CAT, WOUT1, DM, S, E, wave); }
    if (IN(18) && IN(20)) xcd_barrier(bar);
    if (IN(20)) { FRESH(); pg8::DenseOrder S; S.init(NTOK, 256, G, bx); EpiF32 E{LOG, 256};
        _Pragma("unroll 1") for (int rep_ = 0; rep_ < NREP(20); ++rep_) pg8::gemm_phase<EpiF32, pg8::DenseOrder, true>(lds, H2A, ROUT1, DM, S, E, wave); }
    SEAM(20);
    if (IN(21)) { FRESH(); topk_phase(LOG, L1[13], TOPI, TOPW, RANK, cnt1, lds, bx, G, wave, tid); }
    SEAM(21);
    if (IN(22)) { FRESH(); moe_tables(cnt1, TB, tid); _Pragma("unroll 1") for (int rep_ = 0; rep_ < NREP(22); ++rep_) list_phase(TOPI, RANK, SLOT, LIST, TB, gtid, NGT); }
    SEAM(22);
    if (IN(23)) { FRESH(); moe_tables(cnt1, TB, tid); GroupOrder S; S.init(TB, LIST, 2, G, bx); EpiGateUp E{HB};
        _Pragma("unroll 1") for (int rep_ = 0; rep_ < NREP(23); ++rep_) pg8::gemm_phase<EpiGateUp, GroupOrder, true>(lds, H2A, GU, DM, S, E, wave); }
    SEAM(23);
    if (IN(24)) { FRESH(); moe_tables(cnt1, TB, tid); GroupOrder S; S.init(TB, nullptr, 4, G, bx); EpiDown E{YB};
        _Pragma("unroll 1") for (int rep_ = 0; rep_ < NREP(24); ++rep_) pg8::gemm_phase<EpiDown, GroupOrder, true>(lds, HB, DN, EFF, S, E, wave); }
    SEAM(24);
    if (IN(25)) { FRESH(); combine_phase(xo, YB, SLOT, TOPW, MOD + 8 * 6144, 5120, nullptr, nullptr, 0, 0, nullptr, fnorm, gw, NGW, lane); }
    {
    if (pass == 1 && hi < N_PHASES && hi > 0 && IN(hi - 1)) { FRESH();
        xcd_barrier(bar);
        const float* src = (hi - 1 >= 6) ? (const float*)xo : x_in;
        for (int m = gw; m < NTOK; m += NGW) { const f32x4* xr = (const f32x4*)(src + (size_t)m * DM) + lane; f32x4 v[4];
#pragma unroll
            for (int j = 0; j < 4; ++j) v[j] = xr[64 * j];
            finalnorm_row(v, fnorm, xo + (size_t)m * DM, lane); }
    }
    }
#undef IN
#undef SEAM
}

extern "C" void kernel_launch(void* const* d_in, const int* in_sizes, int n_in, void* d_out, int out_size, void* d_ws, size_t ws_size, hipStream_t stream) {
    static int grid = 0;
    if (grid == 0) {
        if (n_in != 44 || in_sizes[0] != NTOK * DM || out_size != NTOK * DM || ws_size < WS_END) {
            fprintf(stderr, "kernel_launch: shape mismatch: n_in %d in0 %d out %d ws %zu (need %zu)\n", n_in, n_in > 0 ? in_sizes[0] : -1, out_size, ws_size, (size_t)WS_END); grid = -1; return; }
        int dev = 0, cus = 0, per_cu = 0;
        if (hipGetDevice(&dev) != hipSuccess || hipDeviceGetAttribute(&cus, hipDeviceAttributeMultiprocessorCount, dev) != hipSuccess) { grid = -1; return; }
        if (hipFuncSetAttribute((const void*)fwd_kernel, hipFuncAttributeMaxDynamicSharedMemorySize, LDS_BYTES) != hipSuccess) { fprintf(stderr, "kernel_launch: hipFuncSetAttribute failed\n"); grid = -1; return; }
        if (hipOccupancyMaxActiveBlocksPerMultiprocessor(&per_cu, (const void*)fwd_kernel, NWAVES * 64, LDS_BYTES) != hipSuccess || per_cu < 1) { fprintf(stderr, "kernel_launch: occupancy query reports %d\n", per_cu); }
        (void)hipGetLastError();
        grid = cus;
    }
    if (grid < 0) return;
    if (hipMemsetAsync((char*)d_ws + WS_CTL, 0, CTL_ZERO_BYTES, stream) != hipSuccess) return;
    Args a{};
    for (int i = 0; i < 44; ++i) a.in[i] = (const float*)d_in[i];
    a.out = (float*)d_out; a.ws = (unsigned char*)d_ws;
#if PREFIX_K >= 0
    a.ph_lo = 0; a.ph_hi = PREFIX_K + 1; a.li = 0;
    hipLaunchKernelGGL(fwd_kernel, dim3(grid), dim3(NWAVES * 64), LDS_BYTES, stream, a);
#endif
    a.ph_lo = 0; a.ph_hi = STOP_AFTER + 1; a.li = 1;
    hipLaunchKernelGGL(fwd_kernel, dim3(grid), dim3(NWAVES * 64), LDS_BYTES, stream, a);
    const hipError_t le = hipPeekAtLastError();
    if (le != hipSuccess) fprintf(stderr, "kernel_launch: launch failed: %s\n", hipGetErrorName(le));
}
```
